# Optimizing an MI355X kernel written in HIP

```python
import math
import jax, jax.numpy as jnp
from jax import lax
import numpy as np

D_MODEL = 2048
BATCH = 16
SEQ = 2048
DEPTH = 4
DEC_BATCH = 8
DEC_SEQ = 2048
PAST_LEN = 128

CONV_CH = 1024
N_HEADS = 8
HEAD_DIM = 128
ATTN_W = N_HEADS * HEAD_DIM
DIL_PAIRS = ((128, 1), (512, 4), (2048, 16))
ROPE_THETA = 10000.0
N_FOURIER_GROUPS = 4
D_FF = 5632
N_EVEN = (DEPTH + 1) // 2
N_ODD = DEPTH // 2
D_IN_MIX = 3 * CONV_CH + 3 * ATTN_W
ALPHA = (2 * DEPTH) ** 0.25
BETA = (8 * DEPTH) ** -0.25
LN_EPS = 1e-5

kernel_name = "hybrid_conv_dilattn_fnet_encoder"


def layer_norm(x, g, b):
    xf = x.astype(jnp.float32)
    mu = jnp.mean(xf, axis=-1, keepdims=True)
    var = jnp.mean(jnp.square(xf - mu), axis=-1, keepdims=True)
    y = (xf - mu) * lax.rsqrt(var + LN_EPS) * g.astype(jnp.float32) + b.astype(jnp.float32)
    return y.astype(x.dtype)


def dwconv3(x, w):
    xp = jnp.pad(x, ((0, 0), (1, 1), (0, 0)))
    return xp[:, :-2] * w[0] + xp[:, 1:-1] * w[1] + xp[:, 2:] * w[2]


def rope(x):
    S = x.shape[1]
    half = HEAD_DIM // 2
    inv = 1.0 / (ROPE_THETA ** (jnp.arange(half, dtype=jnp.float32) / half))
    ang = jnp.arange(S, dtype=jnp.float32)[:, None] * inv[None, :]
    cos = jnp.cos(ang)[None, :, None, :]
    sin = jnp.sin(ang)[None, :, None, :]
    xf = x.astype(jnp.float32)
    x1, x2 = xf[..., :half], xf[..., half:]
    return jnp.concatenate([x1 * cos - x2 * sin, x2 * cos + x1 * sin], axis=-1).astype(x.dtype)


def dilated_branch(q, k, v, window, dilation):
    Bsz, H, S, hd = q.shape
    r = dilation
    n_side = window // (2 * dilation)
    QB = n_side
    L = S // r
    nb = -(-L // QB)
    Lp = nb * QB

    def to_phase(t):
        return t.reshape(Bsz, H, L, r, hd).transpose(0, 1, 3, 2, 4)

    qp = jnp.pad(to_phase(q), ((0, 0), (0, 0), (0, 0), (0, Lp - L), (0, 0)))
    qb = qp.reshape(Bsz, H, r, nb, QB, hd)
    pad_k = ((0, 0), (0, 0), (0, 0), (QB, Lp - L + QB), (0, 0))
    kb = jnp.pad(to_phase(k), pad_k).reshape(Bsz, H, r, nb + 2, QB, hd)
    vb = jnp.pad(to_phase(v), pad_k).reshape(Bsz, H, r, nb + 2, QB, hd)
    kb = jnp.concatenate([kb[:, :, :, 0:nb], kb[:, :, :, 1:nb + 1], kb[:, :, :, 2:nb + 2]], axis=-2)
    vb = jnp.concatenate([vb[:, :, :, 0:nb], vb[:, :, :, 1:nb + 1], vb[:, :, :, 2:nb + 2]], axis=-2)

    a = jnp.arange(QB)[:, None]
    c = jnp.arange(3 * QB)[None, :]
    band = jnp.abs(c - QB - a) <= n_side
    kl = jnp.arange(nb)[:, None] * QB + jnp.arange(3 * QB)[None, :] - QB
    in_range = (kl >= 0) & (kl < L)
    mask = band[None, :, :] & in_range[:, None, :]

    s = jnp.einsum('bhrnqd,bhrnkd->bhrnqk', qb, kb)
    s = jnp.where(mask, s, -jnp.inf)
    m = jnp.max(s, axis=-1, keepdims=True)
    p = jnp.exp(s - m)
    den = jnp.sum(p, axis=-1, keepdims=True)
    o = jnp.einsum('bhrnqk,bhrnkd->bhrnqd', p, vb) / den
    lse = (m + jnp.log(den))[..., 0]

    o = o.reshape(Bsz, H, r, Lp, hd)[:, :, :, :L].transpose(0, 1, 3, 2, 4).reshape(Bsz, H, S, hd)
    lse = lse.reshape(Bsz, H, r, Lp)[..., :L].transpose(0, 1, 3, 2).reshape(Bsz, H, S)
    return o, lse


def dilated_attention(q, k, v):
    outs, lses = [], []
    for window, dilation in DIL_PAIRS:
        o, l = dilated_branch(q, k, v, window, dilation)
        outs.append(o)
        lses.append(l)
    w = jax.nn.softmax(jnp.stack(lses, axis=0), axis=0)
    return jnp.sum(w[..., None] * jnp.stack(outs, axis=0), axis=0)


def even_mixer(x, w_in, conv_w, w_out):
    Bsz, S, _ = x.shape
    h = x @ w_in
    c = CONV_CH
    bg, cg, xv, q, k, v = jnp.split(
        h, [c, 2 * c, 3 * c, 3 * c + ATTN_W, 3 * c + 2 * ATTN_W], axis=-1)
    y_conv = bg * dwconv3(cg * xv, conv_w)
    q = rope(q.reshape(Bsz, S, N_HEADS, HEAD_DIM))
    k = rope(k.reshape(Bsz, S, N_HEADS, HEAD_DIM))
    v = v.reshape(Bsz, S, N_HEADS, HEAD_DIM)
    qf = q.transpose(0, 2, 1, 3).astype(jnp.float32) * (HEAD_DIM ** -0.5)
    kf = k.transpose(0, 2, 1, 3).astype(jnp.float32)
    vf = v.transpose(0, 2, 1, 3).astype(jnp.float32)
    o = dilated_attention(qf, kf, vf)
    y_attn = o.transpose(0, 2, 1, 3).reshape(Bsz, S, ATTN_W).astype(x.dtype)
    return jnp.concatenate([y_conv, y_attn], axis=-1) @ w_out


def fourier_mixer(x, w_out):
    Bsz, S, D = x.shape
    xg = x.astype(jnp.float32).reshape(Bsz, S, N_FOURIER_GROUPS, D // N_FOURIER_GROUPS)
    f = jnp.fft.fft2(xg, axes=(1, 3), norm="ortho").real
    return f.reshape(Bsz, S, D).astype(x.dtype) @ w_out


def conv_ffn(x, w_up, conv_w, w_down):
    h = dwconv3(x @ w_up, conv_w)
    g, u = jnp.split(h, 2, axis=-1)
    return (jax.nn.silu(g) * u) @ w_down


def trunk(x, w_in_mix, conv_short, w_out_mix, w_out_fourier, ln_mix_g, ln_mix_b,
          w_up, conv_ffn_w, w_down, ln_ffn_g, ln_ffn_b):
    for l in range(DEPTH):
        if l % 2 == 0:
            i = l // 2
            mix = even_mixer(x, w_in_mix[i], conv_short[i], w_out_mix[i])
        else:
            mix = fourier_mixer(x, w_out_fourier[l // 2])
        x = layer_norm(ALPHA * x + mix, ln_mix_g[l], ln_mix_b[l])
        x = layer_norm(ALPHA * x + conv_ffn(x, w_up[l], conv_ffn_w[l], w_down[l]), ln_ffn_g[l], ln_ffn_b[l])
    return x


def setup_inputs(seed: int = 0) -> dict:
    key = jax.random.key(seed)
    ks = jax.random.split(key, 13)
    f32 = jnp.float32
    D = D_MODEL
    nrm = lambda k, shape, scale: jax.random.normal(k, shape, f32) * scale
    return {
        "x_prompt": jax.random.normal(ks[0], (BATCH, SEQ, D), f32),
        "x_sample": jax.random.normal(ks[1], (DEC_BATCH, DEC_SEQ, D), f32),
        "w_in_mix": nrm(ks[2], (N_EVEN, D, D_IN_MIX), D ** -0.5),
        "conv_short": nrm(ks[3], (N_EVEN, 3, CONV_CH), 3 ** -0.5),
        "w_out_mix": nrm(ks[4], (N_EVEN, CONV_CH + ATTN_W, D), BETA * (CONV_CH + ATTN_W) ** -0.5),
        "w_out_fourier": nrm(ks[5], (N_ODD, D, D), BETA * D ** -0.5),
        "ln_mix_g": 1.0 + nrm(ks[6], (DEPTH, D), 0.02),
        "ln_mix_b": nrm(ks[7], (DEPTH, D), 0.02),
        "w_up": nrm(ks[8], (DEPTH, D, 2 * D_FF), D ** -0.5),
        "conv_ffn_w": nrm(ks[9], (DEPTH, 3, 2 * D_FF), 3 ** -0.5),
        "w_down": nrm(ks[10], (DEPTH, D_FF, D), BETA * D_FF ** -0.5),
        "ln_ffn_g": 1.0 + nrm(ks[11], (DEPTH, D), 0.02),
        "ln_ffn_b": nrm(ks[12], (DEPTH, D), 0.02),
    }


def reference(x_prompt, x_sample, w_in_mix, conv_short, w_out_mix, w_out_fourier, ln_mix_g, ln_mix_b,
              w_up, conv_ffn_w, w_down, ln_ffn_g, ln_ffn_b):
    y_prompt = trunk(x_prompt, w_in_mix, conv_short, w_out_mix, w_out_fourier, ln_mix_g, ln_mix_b,
                     w_up, conv_ffn_w, w_down, ln_ffn_g, ln_ffn_b)
    y_sample = trunk(x_sample, w_in_mix, conv_short, w_out_mix, w_out_fourier, ln_mix_g, ln_mix_b,
                     w_up, conv_ffn_w, w_down, ln_ffn_g, ln_ffn_b)
    return (y_prompt, y_sample)
```

```cpp
#include <hip/hip_runtime.h>
#include <cstdio>
#include <cstdint>

#ifndef MK_ONE_LAUNCH
#define MK_ONE_LAUNCH 1
#endif

#define LAS __attribute__((address_space(3)))
#define GAS __attribute__((address_space(1)))
typedef _Float16 h16;
typedef _Float16 h16x8 __attribute__((ext_vector_type(8)));
typedef _Float16 h16x4 __attribute__((ext_vector_type(4)));
typedef _Float16 h16x2 __attribute__((ext_vector_type(2)));
typedef float f32x4 __attribute__((ext_vector_type(4)));
typedef float f32x2 __attribute__((ext_vector_type(2)));
typedef unsigned u32x4 __attribute__((ext_vector_type(4)));
typedef unsigned u32x2 __attribute__((ext_vector_type(2)));
typedef short s16x4 __attribute__((ext_vector_type(4)));

constexpr int D = 2048, SEQ = 2048, NSEQ = 24, M = NSEQ * SEQ;
constexpr int M_PROMPT = 16 * SEQ;
constexpr int CONV = 1024, ATT = 1024, NH = 8, HD = 128, DIN = 6144, FF = 5632, FF2 = 11264;
constexpr int NHALO = 2 * (M / 128);
constexpr float ALPHA = 1.6817928305074290861f;
constexpr float LN_EPS = 1e-5f;
constexpr float QSCALE = 0.08838834764831844055f * 1.44269504088896341f;

constexpr size_t MiB = 1u << 20;
constexpr size_t WS_CTL = 0, CTL_ZERO_BYTES = 256 * 1024;
constexpr size_t WS_ROPE = 1 * MiB;
constexpr size_t WS_VEC = 2 * MiB;
constexpr size_t WS_PART = 3 * MiB;
constexpr size_t WS_STATS = 19 * MiB;
constexpr size_t WS_LSE = 27 * MiB;
constexpr size_t WS_HALO = 32 * MiB;
constexpr size_t WS_FMAT = 66 * MiB;
constexpr size_t WS_DM = 82 * MiB;
constexpr size_t WS_WIN = 90 * MiB;
constexpr size_t WS_WOM = 138 * MiB;
constexpr size_t WS_WOF = 154 * MiB;
constexpr size_t WS_WUP = 170 * MiB;
constexpr size_t WS_WDN = 346 * MiB;
constexpr size_t WS_R2 = 434 * MiB;
constexpr size_t WS_R1 = 722 * MiB;
constexpr size_t WS_X8 = 1298 * MiB;
constexpr size_t WS_W8 = 1394 * MiB;
constexpr size_t WS_END = 1482 * MiB;
constexpr size_t WS_WDN8 = WS_WUP + 16 * MiB;
constexpr size_t WS_WIN8 = WS_WUP;
#ifndef I8MASK
#define I8MASK 0xF
#endif
constexpr unsigned kI8Mask = I8MASK;
constexpr size_t R1_HQKV = (size_t)M * 3072 * 2;
constexpr int BTP = 4096 + 64;
constexpr size_t R1_F = (size_t)NSEQ * 2048 * 4096 * 2;
constexpr int V_CSUM_IN = 0, V_BIAS_IN = V_CSUM_IN + 2 * DIN, V_CSUM_UP = V_BIAS_IN + 2 * DIN, V_BIAS_UP = V_CSUM_UP + 4 * FF2,
              V_CSUM_D = V_BIAS_UP + 4 * FF2, V_BIAS_D = V_CSUM_D + 2 * 4 * 1024, V_ONES = V_BIAS_D + 2 * 4 * 1024, V_ZEROS = V_ONES + D, V_END = V_ZEROS + D;
static_assert(V_END * 4 <= (int)MiB, "vector region");
constexpr int V_SW = 0;
constexpr int V_SX = 65536;
constexpr int V_SWQ = 4 * FF2;
constexpr int PM_STRIDE = 4 * FF2 + 2 * 3072;
constexpr int V_SWD = V_SWQ + 2 * 3072;
constexpr int V_SA = 131072;
static_assert(V_SWD + 4 * D <= V_SX && (V_SX + M) <= V_SA && (V_SA + M) * 4 <= (int)MiB, "scale vectors");
#ifndef D8MASK
#define D8MASK 0xE
#endif
constexpr unsigned kD8Mask = D8MASK;
static_assert(MK_ONE_LAUNCH || kD8Mask == 0u, "the activation-quantisation phase has no phase id of its own");
__host__ __device__ constexpr size_t part_off(int mi) { return mi < 2 ? (size_t)mi * 32 * 2 * DIN : (size_t)2 * 32 * 2 * DIN + (size_t)(mi - 2) * 32 * 2 * FF2; }
static_assert(part_off(6) * 4 <= 16 * MiB, "partial region");

constexpr int CW_BAR = 1024;
constexpr int CW_SMAX = 16384;
constexpr int LDS_BYTES = 147456;
constexpr int LDS_TAB = 131072;
constexpr int LDS_RED = 133120;
constexpr int LDS_MISC = LDS_BYTES - 128;
constexpr int ATT_K = 0, ATT_V = 65536;
static_assert(ATT_V + 272 * 256 <= LDS_MISC, "attention LDS");

__device__ __forceinline__ unsigned pk_h2(float lo, float hi) { f32x2 v = {lo, hi}; h16x2 h = __builtin_convertvector(v, h16x2); return __builtin_bit_cast(unsigned, h); }
__device__ __forceinline__ int mk_lane() { int l; asm volatile("v_mbcnt_lo_u32_b32 %0, -1, 0\n\tv_mbcnt_hi_u32_b32 %0, -1, %0" : "=v"(l)); return l; }
template <int O> __device__ __forceinline__ float shx(float v) {
    if constexpr (O < 32) return __builtin_bit_cast(float, __builtin_amdgcn_ds_swizzle(__builtin_bit_cast(int, v), (O << 10) | 0x1f));
    else return __builtin_bit_cast(float, __builtin_amdgcn_ds_bpermute((mk_lane() ^ 32) << 2, __builtin_bit_cast(int, v)));
}
template <int CTRL, int RM> __device__ __forceinline__ float dpp_f(float ident, float v) {
    return __builtin_bit_cast(float, __builtin_amdgcn_update_dpp(__builtin_bit_cast(int, ident), __builtin_bit_cast(int, v), CTRL, RM, 0xF, false));
}
__device__ __forceinline__ float wave_sum(float v) {
    v += dpp_f<0xB1, 0xF>(0.f, v); v += dpp_f<0x4E, 0xF>(0.f, v); v += dpp_f<0x141, 0xF>(0.f, v); v += dpp_f<0x140, 0xF>(0.f, v);
    v += dpp_f<0x142, 0xA>(0.f, v); v += dpp_f<0x143, 0xC>(0.f, v);
    return __builtin_bit_cast(float, __builtin_amdgcn_readlane(__builtin_bit_cast(int, v), 63));
}
__device__ __forceinline__ float wave_max(float v) {
    v = fmaxf(v, dpp_f<0xB1, 0xF>(0.f, v)); v = fmaxf(v, dpp_f<0x4E, 0xF>(0.f, v)); v = fmaxf(v, dpp_f<0x141, 0xF>(0.f, v)); v = fmaxf(v, dpp_f<0x140, 0xF>(0.f, v));
    v = fmaxf(v, dpp_f<0x142, 0xA>(0.f, v)); v = fmaxf(v, dpp_f<0x143, 0xC>(0.f, v));
    return __builtin_bit_cast(float, __builtin_amdgcn_readlane(__builtin_bit_cast(int, v), 63));
}
__device__ __forceinline__ void rot128(float (&v)[8], float s1, float s2, float s3, float s4) {
#pragma unroll
    for (int h = 1; h < 8; h <<= 1)
#pragma unroll
        for (int i = 0; i < 8; ++i) if ((i & h) == 0) { const float a = v[i], b = v[i + h]; v[i] = a + b; v[i + h] = a - b; }
    asm volatile(
        "s_nop 1\n\t"
        "v_fmac_f32_dpp %0, %0, %8 quad_perm:[1,0,3,2] row_mask:0xf bank_mask:0xf\n\t"
        "v_fmac_f32_dpp %1, %1, %8 quad_perm:[1,0,3,2] row_mask:0xf bank_mask:0xf\n\t"
        "v_fmac_f32_dpp %2, %2, %8 quad_perm:[1,0,3,2] row_mask:0xf bank_mask:0xf\n\t"
        "v_fmac_f32_dpp %3, %3, %8 quad_perm:[1,0,3,2] row_mask:0xf bank_mask:0xf\n\t"
        "v_fmac_f32_dpp %4, %4, %8 quad_perm:[1,0,3,2] row_mask:0xf bank_mask:0xf\n\t"
        "v_fmac_f32_dpp %5, %5, %8 quad_perm:[1,0,3,2] row_mask:0xf bank_mask:0xf\n\t"
        "v_fmac_f32_dpp %6, %6, %8 quad_perm:[1,0,3,2] row_mask:0xf bank_mask:0xf\n\t"
        "v_fmac_f32_dpp %7, %7, %8 quad_perm:[1,0,3,2] row_mask:0xf bank_mask:0xf\n\t"
        "v_fmac_f32_dpp %0, %0, %9 quad_perm:[2,3,0,1] row_mask:0xf bank_mask:0xf\n\t"
        "v_fmac_f32_dpp %1, %1, %9 quad_perm:[2,3,0,1] row_mask:0xf bank_mask:0xf\n\t"
        "v_fmac_f32_dpp %2, %2, %9 quad_perm:[2,3,0,1] row_mask:0xf bank_mask:0xf\n\t"
        "v_fmac_f32_dpp %3, %3, %9 quad_perm:[2,3,0,1] row_mask:0xf bank_mask:0xf\n\t"
        "v_fmac_f32_dpp %4, %4, %9 quad_perm:[2,3,0,1] row_mask:0xf bank_mask:0xf\n\t"
        "v_fmac_f32_dpp %5, %5, %9 quad_perm:[2,3,0,1] row_mask:0xf bank_mask:0xf\n\t"
        "v_fmac_f32_dpp %6, %6, %9 quad_perm:[2,3,0,1] row_mask:0xf bank_mask:0xf\n\t"
        "v_fmac_f32_dpp %7, %7, %9 quad_perm:[2,3,0,1] row_mask:0xf bank_mask:0xf\n\t"
        "v_fmac_f32_dpp %0, %0, %10 row_half_mirror row_mask:0xf bank_mask:0xf\n\t"
        "v_fmac_f32_dpp %1, %1, %10 row_half_mirror row_mask:0xf bank_mask:0xf\n\t"
        "v_fmac_f32_dpp %2, %2, %10 row_half_mirror row_mask:0xf bank_mask:0xf\n\t"
        "v_fmac_f32_dpp %3, %3, %10 row_half_mirror row_mask:0xf bank_mask:0xf\n\t"
        "v_fmac_f32_dpp %4, %4, %10 row_half_mirror row_mask:0xf bank_mask:0xf\n\t"
        "v_fmac_f32_dpp %5, %5, %10 row_half_mirror row_mask:0xf bank_mask:0xf\n\t"
        "v_fmac_f32_dpp %6, %6, %10 row_half_mirror row_mask:0xf bank_mask:0xf\n\t"
        "v_fmac_f32_dpp %7, %7, %10 row_half_mirror row_mask:0xf bank_mask:0xf\n\t"
        "v_fmac_f32_dpp %0, %0, %11 row_mirror row_mask:0xf bank_mask:0xf\n\t"
        "v_fmac_f32_dpp %1, %1, %11 row_mirror row_mask:0xf bank_mask:0xf\n\t"
        "v_fmac_f32_dpp %2, %2, %11 row_mirror row_mask:0xf bank_mask:0xf\n\t"
        "v_fmac_f32_dpp %3, %3, %11 row_mirror row_mask:0xf bank_mask:0xf\n\t"
        "v_fmac_f32_dpp %4, %4, %11 row_mirror row_mask:0xf bank_mask:0xf\n\t"
        "v_fmac_f32_dpp %5, %5, %11 row_mirror row_mask:0xf bank_mask:0xf\n\t"
        "v_fmac_f32_dpp %6, %6, %11 row_mirror row_mask:0xf bank_mask:0xf\n\t"
        "v_fmac_f32_dpp %7, %7, %11 row_mirror row_mask:0xf bank_mask:0xf\n\t"
        : "+v"(v[0]), "+v"(v[1]), "+v"(v[2]), "+v"(v[3]), "+v"(v[4]), "+v"(v[5]), "+v"(v[6]), "+v"(v[7])
        : "v"(s1), "v"(s2), "v"(s3), "v"(s4));
}
__device__ __forceinline__ u32x2 pack8_i8(float a0, float a1, float a2, float a3, float a4, float a5, float a6, float a7, float inv) {
    const unsigned b0 = __builtin_bit_cast(unsigned, __builtin_fmaf(a0, inv, 12582912.0f)), b1 = __builtin_bit_cast(unsigned, __builtin_fmaf(a1, inv, 12582912.0f)),
                   b2 = __builtin_bit_cast(unsigned, __builtin_fmaf(a2, inv, 12582912.0f)), b3 = __builtin_bit_cast(unsigned, __builtin_fmaf(a3, inv, 12582912.0f)),
                   b4 = __builtin_bit_cast(unsigned, __builtin_fmaf(a4, inv, 12582912.0f)), b5 = __builtin_bit_cast(unsigned, __builtin_fmaf(a5, inv, 12582912.0f)),
                   b6 = __builtin_bit_cast(unsigned, __builtin_fmaf(a6, inv, 12582912.0f)), b7 = __builtin_bit_cast(unsigned, __builtin_fmaf(a7, inv, 12582912.0f));
    u32x2 o;
    o.x = __builtin_amdgcn_perm(b1, b0, 0x0c0c0400u) | __builtin_amdgcn_perm(b3, b2, 0x04000c0cu);
    o.y = __builtin_amdgcn_perm(b5, b4, 0x0c0c0400u) | __builtin_amdgcn_perm(b7, b6, 0x04000c0cu);
    return o;
}
__device__ __forceinline__ float rowq_rot(const h16x8 (&in)[11], signed char* dst, int lane) {
    const float s1 = (lane & 1) ? -1.0f : 1.0f, s2 = (lane & 2) ? -1.0f : 1.0f, s3 = (lane & 4) ? -1.0f : 1.0f, s4 = (lane & 8) ? -1.0f : 1.0f;
    float v[11][8]; float amax = 0.f;
#pragma unroll
    for (int j = 0; j < 11; ++j) {
#pragma unroll
        for (int e = 0; e < 8; ++e) v[j][e] = (float)in[j][e];
        rot128(v[j], s1, s2, s3, s4);
#pragma unroll
        for (int e = 0; e < 8; ++e) amax = fmaxf(amax, fabsf(v[j][e]));
    }
    amax = wave_max(amax);
    const float inv = amax > 0.f ? 127.0f / amax : 0.f;
#pragma unroll
    for (int j = 0; j < 11; ++j) *(u32x2*)(dst + 512 * j + 8 * lane) = pack8_i8(v[j][0], v[j][1], v[j][2], v[j][3], v[j][4], v[j][5], v[j][6], v[j][7], inv);
    return amax * (1.0f / 127.0f);
}
#define LDS_FENCE_BAR() do { asm volatile("s_waitcnt lgkmcnt(0)" ::: "memory"); __builtin_amdgcn_s_barrier(); asm volatile("" ::: "memory"); } while (0)

#define XB_TMO      128
#define XB_XCNT(j)  (256  + 64 * (j))
#define XB_XSUB(j)  (1280 + 64 * (j))
#define XB_XGEN(j)  (2304 + 64 * (j))
#define XB_TOP      3328
#define XB_TOPGEN   3392
#define XCD_BAR_WORDS 3456
#define XB_SPIN_CAP (1u << 22)
static_assert(kI8Mask == 0xFu, "WS_WIN8 lives in the fp16 up-weight region");
static_assert(CW_BAR + XCD_BAR_WORDS <= CW_SMAX && (CW_SMAX + 4 * FF2) * 4 <= (int)CTL_ZERO_BYTES, "control words inside the memset region");
__device__ __forceinline__ unsigned xb_ld(unsigned* p)              { return __hip_atomic_load(p, __ATOMIC_RELAXED, __HIP_MEMORY_SCOPE_AGENT); }
__device__ __forceinline__ unsigned xb_add(unsigned* p, unsigned v) { return __hip_atomic_fetch_add(p, v, __ATOMIC_RELAXED, __HIP_MEMORY_SCOPE_AGENT); }
__device__ __forceinline__ unsigned xb_xcc_id() { return (unsigned)__builtin_amdgcn_s_getreg((3 << 11) | 20) & 0xFu; }
#define XB_SPIN(cond, bar) do { unsigned _sp = 0; while (cond) { __builtin_amdgcn_s_sleep(1); \
    if ((++_sp & 255u) == 0u) { if (xb_ld(&(bar)[XB_TMO])) break; if (_sp > XB_SPIN_CAP) { atomicAdd(&(bar)[XB_TMO], 1u); break; } } } } while (0)
struct XcdBarrier { unsigned* bar; unsigned x; volatile LAS unsigned* st; int w; };
__device__ __forceinline__ XcdBarrier xcd_barrier_post(unsigned* bar, volatile LAS unsigned* st) {
    XcdBarrier b; b.bar = bar; b.x = xb_xcc_id(); b.st = st; b.w = 0;
    if (threadIdx.x == 0) (void)xb_add(&bar[XB_XCNT(b.x)], 1u);
    return b;
}
__device__ __forceinline__ void xcd_barrier_complete(unsigned* bar, unsigned x, unsigned& nloc, unsigned& nx) {
    const unsigned G = gridDim.x * gridDim.y * gridDim.z;
    unsigned sum, cnt, mine, sp = 0u;
    for (;;) {
        sum = 0u; cnt = 0u; mine = 0u;
#pragma unroll
        for (unsigned j = 0; j < 16; ++j) { const unsigned c = xb_ld(&bar[XB_XCNT(j)]); sum += c; cnt += (c > 0u) ? 1u : 0u; mine = (j == x) ? c : mine; }
        if (sum == G) break;
        __builtin_amdgcn_s_sleep(1);
        if ((++sp & 255u) == 0u) { if (xb_ld(&bar[XB_TMO])) break; if (sp > XB_SPIN_CAP) { atomicAdd(&bar[XB_TMO], 1u); break; } }
    }
    nloc = mine > 0u ? mine : 1u; nx = cnt > 0u ? cnt : 1u;
}
__device__ __forceinline__ void xcd_barrier(const XcdBarrier& b) {
    asm volatile("s_waitcnt vmcnt(0)" ::: "memory");
    __syncthreads();
    if (b.w == 0 && mk_lane() == 0) {
        unsigned* bar = b.bar;
        __builtin_amdgcn_s_waitcnt(0);
        unsigned nloc = b.st[0], nx = b.st[1];
        if (nloc == 0u) { xcd_barrier_complete(bar, b.x, nloc, nx); b.st[0] = nloc; b.st[1] = nx; }
        const unsigned old = xb_add(&bar[XB_XSUB(b.x)], 1u);
        const unsigned gen = old / nloc;
        if (old + 1u == (gen + 1u) * nloc) {
            __builtin_amdgcn_fence(__ATOMIC_RELEASE, "agent");
            asm volatile("s_waitcnt vmcnt(0)" ::: "memory");
            const unsigned og = xb_add(&bar[XB_TOP], 1u);
            const unsigned tg = og / nx;
            if (og + 1u == (tg + 1u) * nx) xb_add(&bar[XB_TOPGEN], 1u);
            else XB_SPIN(xb_ld(&bar[XB_TOPGEN]) == tg, bar);
            __builtin_amdgcn_fence(__ATOMIC_ACQUIRE, "agent");
            xb_add(&bar[XB_XGEN(b.x)], 1u);
            asm volatile("s_waitcnt vmcnt(0)" ::: "memory");
        } else {
            XB_SPIN(xb_ld(&bar[XB_XGEN(b.x)]) == gen, bar);
            __builtin_amdgcn_fence(__ATOMIC_ACQUIRE, "agent");
            asm volatile("s_waitcnt vmcnt(0)" ::: "memory");
        }
    }
    __syncthreads();
}

namespace pg8 {
constexpr int BM = 256, BK = 64, HALF = 128, HTB = HALF * BK * 2, STAGE_BYTES = 8 * HTB, NXCD = 8, WGM = 4;
__device__ __forceinline__ int lds_byte(int r, int c) { const int st = (r >> 4) * 2 + (c >> 5), rr = r & 15, cc = c & 31, ob = rr * 64 + cc * 2; return st * 1024 + (ob ^ (((ob >> 9) & 1) << 5)); }
__device__ __forceinline__ void stage_rc(int b, int& R, int& C) { const int st = b / 1024, sb = b % 1024, swz = sb ^ (((sb >> 9) & 1) << 5); R = (st >> 1) * 16 + swz / 64; C = (st & 1) * 32 + (swz % 64) / 2; }
__device__ __forceinline__ int perm32(int rho) { const int n = rho >> 4, i = rho & 15; return 8 * (i >> 2) + 4 * n + (i & 3); }
struct Unit { int pm, pn, g; int part, keep; };
typedef f32x4 Acc[2][2][4][2];
__device__ __forceinline__ void glds16_s(const void* sbase, unsigned voff, unsigned lds_dst) {
    unsigned keep;
    asm volatile("s_mov_b32 %0, m0\n\ts_mov_b32 m0, %3\n\ts_nop 0\n\tglobal_load_lds_dwordx4 %1, %2\n\ts_mov_b32 m0, %0" : "=&s"(keep) : "v"(voff), "s"(sbase), "s"(lds_dst) : "memory");
}

struct StaticOrder {
    int nM, nN, nwg, G, c;
    __device__ void init(int nM_, int nN_, int G_, int c_) { nM = nM_; nN = nN_; nwg = nM * nN; G = G_; c = c_; }
    __device__ bool next(int i, Unit& u) const {
        const long L = (long)i * G + c; if (L >= nwg) return false;
        int wgid = (int)L; { const int q = nwg / NXCD, r = nwg % NXCD, xcd = wgid % NXCD, off = wgid / NXCD; wgid = (xcd < r ? xcd * (q + 1) : r * (q + 1) + (xcd - r) * q) + off; }
        const int nig = WGM * nN, gid = wgid / nig, fm = gid * WGM, gsz = (nM - fm) < WGM ? (nM - fm) : WGM;
        u.pm = fm + ((wgid % nig) % gsz); u.pn = (wgid % nig) / gsz; u.g = 0; u.part = 0; u.keep = 0; return true;
    }
};

typedef int i32x4 __attribute__((ext_vector_type(4)));
template <bool I8> __device__ __forceinline__ f32x4 mma_step(const h16x8& b, const h16x8& a, const f32x4& c) {
    if constexpr (I8) return __builtin_bit_cast(f32x4, __builtin_amdgcn_mfma_i32_16x16x64_i8(__builtin_bit_cast(i32x4, b), __builtin_bit_cast(i32x4, a), __builtin_bit_cast(i32x4, c), 0, 0, 0));
    else return __builtin_amdgcn_mfma_f32_16x16x32_f16(b, a, c, 0, 0, 0);
}
template <class Prob, class Epi, bool I8 = false, bool ALIGN_EPI = true, bool SP2 = true>
__device__ __forceinline__ void gemm_phase(LAS unsigned char* lds, int wave, const Prob& P, const Epi& E) {
    const int tid_ = wave * 64 + mk_lane();
    const int tid = tid_, wid = __builtin_amdgcn_readfirstlane(tid >> 6), lane = tid & 63, wr = wid >> 2, wc = wid & 3, fr = lane & 15, fq = lane >> 4;
    const int K = P.K, nt = K / BK;
    unsigned voffA[2], voffB[2];
#pragma unroll
    for (int i = 0; i < 2; ++i) { int R, C; stage_rc(tid * 16 + i * 8192, R, C); const int Rb = (R & ~31) + perm32(R & 31);
        voffA[i] = P.a_rowoff(R) + (unsigned)C * 2u; voffB[i] = P.b_rowoff(Rb) + (unsigned)C * 2u; }
    const size_t kstep = (size_t)(BK * 2);
    const size_t hstepA = P.a_hstep(), hstepB = P.b_hstep();
    const unsigned ldsw = (unsigned)wid * 1024u;
    const unsigned ldsb = (unsigned)(size_t)lds + ldsw;
    const int aoff = lds_byte(wr * 64 + fr, fq * 8), boff = lds_byte(wc * 32 + fr, fq * 8);
#define PG8_SA(b, h) (((b) * 2 + (h)) * HTB)
#define PG8_SB(b, h) ((4 + (b) * 2 + (h)) * HTB)
#define PG8_STAGE(bufoff, gbase, voff) do { _Pragma("unroll") for (int _i = 0; _i < 2; ++_i) glds16_s((gbase), (voff)[_i], ldsb + (unsigned)((bufoff) + _i * 8192)); } while (0)
#define PG8_LDA(dst, b, h) do { _Pragma("unroll") for (int m = 0; m < 4; ++m) _Pragma("unroll") for (int k = 0; k < 2; ++k) dst[m][k] = *(const LAS h16x8*)(lds + PG8_SA(b, h) + aoff + m * 2048 + k * 1024); } while (0)
#define PG8_LDB(dst, b, h) do { _Pragma("unroll") for (int n = 0; n < 2; ++n) _Pragma("unroll") for (int k = 0; k < 2; ++k) dst[n][k] = *(const LAS h16x8*)(lds + PG8_SB(b, h) + boff + n * 2048 + k * 1024); } while (0)
#define PG8_MMA(ai, bj, At, Bt) do { __builtin_amdgcn_s_setprio(1); _Pragma("unroll") for (int m = 0; m < 4; ++m) _Pragma("unroll") for (int n = 0; n < 2; ++n) _Pragma("unroll") for (int k = 0; k < 2; ++k) \
        acc[ai][bj][m][n] = mma_step<I8>(Bt[n][k], At[m][k], acc[ai][bj][m][n]); __builtin_amdgcn_s_setprio(0); } while (0)
#define PG8_WAIT_V(n) asm volatile("s_waitcnt vmcnt(" #n ")" ::: "memory")
#define PG8_WAIT_L(n) asm volatile("s_waitcnt lgkmcnt(" #n ")" ::: "memory")
#define PG8_BAR __builtin_amdgcn_s_barrier()
#define PG8_SCHED __builtin_amdgcn_sched_barrier(0)
    Unit cur, nxt; int ui = 0;
    if (!P.next(0, cur)) return;
    Acc acc;
#pragma unroll
    for (int a = 0; a < 2; ++a)
#pragma unroll
        for (int b = 0; b < 2; ++b)
#pragma unroll
            for (int m = 0; m < 4; ++m)
#pragma unroll
                for (int n = 0; n < 2; ++n) acc[a][b][m][n] = (f32x4){0.f, 0.f, 0.f, 0.f};
    h16x8 At[4][2], B0[2][2], B1[2][2];
    const char* cA = P.a_tile(cur); const char* cB = P.b_tile(cur);
    if constexpr (SP2) {
        PG8_STAGE(PG8_SB(0, 0), cB, voffB); PG8_STAGE(PG8_SB(0, 1), cB + hstepB, voffB); PG8_STAGE(PG8_SA(0, 0), cA, voffA); PG8_STAGE(PG8_SA(0, 1), cA + hstepA, voffA);
        if (wr == 1) PG8_BAR;
        PG8_WAIT_V(2); PG8_BAR;
        PG8_STAGE(PG8_SB(1, 0), cB + kstep, voffB); PG8_STAGE(PG8_SA(1, 0), cA + kstep, voffA); PG8_STAGE(PG8_SB(1, 1), cB + hstepB + kstep, voffB);
        PG8_WAIT_V(6); PG8_BAR;
    } else {
        PG8_STAGE(PG8_SB(0, 0), cB, voffB); PG8_STAGE(PG8_SA(0, 0), cA, voffA); PG8_STAGE(PG8_SB(0, 1), cB + hstepB, voffB); PG8_STAGE(PG8_SA(0, 1), cA + hstepA, voffA);
        if (wr == 1) PG8_BAR;
        PG8_WAIT_V(4); PG8_BAR;
        PG8_STAGE(PG8_SB(1, 0), cB + kstep, voffB); PG8_STAGE(PG8_SA(1, 0), cA + kstep, voffA); PG8_STAGE(PG8_SB(1, 1), cB + hstepB + kstep, voffB);
        PG8_WAIT_V(6); PG8_BAR;
    }
    for (;;) {
        const bool has_next = P.next(ui + 1, nxt);
        const char* nA = has_next ? P.a_tile(nxt) : cA; const char* nB = has_next ? P.b_tile(nxt) : cB;
        for (int t = 0; t < nt; t += 2) {
            const bool last = (t == nt - 2);
            const char* a1 = cA + (size_t)(t + 1) * kstep;
            const char* a2 = last ? nA : cA + (size_t)(t + 2) * kstep; const char* b2 = last ? nB : cB + (size_t)(t + 2) * kstep;
            const char* a3 = a2 + kstep; const char* b3 = b2 + kstep;
            if constexpr (SP2) {
            PG8_LDB(B0, 0, 0); PG8_LDB(B1, 0, 1); PG8_SCHED; PG8_LDA(At, 0, 0); PG8_STAGE(PG8_SA(1, 1), a1 + hstepA, voffA);
            PG8_WAIT_V(8); PG8_WAIT_L(0); PG8_BAR; PG8_MMA(0, 0, At, B0); PG8_MMA(0, 1, At, B1); PG8_BAR; PG8_SCHED;
            PG8_LDA(At, 0, 1); PG8_STAGE(PG8_SB(0, 0), b2, voffB); PG8_STAGE(PG8_SB(0, 1), b2 + hstepB, voffB); PG8_STAGE(PG8_SA(0, 0), a2, voffA);
            PG8_WAIT_V(8); PG8_WAIT_L(0); PG8_BAR; PG8_MMA(1, 0, At, B0); PG8_MMA(1, 1, At, B1); PG8_BAR; PG8_SCHED;
            PG8_LDB(B0, 1, 0); PG8_LDB(B1, 1, 1); PG8_SCHED; PG8_LDA(At, 1, 0); PG8_STAGE(PG8_SA(0, 1), a2 + hstepA, voffA);
            PG8_WAIT_V(8); PG8_WAIT_L(0); PG8_BAR; PG8_MMA(0, 0, At, B0); PG8_MMA(0, 1, At, B1); PG8_BAR; PG8_SCHED;
            PG8_LDA(At, 1, 1); PG8_STAGE(PG8_SB(1, 0), b3, voffB); PG8_STAGE(PG8_SB(1, 1), b3 + hstepB, voffB); PG8_STAGE(PG8_SA(1, 0), a3, voffA);
            PG8_WAIT_V(8); PG8_WAIT_L(0); PG8_BAR; PG8_MMA(1, 0, At, B0); PG8_MMA(1, 1, At, B1); PG8_BAR; PG8_SCHED;
            } else {
            PG8_LDB(B0, 0, 0); PG8_SCHED; PG8_LDA(At, 0, 0); PG8_STAGE(PG8_SA(1, 1), a1 + hstepA, voffA);
            PG8_WAIT_L(8); PG8_BAR; PG8_WAIT_L(0); PG8_MMA(0, 0, At, B0); PG8_BAR; PG8_SCHED;
            PG8_LDB(B1, 0, 1); PG8_STAGE(PG8_SB(0, 0), b2, voffB);
            PG8_BAR; PG8_WAIT_L(0); PG8_MMA(0, 1, At, B1); PG8_BAR;
            PG8_LDA(At, 0, 1); PG8_STAGE(PG8_SA(0, 0), a2, voffA);
            PG8_BAR; PG8_WAIT_L(0); PG8_MMA(1, 0, At, B0); PG8_BAR; PG8_SCHED;
            PG8_STAGE(PG8_SB(0, 1), b2 + hstepB, voffB);
            PG8_WAIT_V(6); PG8_BAR; PG8_MMA(1, 1, At, B1); PG8_BAR;
            PG8_LDB(B0, 1, 0); PG8_SCHED; PG8_LDA(At, 1, 0); PG8_STAGE(PG8_SA(0, 1), a2 + hstepA, voffA);
            PG8_WAIT_L(8); PG8_BAR; PG8_WAIT_L(0); PG8_MMA(0, 0, At, B0); PG8_BAR; PG8_SCHED;
            PG8_LDB(B1, 1, 1); PG8_STAGE(PG8_SB(1, 0), b3, voffB);
            PG8_BAR; PG8_WAIT_L(0); PG8_MMA(0, 1, At, B1); PG8_BAR;
            PG8_LDA(At, 1, 1); PG8_STAGE(PG8_SA(1, 0), a3, voffA);
            PG8_BAR; PG8_WAIT_L(0); PG8_MMA(1, 0, At, B0); PG8_BAR; PG8_SCHED;
            PG8_STAGE(PG8_SB(1, 1), b3 + hstepB, voffB);
            PG8_WAIT_V(6); PG8_BAR; PG8_MMA(1, 1, At, B1); PG8_BAR;
            }
        }
        if constexpr (ALIGN_EPI) { if (wr == 0) PG8_BAR; }
        { const int l_tid = wave * 64 + mk_lane();
          const int l_lane = l_tid & 63; E(acc, cur, wr, wc, l_lane & 15, l_lane >> 4, lds, l_tid); }
        if (!has_next) break;
        if (!cur.keep) {
#pragma unroll
        for (int a = 0; a < 2; ++a)
#pragma unroll
            for (int b = 0; b < 2; ++b)
#pragma unroll
                for (int m = 0; m < 4; ++m)
#pragma unroll
                    for (int n = 0; n < 2; ++n) acc[a][b][m][n] = (f32x4){0.f, 0.f, 0.f, 0.f};
        }
        cur = nxt; cA = nA; cB = nB; ++ui;
        if constexpr (ALIGN_EPI) { if (wr == 1) PG8_BAR; }
    }
    PG8_WAIT_V(0);
    if constexpr (!ALIGN_EPI) { if (wr == 0) PG8_BAR; }
    PG8_BAR;
#undef PG8_SA
#undef PG8_SB
#undef PG8_STAGE
#undef PG8_LDA
#undef PG8_LDB
#undef PG8_MMA
#undef PG8_WAIT_V
#undef PG8_WAIT_L
#undef PG8_BAR
#undef PG8_SCHED
}
}
using pg8::Unit; using pg8::Acc;

struct ProbStd {
    const char* A; const char* B; int K, lda, ldb; bool upmap; pg8::StaticOrder S;
    __device__ bool next(int i, Unit& u) const { return S.next(i, u); }
    __device__ const char* a_tile(const Unit& u) const { return A + (size_t)u.pm * 256 * lda * 2; }
    __device__ const char* b_tile(const Unit& u) const { return B + (size_t)u.pn * 256 * ldb * 2; }
    __device__ unsigned a_rowoff(int R) const { const int r = upmap ? (128 * (R >> 6) + 8 * (R & 15) + ((R >> 4) & 3)) : R; return (unsigned)r * (unsigned)lda * 2u; }
    __device__ unsigned b_rowoff(int R) const { return (unsigned)R * (unsigned)ldb * 2u; }
    __device__ size_t a_hstep() const { return (size_t)(upmap ? 4 : 128) * lda * 2; }
    __device__ size_t b_hstep() const { return (size_t)128 * ldb * 2; }
};
struct ProbHalo {
    const char* A; const char* B; int K, lda, ldb; int G, c;
    __device__ bool next(int i, Unit& u) const { const int L = i * G + c; if (L >= 3 * 44) return false; u.pm = L % 3; u.pn = L / 3; u.g = 0; u.part = 0; u.keep = 0; return true; }
    __device__ const char* a_tile(const Unit& u) const { return A + ((long)64 * 256 * u.pm - 1) * (long)lda * 2; }
    __device__ const char* b_tile(const Unit& u) const { return B + (size_t)u.pn * 256 * ldb * 2; }
    __device__ unsigned a_rowoff(int R) const { return (unsigned)(64 * R + 65 * (R & 1)) * (unsigned)lda * 2u; }
    __device__ unsigned b_rowoff(int R) const { return (unsigned)R * (unsigned)ldb * 2u; }
    __device__ size_t a_hstep() const { return (size_t)64 * 128 * lda * 2; }
    __device__ size_t b_hstep() const { return (size_t)128 * ldb * 2; }
};
struct ProbDftC {
    const char* Dm; const char* zb; int G, c;
    static constexpr int K = 512;
    __device__ bool next(int i, Unit& u) const { const int L0 = i * G + c; if (L0 >= 1536) return false; const int L = (L0 % 8) * 192 + L0 / 8;
        u.pm = L & 1; u.g = (L >> 1) & 3; u.pn = L >> 3; u.part = 0; u.keep = 0; return true; }
    __device__ const char* a_tile(const Unit& u) const { return Dm + (size_t)u.pm * 512 * 512 * 2; }
    __device__ const char* b_tile(const Unit& u) const { return zb + ((size_t)u.pn * 256 * D + 512 * u.g) * 2; }
    __device__ unsigned a_rowoff(int R) const { return (unsigned)R * 512u * 2u; }
    __device__ unsigned b_rowoff(int R) const { return (unsigned)R * (unsigned)D * 2u; }
    __device__ size_t a_hstep() const { return (size_t)128 * 512 * 2; }
    __device__ size_t b_hstep() const { return (size_t)128 * D * 2; }
};
struct ProbDftS {
    const char* Fmat; const char* Bt; int G, c;
    static constexpr int K = 2048;
    __device__ bool next(int i, Unit& u) const { const int L0 = (i >> 1) * G + c; if (L0 >= 384) return false;
        const int L = (L0 % 8) * 48 + L0 / 8; u.pn = L & 3; u.pm = (L >> 2) & 3; u.g = L >> 4; u.part = i & 1; u.keep = (i & 1) ^ 1; return true; }
    __device__ const char* a_tile(const Unit& u) const { return Fmat + ((size_t)u.pm * 256 * 4096 + (size_t)u.part * 2048) * 2; }
    __device__ const char* b_tile(const Unit& u) const { return Bt + (((size_t)u.g * 1024 + (size_t)u.pn * 256) * BTP + (size_t)u.part * 2048) * 2; }
    __device__ unsigned a_rowoff(int R) const { return (unsigned)R * 4096u * 2u; }
    __device__ unsigned b_rowoff(int R) const { return (unsigned)R * (unsigned)BTP * 2u; }
    __device__ size_t a_hstep() const { return (size_t)128 * 4096 * 2; }
    __device__ size_t b_hstep() const { return (size_t)128 * BTP * 2; }
};

__device__ __forceinline__ void store_h8(h16* p, const f32x4& v0, const f32x4& v1) {
    u32x4 w; w.x = pk_h2(v0[0], v0[1]); w.y = pk_h2(v0[2], v0[3]); w.z = pk_h2(v1[0], v1[1]); w.w = pk_h2(v1[2], v1[3]);
    *(u32x4*)p = w;
}

__device__ __forceinline__ f32x4 ldf4(const float* base, unsigned idx) { return *(const f32x4*)((const char*)base + (idx << 2)); }
struct EpiIn {
    h16* Hc; h16* Hq; const float* ropec; const float* ropes;
    __device__ __forceinline__ void operator()(Acc& acc, const Unit& u, int wr, int wc, int fr, int fq, LAS unsigned char* lds, int tid) const {
        const unsigned row0 = u.pm * 256, pn = u.pn, colt = pn * 256 + wc * 32 + 8 * fq;
        const bool rope = (pn >= 12 && pn < 20);
        const float sc = (pn >= 12 && pn < 16) ? QSCALE : 1.0f;
#pragma unroll
        for (int ai = 0; ai < 2; ++ai)
#pragma unroll
            for (int m = 0; m < 4; ++m) {
                const unsigned row = row0 + ai * 128 + wr * 64 + m * 16 + fr;
                if (rope) {
                    const unsigned t = row & (SEQ - 1), d0 = 32 * (wc & 1) + 8 * fq;
                    const float* cp = ropec + t * 64 + d0; const float* sp = ropes + t * 64 + d0;
                    f32x4 v[2][2];
#pragma unroll
                    for (int n = 0; n < 2; ++n) { const f32x4 c = *(const f32x4*)(cp + 4 * n), s = *(const f32x4*)(sp + 4 * n);
                        const f32x4 x1 = acc[ai][0][m][n], x2 = acc[ai][1][m][n];
                        v[0][n] = (x1 * c - x2 * s) * sc; v[1][n] = (x2 * c + x1 * s) * sc; }
                    h16* o = Hq + (size_t)row * 3072 + (256 * (pn - 12) + 128 * (wc >> 1) + d0);
                    store_h8(o, v[0][0], v[0][1]); store_h8(o + 64, v[1][0], v[1][1]);
                } else {
                    if (pn >= 4 && pn < 12) {
                        store_h8(Hc + (size_t)row * 3072 + 1024 + (pn - 4) * 128 + wc * 32 + 8 * fq, acc[ai][0][m][0] * acc[ai][1][m][0], acc[ai][0][m][1] * acc[ai][1][m][1]);
                    } else {
                    h16* o = (pn < 12) ? (Hc + (size_t)row * 3072 + colt) : (Hq + (size_t)row * 3072 + (colt - 3072));
                    store_h8(o, acc[ai][0][m][0], acc[ai][0][m][1]); store_h8(o + 128, acc[ai][1][m][0], acc[ai][1][m][1]); }
                }
                asm volatile("" ::: "memory");
            }
    }
};

struct EpiInQ {
    h16* Hq; const float* ropec; const float* ropes; const float* sx; const float* sw;
    __device__ __forceinline__ void operator()(Acc& acc, const Unit& u, int wr, int wc, int fr, int fq, LAS unsigned char* lds, int tid) const {
        const unsigned row0 = u.pm * 256, pn = u.pn, colt = pn * 256 + wc * 32 + 8 * fq;
        const bool rope = pn < 8;
        const float sc = pn < 4 ? QSCALE : 1.0f;
        f32x4 swv[2][2];
#pragma unroll
        for (int bj = 0; bj < 2; ++bj)
#pragma unroll
            for (int n = 0; n < 2; ++n) swv[bj][n] = ldf4(sw, colt + 128u * bj + 4u * n) * sc;
#pragma unroll
        for (int ai = 0; ai < 2; ++ai)
#pragma unroll
            for (int m = 0; m < 4; ++m) {
                const unsigned row = row0 + ai * 128 + wr * 64 + m * 16 + fr;
                const float rs = *(const float*)((const char*)sx + (row << 2));
                f32x4 x[2][2];
#pragma unroll
                for (int bj = 0; bj < 2; ++bj)
#pragma unroll
                    for (int n = 0; n < 2; ++n) { const pg8::i32x4 iv = __builtin_bit_cast(pg8::i32x4, acc[ai][bj][m][n]); x[bj][n] = __builtin_convertvector(iv, f32x4) * (swv[bj][n] * rs); }
                if (rope) {
                    const unsigned t = row & (SEQ - 1), d0 = 32 * (wc & 1) + 8 * fq;
                    f32x4 v[2][2];
#pragma unroll
                    for (int n = 0; n < 2; ++n) { const f32x4 c = ldf4(ropec, t * 64 + d0 + 4u * n), s = ldf4(ropes, t * 64 + d0 + 4u * n);
                        v[0][n] = x[0][n] * c - x[1][n] * s; v[1][n] = x[1][n] * c + x[0][n] * s; }
                    h16* o = Hq + (size_t)row * 3072 + (256 * pn + 128 * (wc >> 1) + d0);
                    store_h8(o, v[0][0], v[0][1]); store_h8(o + 64, v[1][0], v[1][1]);
                } else {
                    h16* o = Hq + (size_t)row * 3072 + colt;
                    store_h8(o, x[0][0], x[0][1]); store_h8(o + 128, x[1][0], x[1][1]);
                }
                asm volatile("" ::: "memory");
            }
    }
};

template <bool LNX, bool I8 = false> struct EpiResT {
    h16* X; const float* stats; const float* g; const float* bta;
    const float* sa; const float* swd;
    __device__ __forceinline__ void operator()(Acc& acc, const Unit& u, int wr, int wc, int fr, int fq, LAS unsigned char* lds, int tid) const {
#pragma unroll
        for (int bj = 0; bj < 2; ++bj) {
            const unsigned colt = u.pn * 256 + 128u * bj + wc * 32 + 8 * fq;
            f32x4 ga[2], ba[2], cs[2];
            if constexpr (LNX) {
#pragma unroll
                for (int n = 0; n < 2; ++n) { ga[n] = ldf4(g, colt + 4u * n) * ALPHA; ba[n] = ldf4(bta, colt + 4u * n) * ALPHA; }
            }
            if constexpr (I8) {
#pragma unroll
                for (int n = 0; n < 2; ++n) cs[n] = ldf4(swd, colt + 4u * n);
            }
#pragma unroll
            for (int ai = 0; ai < 2; ++ai) {
                h16x8 xv[4];
                f32x2 st[4]; float rs[4];
#pragma unroll
                for (int m = 0; m < 4; ++m) { const unsigned row = u.pm * 256 + ai * 128 + wr * 64 + m * 16 + fr; xv[m] = *(const h16x8*)(X + (size_t)row * D + colt);
                    if constexpr (LNX) st[m] = *(const f32x2*)((const char*)stats + (row << 3));
                    if constexpr (I8) rs[m] = *(const float*)((const char*)sa + (row << 2)); }
                asm volatile("" ::: "memory");
#pragma unroll
                for (int m = 0; m < 4; ++m) {
                    const unsigned row = u.pm * 256 + ai * 128 + wr * 64 + m * 16 + fr;
                    f32x4 z[2];
#pragma unroll
                    for (int n = 0; n < 2; ++n) {
                        f32x4 a = acc[ai][bj][m][n];
                        if constexpr (I8) { const pg8::i32x4 iv = __builtin_bit_cast(pg8::i32x4, a); a = __builtin_convertvector(iv, f32x4) * (cs[n] * rs[m]); }
#pragma unroll
                        for (int e = 0; e < 4; ++e) {
                            if constexpr (LNX) { const float t = ((float)xv[m][4 * n + e] - st[m].x) * st[m].y; z[n][e] = t * ga[n][e] + (ba[n][e] + a[e]); }
                            else z[n][e] = (float)xv[m][4 * n + e] * ALPHA + a[e]; }
                    }
                    store_h8(X + (size_t)row * D + colt, z[0], z[1]);
                }
                asm volatile("" ::: "memory");
            }
        }
    }
};
typedef EpiResT<false> EpiRes;

template <bool I8> struct EpiHalo {
    float* HALO; const float* sx; const float* sw;
    __device__ __forceinline__ void operator()(Acc& acc, const Unit& u, int wr, int wc, int fr, int fq, LAS unsigned char* lds, int tid) const {
        const unsigned h0 = u.pm * 256, colt = u.pn * 256 + wc * 32 + 8 * fq;
        if constexpr (I8) {
#pragma unroll
            for (int ai = 0; ai < 2; ++ai)
#pragma unroll
                for (int m = 0; m < 4; ++m) { const int hidx = (int)(h0 + ai * 128 + wr * 64 + m * 16 + fr); int tok = 64 * hidx + 65 * (hidx & 1) - 1; tok = tok < 0 ? 0 : (tok >= M ? M - 1 : tok);
                    const float rs = sx[tok];
#pragma unroll
                    for (int bj = 0; bj < 2; ++bj)
#pragma unroll
                        for (int n = 0; n < 2; ++n) { const pg8::i32x4 iv = __builtin_bit_cast(pg8::i32x4, acc[ai][bj][m][n]); acc[ai][bj][m][n] = __builtin_convertvector(iv, f32x4) * rs; } } }
#pragma unroll
        for (int ai = 0; ai < 2; ++ai)
#pragma unroll
            for (int m = 0; m < 4; ++m) {
                const unsigned rl = ai * 128 + wr * 64 + m * 16 + fr;
                float* o = HALO + (size_t)(h0 + rl) * FF2 + colt;
#pragma unroll
                for (int bj = 0; bj < 2; ++bj)
#pragma unroll
                    for (int n = 0; n < 2; ++n) *(f32x4*)(o + bj * 128 + 4 * n) = acc[ai][bj][m][n];
            }
    }
};

__device__ __forceinline__ float dpp_shr1(float oldv, float src) {
    return __builtin_bit_cast(float, __builtin_amdgcn_update_dpp(__builtin_bit_cast(int, oldv), __builtin_bit_cast(int, src), 0x111, 0xf, 0xf, false));
}
__device__ __forceinline__ float dpp_shl1(float oldv, float src) {
    return __builtin_bit_cast(float, __builtin_amdgcn_update_dpp(__builtin_bit_cast(int, oldv), __builtin_bit_cast(int, src), 0x101, 0xf, 0xf, false));
}
__device__ __forceinline__ float silu_f(float x) { return x * __builtin_amdgcn_rcpf(1.0f + __expf(-x)); }

template <bool I8> struct EpiUp {
    h16* ACT; const float* HALO; const float* cw;
    const float* sx; const float* sw;
    __device__ __forceinline__ void operator()(Acc& acc, const Unit& u, int wr, int wc, int fr, int fq, LAS unsigned char* lds, int tid) const {
        const unsigned tok0 = u.pm * 256;
        const unsigned tl0 = 128 * wr + 8 * fr;
        if constexpr (I8) {
#pragma unroll
            for (int ai = 0; ai < 2; ++ai) { const f32x4 sa = ldf4(sx, tok0 + tl0 + 4u * ai);
#pragma unroll
                for (int m = 0; m < 4; ++m)
#pragma unroll
                    for (int bj = 0; bj < 2; ++bj)
#pragma unroll
                        for (int n = 0; n < 2; ++n) { const pg8::i32x4 iv = __builtin_bit_cast(pg8::i32x4, acc[ai][bj][m][n]); acc[ai][bj][m][n] = __builtin_convertvector(iv, f32x4) * sa[m]; }
                asm volatile("" ::: "memory"); }
        }
        const unsigned bk = 2 * u.pm + wr;
        const bool lvalid = (bk & 15) != 0, rvalid = (bk & 15) != 15;
#pragma unroll
        for (int bj = 0; bj < 2; ++bj) {
            const unsigned colp = u.pn * 256 + bj * 128 + wc * 32 + 8 * fq;
            const unsigned coll = bj * FF + u.pn * 128 + wc * 32 + 8 * fq;
#pragma unroll
            for (int n = 0; n < 2; ++n) {
                f32x4 c0 = ldf4(cw, coll + 4u * n), c1 = ldf4(cw, (unsigned)FF2 + coll + 4u * n), c2 = ldf4(cw, 2u * FF2 + coll + 4u * n);
                if constexpr (I8) { const f32x4 swv = ldf4(sw, colp + 4u * n); c0 = c0 * swv; c1 = c1 * swv; c2 = c2 * swv; }
                f32x4 hl = {0.f, 0.f, 0.f, 0.f}, hr = {0.f, 0.f, 0.f, 0.f};
                if (fr == 0 && lvalid) hl = ldf4(HALO, (2u * bk) * (unsigned)FF2 + colp + 4u * n);
                if (fr == 15 && rvalid) hr = ldf4(HALO, (2u * bk + 1u) * (unsigned)FF2 + colp + 4u * n);
#pragma unroll
                for (int e = 0; e < 4; ++e) {
                    const float prev = dpp_shr1(hl[e], acc[1][bj][3][n][e]);
                    const float next = dpp_shl1(hr[e], acc[0][bj][0][n][e]);
                    float left = prev;
#pragma unroll
                    for (int j = 0; j < 8; ++j) {
                        const float cur = acc[j >> 2][bj][j & 3][n][e];
                        const float nx = (j < 7) ? acc[(j + 1) >> 2][bj][(j + 1) & 3][n][e] : next;
                        acc[j >> 2][bj][j & 3][n][e] = c0[e] * left + c1[e] * cur + c2[e] * nx;
                        left = cur;
                    }
                }
                asm volatile("" ::: "memory");
            }
        }
        const unsigned colo = u.pn * 128 + wc * 32 + 8 * fq;
#pragma unroll
        for (int ai = 0; ai < 2; ++ai)
#pragma unroll
            for (int m = 0; m < 4; ++m) {
                f32x4 a[2];
#pragma unroll
                for (int n = 0; n < 2; ++n)
#pragma unroll
                    for (int e = 0; e < 4; ++e) a[n][e] = silu_f(acc[ai][0][m][n][e]) * acc[ai][1][m][n][e];
                store_h8((h16*)((char*)ACT + (((tok0 + tl0 + 4u * ai + m) * (unsigned)FF + colo) << 1)), a[0], a[1]);
                asm volatile("" ::: "memory");
            }
    }
};

struct EpiDftC {
    h16* BtAB;
    __device__ __forceinline__ void operator()(Acc& acc, const Unit& u, int wr, int wc, int fr, int fq, LAS unsigned char* lds, int tid) const {
        const unsigned b = u.pn >> 3, s0 = (u.pn & 7) * 256;
#pragma unroll
        for (int ai = 0; ai < 2; ++ai)
#pragma unroll
            for (int m = 0; m < 4; ++m) {
                const unsigned rl = ai * 128 + wr * 64 + m * 16 + fr;
                h16* o = BtAB + ((size_t)(b * 1024 + u.g * 256 + rl)) * BTP + (u.pm * 2048 + s0 + wc * 32 + 8 * fq);
                store_h8(o, acc[ai][0][m][0], acc[ai][0][m][1]); store_h8(o + 128, acc[ai][1][m][0], acc[ai][1][m][1]);
            }
    }
};

__device__ __forceinline__ void store_h8_skip0(h16* p, const f32x4& v0, const f32x4& v1) {
    const unsigned w0 = pk_h2(v0[0], v0[1]), w1 = pk_h2(v0[2], v0[3]); u32x2 w23; w23.x = pk_h2(v1[0], v1[1]); w23.y = pk_h2(v1[2], v1[3]);
    *(unsigned short*)(p + 1) = (unsigned short)(w0 >> 16); *(unsigned*)(p + 2) = w1; *(u32x2*)(p + 4) = w23;
}
struct EpiDftS2 {
    h16* F; float* scratch;
    __device__ __forceinline__ void operator()(Acc& acc, const Unit& u, int wr, int wc, int fr, int fq, LAS unsigned char* lds, int tid) const {
        f32x4* ps = (f32x4*)scratch + tid;
        if (u.part == 0) {
#pragma unroll
            for (int ai = 0; ai < 2; ++ai)
#pragma unroll
                for (int m = 0; m < 4; ++m)
#pragma unroll
                    for (int bj = 0; bj < 2; ++bj)
#pragma unroll
                        for (int n = 0; n < 2; ++n) ps[(((ai * 4 + m) * 2 + bj) * 2 + n) * 512] = acc[ai][bj][m][n];
            return;
        }
        const float sc = 0.0009765625f;
        const unsigned jl = wc * 32 + 8 * fq;
#pragma unroll
        for (int ai = 0; ai < 2; ++ai)
#pragma unroll
            for (int m = 0; m < 4; ++m) {
                const unsigned kk = u.pm * 256 + ai * 128 + wr * 64 + m * 16 + fr;
                h16* o = F + (size_t)(u.g * 2048 + kk) * D + u.pn * 512 + jl;
                h16* om = F + (size_t)(u.g * 2048 + 2048 - kk) * D + u.pn * 512 + jl;
#pragma unroll
                for (int bj = 0; bj < 2; ++bj) {
                    const f32x4 p0 = ps[(((ai * 4 + m) * 2 + bj) * 2 + 0) * 512], p1 = ps[(((ai * 4 + m) * 2 + bj) * 2 + 1) * 512];
                    const f32x4 y0 = acc[ai][bj][m][0] * sc, y1 = acc[ai][bj][m][1] * sc;
                    const f32x4 z0 = (p0 * 2.0f - acc[ai][bj][m][0]) * sc, z1 = (p1 * 2.0f - acc[ai][bj][m][1]) * sc;
                    const bool j0 = (bj == 0) && (jl == 0);
                    store_h8(o + bj * 128, y0, y1);
                    if (j0) store_h8_skip0(o + 256, z0, z1); else store_h8(o + 256 + bj * 128, z0, z1);
                    if (kk != 0) {
                        store_h8(om + bj * 128, z0, z1);
                        if (j0) store_h8_skip0(om + 256, y0, y1); else store_h8(om + 256 + bj * 128, y0, y1);
                    }
                }
                asm volatile("" ::: "memory");
            }
    }
};

struct Args { const float* in[13]; float* out; unsigned char* ws; int ph_lo, ph_hi; };
struct Frame {
    LAS unsigned char* lds; volatile LAS unsigned* MISC; unsigned* ctl;
    int wave, vcu, G;
    unsigned char* ws;
};

__device__ __forceinline__ void dftc_side(Frame& F, const h16* xb, h16* A256) {
    const int lane_ = mk_lane();
    const int gw = F.vcu * 8 + F.wave, NGW = F.G * 8, lane = lane_;
    for (int t = gw; t < M; t += NGW) {
        const h16x8* xr = (const h16x8*)(xb + (size_t)t * D) + lane; float s[4];
#pragma unroll
        for (int j = 0; j < 4; ++j) { const h16x8 v = xr[64 * j]; float a = 0.f;
#pragma unroll
            for (int e = 0; e < 8; e += 2) a += (float)v[e] - (float)v[e + 1];
            s[j] = wave_sum(a); }
        if (lane < 4) { const float v = lane == 0 ? s[0] : (lane == 1 ? s[1] : (lane == 2 ? s[2] : s[3])); A256[((size_t)(t >> 11) * 4 + lane) * 2048 + (t & 2047)] = (h16)v; }
    }
}
__device__ __forceinline__ void dfts_side(Frame& F, const h16* BtAB, const h16* A256, const h16* Fmat, h16* Fo) {
    const int lane_ = mk_lane();
    const int nheavy = (F.G < 384 && 2 * F.G > 384) ? 384 - F.G : 0, bxi = (int)blockIdx.x;
    if (bxi < nheavy) return;
    const int gw = (bxi - nheavy) * 8 + F.wave, NGW = (F.G - nheavy) * 8, lane = lane_;
    for (int J = gw; J < 96 * 32; J += NGW) {
        const int pair = J >> 5, ch = J & 31, b = pair >> 2, grp = pair & 3;
        const h16x8* ap = (const h16x8*)(A256 + (size_t)pair * 2048) + lane; float av[4][8];
#pragma unroll
        for (int j = 0; j < 4; ++j) { const h16x8 v = ap[64 * j];
#pragma unroll
            for (int e = 0; e < 8; ++e) av[j][e] = (float)v[e]; }
        for (int k0 = ch * 33; k0 < ch * 33 + 33; k0 += 3) {
            float a3[3] = {0.f, 0.f, 0.f};
#pragma unroll
            for (int q = 0; q < 3; ++q) { const int kk = (k0 + q) <= 1024 ? (k0 + q) : 1024; const h16x8* fp = (const h16x8*)(Fmat + (size_t)kk * 4096) + lane;
#pragma unroll
                for (int j = 0; j < 4; ++j) { const h16x8 v = fp[64 * j];
#pragma unroll
                    for (int e = 0; e < 8; ++e) a3[q] += (float)v[e] * av[j][e]; } }
#pragma unroll
            for (int q = 0; q < 3; ++q) { const int kk = k0 + q; const float a = wave_sum(a3[q]) * 0.0009765625f;
                if (lane == 0 && kk <= 1024) { Fo[((size_t)b * 2048 + kk) * D + grp * 512 + 256] = (h16)a; if (kk >= 1 && kk <= 1023) Fo[((size_t)b * 2048 + 2048 - kk) * D + grp * 512 + 256] = (h16)a; } }
        }
    }
    for (int r = gw; r < NSEQ * 1024; r += NGW) {
        const h16x8* p = (const h16x8*)(BtAB + (size_t)r * BTP) + lane; float s = 0.f;
#pragma unroll
        for (int j = 0; j < 4; ++j) { const h16x8 v = p[64 * j];
#pragma unroll
            for (int e = 0; e < 8; e += 2) s += (float)v[e] - (float)v[e + 1]; }
        s = wave_sum(s) * 0.0009765625f;
        if (lane == 0) { const int b = r >> 10, n = r & 1023, grp = n >> 8, j = n & 255; h16* o = Fo + ((size_t)b * 2048 + 1024) * D + grp * 512;
            o[j] = (h16)s; if (j >= 1) o[256 + j] = (h16)s; }
    }
}

__device__ __forceinline__ int fpos_chan(int kpos) { const int p = kpos & 511; return (kpos & ~511) + (p <= 256 ? p : 768 - p); }
template <bool KMAP = false>
__device__ __forceinline__ void p0_transpose_item(const float* W, int K, int N, h16* WT, int kb, int np0, int scol0, LAS float* scr, int lane) {
    const int k0 = 64 * kb;
#pragma unroll 8
    for (int i = 0; i < 32; ++i) { const int kk = 2 * i + (lane >> 5); const int ksrc = KMAP ? fpos_chan(k0 + kk) : (k0 + kk); scr[kk * 33 + (lane & 31)] = W[(size_t)ksrc * N + scol0 + (lane & 31)]; }
    asm volatile("s_waitcnt lgkmcnt(0)" ::: "memory");
    const int c = lane & 7;
#pragma unroll
    for (int j = 0; j < 4; ++j) { const int n = (lane >> 3) + 8 * j; const LAS float* s = scr + (8 * c) * 33 + n;
        u32x4 o; o.x = pk_h2(s[0 * 33], s[1 * 33]); o.y = pk_h2(s[2 * 33], s[3 * 33]); o.z = pk_h2(s[4 * 33], s[5 * 33]); o.w = pk_h2(s[6 * 33], s[7 * 33]);
        *(u32x4*)(WT + (size_t)(np0 + n) * K + k0 + 8 * c) = o; }
    asm volatile("s_waitcnt lgkmcnt(0)" ::: "memory");
}
__device__ __forceinline__ float colmax_of(const float* pmax, int idx) { float m = 0.f;
#pragma unroll
    for (int rb = 0; rb < 8; ++rb) m = fmaxf(m, pmax[(size_t)rb * PM_STRIDE + idx]); return m; }
__device__ __forceinline__ void p0_transpose_item_i8(const float* W, int K, int N, signed char* WT, int kb, int np0, int scol0, const float* pmax, int cidx0, LAS float* scr, int lane) {
    const int k0 = 64 * kb;
#pragma unroll 8
    for (int i = 0; i < 32; ++i) { const int kk = 2 * i + (lane >> 5); scr[kk * 33 + (lane & 31)] = W[(size_t)(k0 + kk) * N + scol0 + (lane & 31)]; }
    asm volatile("s_waitcnt lgkmcnt(0)" ::: "memory");
    const int c = lane & 7;
#pragma unroll
    for (int j = 0; j < 4; ++j) { const int n = (lane >> 3) + 8 * j; const LAS float* s = scr + (8 * c) * 33 + n;
        const float mx = colmax_of(pmax, cidx0 + n); const float inv = mx > 0.f ? 127.0f / mx : 0.f;
        *(u32x2*)(WT + (size_t)(np0 + n) * K + k0 + 8 * c) = pack8_i8(s[0 * 33], s[1 * 33], s[2 * 33], s[3 * 33], s[4 * 33], s[5 * 33], s[6 * 33], s[7 * 33], inv); }
    asm volatile("s_waitcnt lgkmcnt(0)" ::: "memory");
}
__device__ __forceinline__ void p0_colmax(Frame& F, const float* w_up, const float* w_in) {
    const int lane = mk_lane();
    LAS float* red = (LAS float*)F.lds;
    float* pmax = (float*)(F.ws + WS_PART);
    constexpr int NCM_UP = 4 * 44 * 8, NCM_IN = 2 * 12 * 8;
    for (int it = F.vcu; it < NCM_UP + NCM_IN; it += F.G) {
        const float* p; int pidx, rb; size_t pitch;
        if (it < NCM_UP) { const int l = it / 352, r = it % 352, cg = r % 44; rb = r / 44; pitch = FF2; pidx = l * FF2 + cg * 256;
            p = w_up + (size_t)l * D * FF2 + (size_t)(rb * 256 + F.wave * 32) * FF2 + cg * 256 + 4 * lane; }
        else { const int j = it - NCM_UP, i = j / 96, r = j % 96, cg = r % 12; rb = r / 12; pitch = DIN; pidx = 4 * FF2 + i * 3072 + cg * 256;
            p = w_in + (size_t)i * D * DIN + (size_t)(rb * 256 + F.wave * 32) * DIN + 3072 + cg * 256 + 4 * lane; }
        f32x4 m = {0.f, 0.f, 0.f, 0.f};
#pragma unroll
        for (int k = 0; k < 32; ++k) { const f32x4 v = *(const f32x4*)(p + (size_t)k * pitch);
#pragma unroll
            for (int e = 0; e < 4; ++e) m[e] = fmaxf(m[e], fabsf(v[e])); }
        *(LAS f32x4*)(red + F.wave * 256 + 4 * lane) = m;
        LDS_FENCE_BAR();
        if (F.wave < 4) { const int c = F.wave * 64 + lane; float mm = 0.f;
#pragma unroll
            for (int w = 0; w < 8; ++w) mm = fmaxf(mm, red[w * 256 + c]);
            pmax[(size_t)rb * PM_STRIDE + pidx + c] = mm; }
        LDS_FENCE_BAR();
    }
}
__device__ __forceinline__ int in_srccol(int np) {
    if (np >= 1024 && np < 3072) { const int pn = np >> 8, p = np & 255; return ((p >> 7) ? 2048 : 1024) + (pn - 4) * 128 + (p & 127); }
    if (np < 1024 || np >= 5120) return np;
    const int pn = np >> 8, p = np & 255, bj = p >> 7, w = p & 127;
    return pn * 256 + 128 * (w >> 6) + 64 * bj + (w & 63);
}
__device__ __forceinline__ int up_srccol(int np) { const int pn = np >> 8, p = np & 255, bj = p >> 7, w = p & 127; return bj * FF + pn * 128 + w; }

template <int PART> __device__ __forceinline__ void p0_prologue(Frame& F, const Args& a) {
    const float* x_prompt = a.in[0]; const float* x_sample = a.in[1]; const float* w_in = a.in[2]; const float* w_om = a.in[4]; const float* w_of = a.in[5];
    const float* w_up = a.in[8]; const float* w_dn = a.in[10];
    unsigned char* ws = F.ws;
    LAS float* scr = (LAS float*)(F.lds + F.wave * 16384);
    const int gw = F.vcu * 8 + F.wave, NGW = F.G * 8, lane0 = mk_lane();
    const long gt = (long)gw * 64 + lane0, NGT = (long)NGW * 64;
    constexpr int I_IN = 32 * (DIN / 32), I_SQ = 32 * (D / 32), I_UP = 32 * (FF2 / 32), I_DN = (FF / 64) * (D / 32);
    constexpr int NITEMS = 2 * I_IN + 2 * I_SQ + 2 * I_SQ + 4 * I_UP + 4 * I_DN;
    for (int it = gw; it < NITEMS; it += NGW) {
        int r = it;
        if (r < 2 * I_IN) { const int i = r / I_IN; r -= i * I_IN; const int nb = r % (DIN / 32), kb = r / (DIN / 32), np0 = nb * 32;
            if ((np0 >= 3072) != (PART != 0)) continue;
            if (PART) p0_transpose_item_i8(w_in + (size_t)i * D * DIN, D, DIN, (signed char*)(ws + WS_WIN8) + ((long)i * 3072 - 3072) * D, kb, np0, in_srccol(np0), (const float*)(ws + WS_PART), 4 * FF2 + i * 3072 + in_srccol(np0) - 3072, scr, lane0);
            else p0_transpose_item(w_in + (size_t)i * D * DIN, D, DIN, (h16*)(ws + WS_WIN) + (size_t)i * DIN * D, kb, np0, in_srccol(np0), scr, lane0);
            continue; }
        r -= 2 * I_IN;
        if (PART && r < 4 * I_SQ) continue;
        if (r < 2 * I_SQ) { const int i = r / I_SQ; r -= i * I_SQ; const int nb = r % (D / 32), kb = r / (D / 32);
            p0_transpose_item(w_om + (size_t)i * D * D, D, D, (h16*)(ws + WS_WOM) + (size_t)i * D * D, kb, nb * 32, nb * 32, scr, lane0); continue; }
        r -= 2 * I_SQ;
        if (r < 2 * I_SQ) { const int i = r / I_SQ; r -= i * I_SQ; const int nb = r % (D / 32), kb = r / (D / 32);
            p0_transpose_item<true>(w_of + (size_t)i * D * D, D, D, (h16*)(ws + WS_WOF) + (size_t)i * D * D, kb, nb * 32, nb * 32, scr, lane0); continue; }
        r -= 2 * I_SQ;
        if (r < 4 * I_UP) { const int l = r / I_UP; r -= l * I_UP; const int nb = r % (FF2 / 32), kb = r / (FF2 / 32), np0 = nb * 32;
            if (((kI8Mask >> l) & 1u) != (unsigned)PART) continue;
            if (PART) p0_transpose_item_i8(w_up + (size_t)l * D * FF2, D, FF2, (signed char*)(ws + WS_W8) + (size_t)l * FF2 * D, kb, np0, up_srccol(np0), (const float*)(ws + WS_PART), l * FF2 + up_srccol(np0), scr, lane0);
            else p0_transpose_item(w_up + (size_t)l * D * FF2, D, FF2, (h16*)(ws + WS_WUP) + (size_t)l * FF2 * D, kb, np0, up_srccol(np0), scr, lane0);
            continue; }
        r -= 4 * I_UP;
        if (PART) break;
        { const int l = r / I_DN; r -= l * I_DN; const int nb = r % (D / 32), kb = r / (D / 32);
            p0_transpose_item(w_dn + (size_t)l * FF * D, FF, D, (h16*)(ws + WS_WDN) + (size_t)l * D * FF, kb, nb * 32, nb * 32, scr, lane0); }
    }
    if constexpr (PART == 1) {
      float* vec = (float*)(ws + WS_VEC); const float* pmax = (const float*)(ws + WS_PART);
      for (long i = gt; i < 4 * FF2; i += NGT) { const int l = (int)i / FF2, np = (int)i % FF2; vec[V_SW + i] = colmax_of(pmax, l * FF2 + up_srccol(np)) * (1.0f / 127.0f); }
      for (long i = gt; i < 2 * 3072; i += NGT) { const int li = (int)i / 3072, np = 3072 + (int)i % 3072; vec[V_SWQ + i] = colmax_of(pmax, 4 * FF2 + li * 3072 + in_srccol(np) - 3072) * (1.0f / 127.0f); }
      if constexpr (kD8Mask != 0u) {
        const h16* wt = (const h16*)(ws + WS_WDN); signed char* w8 = (signed char*)(ws + WS_WDN8);
        for (int r = gw; r < 4 * D; r += NGW) { if (!((kD8Mask >> (r / D)) & 1u)) continue;
            h16x8 in[11];
#pragma unroll
            for (int j = 0; j < 11; ++j) in[j] = *(const h16x8*)(wt + (size_t)r * FF + 512 * j + 8 * lane0);
            const float sc = rowq_rot(in, w8 + (size_t)r * FF, lane0);
            if (lane0 == 0) vec[V_SWD + r] = sc * (1.0f / 128.0f); } }
      return; }
    { h16* Fm = (h16*)(ws + WS_FMAT);
      for (long ch = gt; ch < (long)2048 * 512; ch += NGT) { const int k = (int)(ch >> 9), c8 = (int)(ch & 511) * 8, p = c8 >> 11, s0 = c8 & 2047; unsigned w[4];
#pragma unroll
          for (int e = 0; e < 4; ++e) { float v[2];
#pragma unroll
              for (int q = 0; q < 2; ++q) { const int s = s0 + 2 * e + q; const int ph = (k * s) & 2047; float sn, cs; sincospif((float)ph * (1.0f / 1024.0f), &sn, &cs); v[q] = p ? -sn : cs; }
              w[e] = pk_h2(v[0], v[1]); }
          u32x4 o; o.x = w[0]; o.y = w[1]; o.z = w[2]; o.w = w[3]; *(u32x4*)(Fm + (size_t)k * 4096 + c8) = o; } }
    { h16* Dm = (h16*)(ws + WS_DM);
      for (long ch = gt; ch < 1024 * 64; ch += NGT) { const int n = (int)(ch >> 6), c0 = (int)(ch & 63) * 8, jj = n & 511; const bool issin = n >= 512; unsigned w[4];
#pragma unroll
          for (int e = 0; e < 4; ++e) { float v[2];
#pragma unroll
              for (int q = 0; q < 2; ++q) { const int c = c0 + 2 * e + q; const int ph = (jj * c) & 511; float sn, cs; sincospif((float)ph * (1.0f / 256.0f), &sn, &cs); v[q] = issin ? sn : cs; }
              w[e] = pk_h2(v[0], v[1]); }
          u32x4 o; o.x = w[0]; o.y = w[1]; o.z = w[2]; o.w = w[3]; *(u32x4*)(Dm + (size_t)n * 512 + c0) = o; } }
    { float* rc = (float*)(ws + WS_ROPE); float* rs = rc + 2048 * 64;
      for (long i = gt; i < 2048 * 64; i += NGT) { const int t = (int)(i >> 6), d = (int)(i & 63); const double inv = exp2(-(double)d * (13.287712379549449 / 64.0)); const double ang = (double)t * inv;
          rc[i] = (float)cos(ang); rs[i] = (float)sin(ang); } }
    { h16* xb = (h16*)(ws + WS_R2); signed char* x8 = (signed char*)(ws + WS_X8); float* sx = (float*)(ws + WS_VEC) + V_SX;
      for (int row = gw; row < M; row += NGW) {
          const float* src = row < M_PROMPT ? x_prompt + (size_t)row * D : x_sample + (size_t)(row - M_PROMPT) * D;
          f32x4 v[4][2]; float amax = 0.f;
#pragma unroll
          for (int j = 0; j < 4; ++j) { const int c = 512 * j + 8 * lane0; v[j][0] = *(const f32x4*)(src + c); v[j][1] = *(const f32x4*)(src + c + 4); }
#pragma unroll
          for (int j = 0; j < 4; ++j) { store_h8(xb + (size_t)row * D + 512 * j + 8 * lane0, v[j][0], v[j][1]);
#pragma unroll
              for (int e = 0; e < 4; ++e) amax = fmaxf(amax, fmaxf(fabsf(v[j][0][e]), fabsf(v[j][1][e]))); }
          amax = wave_max(amax);
          const float inv = amax > 0.f ? 127.0f / amax : 0.f;
#pragma unroll
          for (int j = 0; j < 4; ++j) *(u32x2*)(x8 + (size_t)row * D + 512 * j + 8 * lane0) = pack8_i8(v[j][0][0], v[j][0][1], v[j][0][2], v[j][0][3], v[j][1][0], v[j][1][1], v[j][1][2], v[j][1][3], inv);
          if (lane0 == 0) sx[row] = amax * (1.0f / 127.0f);
      } }
}

__device__ __forceinline__ unsigned att_off(unsigned row, unsigned ch) { return 256u * row + 16u * (ch ^ (((row & 3) << 2) | ((row >> 2) & 3))); }
struct AttItem { int br, r, p, idx0, L, h; size_t rowb; };
__device__ __forceinline__ AttItem att_decode(int I) {
    AttItem t; const int bh = I / 48, it = I % 48; t.h = bh & 7; t.rowb = (size_t)(bh >> 3) * SEQ; int blk;
    if (it < 16) { t.br = 0; t.r = 1; t.p = 0; blk = it; } else if (it < 32) { t.br = 1; t.r = 4; t.p = (it - 16) >> 2; blk = (it - 16) & 3; } else { t.br = 2; t.r = 16; t.p = it - 32; blk = 0; }
    t.L = SEQ / t.r; t.idx0 = 128 * blk; return t;
}
#define ATT_ISSUE(T) do { \
        const int ch_ = tid & 15, r4_ = tid >> 4; \
        const h16* base_ = Hq + (T).h * 128 + 8 * ch_; \
        _Pragma("unroll") for (int j = 0; j < 17; ++j) { const bool isv_ = j >= 8; const int rr_ = isv_ ? r4_ + 32 * (j - 8) : r4_ + 32 * j; \
            int kidx_ = (T).idx0 - 64 + rr_; kidx_ = kidx_ < 0 ? 0 : (kidx_ >= (T).L ? (T).L - 1 : kidx_); \
            if (j < 16 || tid < 256) kv[j] = *(const u32x4*)(base_ + ((T).rowb + (T).p + (T).r * kidx_) * 3072 + (isv_ ? 2048 : 1024)); } \
        const int qtok_ = (T).p + (T).r * ((T).idx0 + 16 * w + q16); const h16* qp_ = Hq + ((T).rowb + qtok_) * 3072 + (T).h * 128 + 8 * g; \
        _Pragma("unroll") for (int s = 0; s < 4; ++s) qn[s] = *(const h16x8*)(qp_ + 32 * s); } while (0)
__device__ __forceinline__ void attn_phase(Frame& F, h16* Obr) {
    const h16* Hq = (const h16*)(F.ws + WS_R1 + R1_HQKV); float* Lse = (float*)(F.ws + WS_LSE);
    const int tid_ = F.wave * 64 + mk_lane();
    LAS unsigned char* lds = F.lds; const int tid = tid_, lane = tid & 63, w = F.wave, q16 = lane & 15, g = lane >> 4;
    constexpr int NITEM = NSEQ * NH * 48;
    int i_lo, i_hi, i_st;
    if (F.G % 8 == 0) { const int per = F.G / 8, x = F.vcu / per, j = F.vcu % per; i_lo = x * (NITEM / 8) + j; i_hi = (x + 1) * (NITEM / 8); i_st = per; }
    else { i_lo = (int)((long)F.vcu * NITEM / F.G); i_hi = (int)((long)(F.vcu + 1) * NITEM / F.G); i_st = 1; }
    if (i_lo >= i_hi) return;
    u32x4 kv[17]; h16x8 qn[4];
    AttItem nx = att_decode(i_lo);
    ATT_ISSUE(nx);
    for (int I = i_lo; I < i_hi; I += i_st) {
        const AttItem cu = nx;
        __syncthreads();
        {   const int ch = tid & 15, r4 = tid >> 4;
#pragma unroll
            for (int j = 0; j < 17; ++j) { const bool isv = j >= 8; const int rr = isv ? r4 + 32 * (j - 8) : r4 + 32 * j;
                if (j < 16 || tid < 256) *(LAS u32x4*)(lds + (isv ? ATT_V : ATT_K) + att_off(rr, ch)) = kv[j]; } }
        h16x8 Qf[4];
#pragma unroll
        for (int s = 0; s < 4; ++s) Qf[s] = qn[s];
        __syncthreads();
        if (I + i_st < i_hi) { nx = att_decode(I + i_st); ATT_ISSUE(nx); }
        const int idx0 = cu.idx0, L = cu.L;
        const int qtok = cu.p + cu.r * (idx0 + 16 * w + q16);
        f32x4 sc[9];
#pragma unroll
        for (int tt = 0; tt < 9; ++tt) { f32x4 a = {0.f, 0.f, 0.f, 0.f};
#pragma unroll
            for (int s = 0; s < 4; ++s) { const h16x8 kf = *(const LAS h16x8*)(lds + ATT_K + att_off(16 * (w + tt) + q16, 4 * s + g)); a = __builtin_amdgcn_mfma_f32_16x16x32_f16(kf, Qf[s], a, 0, 0, 0); }
            sc[tt] = a; }
        const int ql = 16 * w + q16;
        const int clo = ql > 64 - idx0 ? ql : 64 - idx0, chi = (ql + 128) < (L + 63 - idx0) ? (ql + 128) : (L + 63 - idx0);
        const unsigned span = (unsigned)(chi - clo); const int cb = 16 * w + 4 * g - clo;
        float mx = -3.0e38f;
#pragma unroll
        for (int tt = 0; tt < 9; ++tt)
#pragma unroll
            for (int e = 0; e < 4; ++e) { const bool ok = (unsigned)(cb + 16 * tt + e) <= span; sc[tt][e] = ok ? sc[tt][e] : -3.0e38f; mx = fmaxf(mx, sc[tt][e]); }
        mx = fmaxf(mx, shx<16>(mx)); mx = fmaxf(mx, shx<32>(mx));
        float den = 0.f;
#pragma unroll
        for (int tt = 0; tt < 9; ++tt)
#pragma unroll
            for (int e = 0; e < 4; ++e) { const float pv = __builtin_amdgcn_exp2f(sc[tt][e] - mx); sc[tt][e] = pv; den += pv; }
        den += shx<16>(den); den += shx<32>(den);
        h16x8 Pf[5];
#pragma unroll
        for (int ks = 0; ks < 5; ++ks) { u32x4 wv; wv.x = pk_h2(sc[2 * ks][0], sc[2 * ks][1]); wv.y = pk_h2(sc[2 * ks][2], sc[2 * ks][3]);
            if (ks < 4) { wv.z = pk_h2(sc[2 * ks + 1][0], sc[2 * ks + 1][1]); wv.w = pk_h2(sc[2 * ks + 1][2], sc[2 * ks + 1][3]); } else { wv.z = 0u; wv.w = 0u; }
            Pf[ks] = __builtin_bit_cast(h16x8, wv); }
        const float rden = 1.0f / den;
        unsigned char* op = (unsigned char*)Obr + ((size_t)cu.br * M + cu.rowb + qtok) * 1024 + cu.h * 128 + 4 * g;
        const float rs16 = rden * 16.0f;
        const int qq = q16 >> 2, pp = q16 & 3;
#pragma unroll
        for (int c8 = 0; c8 < 8; ++c8) { f32x4 o = {0.f, 0.f, 0.f, 0.f};
#pragma unroll
            for (int ks = 0; ks < 5; ++ks) {
                const unsigned r0 = 16 * (w + 2 * ks) + 4 * g + qq, r1 = r0 + 16;
                const s16x4 lo = __builtin_bit_cast(s16x4, __builtin_amdgcn_ds_read_tr16_b64_v4i16((LAS s16x4*)(lds + ATT_V + att_off(r0, 2 * c8 + (pp >> 1)) + 8 * (pp & 1))));
                const s16x4 hi = __builtin_bit_cast(s16x4, __builtin_amdgcn_ds_read_tr16_b64_v4i16((LAS s16x4*)(lds + ATT_V + att_off(r1, 2 * c8 + (pp >> 1)) + 8 * (pp & 1))));
                typedef short s16x8 __attribute__((ext_vector_type(8)));
                const s16x8 vv = __builtin_shufflevector(lo, hi, 0, 1, 2, 3, 4, 5, 6, 7);
                o = __builtin_amdgcn_mfma_f32_16x16x32_f16(__builtin_bit_cast(h16x8, vv), Pf[ks], o, 0, 0, 0); }
            int ov = __builtin_amdgcn_cvt_pk_fp8_f32(o[0] * rs16, o[1] * rs16, 0, false); ov = __builtin_amdgcn_cvt_pk_fp8_f32(o[2] * rs16, o[3] * rs16, ov, true);
            *(int*)(op + 16 * c8) = ov; }
        if (g == 0) Lse[((size_t)cu.br * M + cu.rowb + qtok) * 8 + cu.h] = (mx + __log2f(den)) * 0.69314718055994531f;
    }
}
#undef ATT_ISSUE

__device__ __forceinline__ void load8(const h16* p, float (&v)[8]) { const h16x8 hv = *(const h16x8*)p;
#pragma unroll
    for (int e = 0; e < 8; ++e) v[e] = (float)hv[e]; }
struct MRow { h16x8 bg[2], pn[2]; u32x2 o[3][2]; float l[3][2]; };
__device__ __forceinline__ MRow merge_load_row(const h16* Hc, const h16* Obr, const float* Lse, int row, int lane) {
    MRow r;
#pragma unroll
    for (int q = 0; q < 2; ++q) {
        const int c = 512 * q + 8 * lane, h = c >> 7;
        r.bg[q] = *(const h16x8*)(Hc + (size_t)row * 3072 + c);
        const int rn = row + 1 < M ? row + 1 : row;
        r.pn[q] = *(const h16x8*)(Hc + (size_t)rn * 3072 + 1024 + c);
#pragma unroll
        for (int b = 0; b < 3; ++b) { r.o[b][q] = *(const u32x2*)((const unsigned char*)Obr + ((size_t)b * M + row) * 1024 + c); r.l[b][q] = Lse[((size_t)b * M + row) * 8 + h]; }
    }
    return r;
}
__device__ __forceinline__ void merge_phase(Frame& F, const h16* Obr, const float* cws  ) {
    const h16* Hc = (const h16*)(F.ws + WS_R1); const float* Lse = (const float*)(F.ws + WS_LSE); h16* YC = (h16*)(F.ws + WS_R1 + R1_HQKV);
    const int lane_ = mk_lane();
    int vcu_ = F.vcu; asm volatile("" : "+s"(vcu_));
    const int gw = vcu_ * 8 + F.wave, NGW = F.G * 8, lane = lane_;
    const int per = (M + NGW - 1) / NGW; const int r_lo = gw * per, r_hi = (r_lo + per) < M ? (r_lo + per) : M;
    if (r_lo >= r_hi) return;
    float w0[2][8], w1[2][8], w2[2][8];
#pragma unroll
    for (int q = 0; q < 2; ++q)
#pragma unroll
        for (int e = 0; e < 8; ++e) { const int c = 512 * q + 8 * lane + e; w0[q][e] = cws[c]; w1[q][e] = cws[1024 + c]; w2[q][e] = cws[2048 + c]; }
    float pl[2][8], pc[2][8];
#pragma unroll
    for (int q = 0; q < 2; ++q) { const int c = 512 * q + 8 * lane;
        load8(Hc + (size_t)r_lo * 3072 + 1024 + c, pc[q]);
        const int rp = r_lo > 0 ? r_lo - 1 : 0;
        load8(Hc + (size_t)rp * 3072 + 1024 + c, pl[q]); }
    MRow cur = merge_load_row(Hc, Obr, Lse, r_lo, lane);
    for (int row = r_lo; row < r_hi; ++row) {
        MRow nxt = cur;
        if (row + 1 < r_hi) nxt = merge_load_row(Hc, Obr, Lse, row + 1, lane);
        asm volatile("" ::: "memory");
        const int t = row & (SEQ - 1);
        const float ml = t > 0 ? 1.0f : 0.0f, mr = t < SEQ - 1 ? 1.0f : 0.0f;
        h16* yo = YC + (size_t)row * D;
#pragma unroll
        for (int q = 0; q < 2; ++q) {
            const int c = 512 * q + 8 * lane;
            f32x4 o0, o1;
#pragma unroll
            for (int e = 0; e < 8; ++e) { const float pr = (float)cur.pn[q][e];
                const float y = (float)cur.bg[q][e] * (w0[q][e] * (ml * pl[q][e]) + w1[q][e] * pc[q][e] + w2[q][e] * (mr * pr)); if (e < 4) o0[e] = y; else o1[e - 4] = y;
                pl[q][e] = pc[q][e]; pc[q][e] = pr; }
            store_h8(yo + c, o0, o1);
        }
#pragma unroll
        for (int q = 0; q < 2; ++q) {
            const int c = 512 * q + 8 * lane;
            const float l0 = cur.l[0][q], l1 = cur.l[1][q], l2 = cur.l[2][q];
            const float mx = fmaxf(l0, fmaxf(l1, l2)); float e0 = __expf(l0 - mx), e1 = __expf(l1 - mx), e2 = __expf(l2 - mx); const float rs = 0.0625f / (e0 + e1 + e2); e0 *= rs; e1 *= rs; e2 *= rs;
            f32x4 o0, o1;
#pragma unroll
            for (int hw = 0; hw < 2; ++hw) {
                const int x0 = (int)(hw ? cur.o[0][q].y : cur.o[0][q].x), x1 = (int)(hw ? cur.o[1][q].y : cur.o[1][q].x), x2 = (int)(hw ? cur.o[2][q].y : cur.o[2][q].x);
                const f32x2 ylo = __builtin_amdgcn_cvt_pk_f32_fp8(x0, false) * e0 + __builtin_amdgcn_cvt_pk_f32_fp8(x1, false) * e1 + __builtin_amdgcn_cvt_pk_f32_fp8(x2, false) * e2;
                const f32x2 yhi = __builtin_amdgcn_cvt_pk_f32_fp8(x0, true) * e0 + __builtin_amdgcn_cvt_pk_f32_fp8(x1, true) * e1 + __builtin_amdgcn_cvt_pk_f32_fp8(x2, true) * e2;
                if (hw == 0) { o0[0] = ylo.x; o0[1] = ylo.y; o0[2] = yhi.x; o0[3] = yhi.y; } else { o1[0] = ylo.x; o1[1] = ylo.y; o1[2] = yhi.x; o1[3] = yhi.y; } }
            store_h8(yo + 1024 + c, o0, o1);
        }
        cur = nxt;
    }
}

template <bool FINAL, bool WA256 = false>
__device__ __forceinline__ void norm_phase(Frame& F, h16* xb, float* out, const float* g, const float* bta, h16* A256 = nullptr) {
    const int lane_ = mk_lane();
    const int gw = F.vcu * 8 + F.wave, NGW = F.G * 8, lane = lane_;
    f32x4 gg[4][2], bb[4][2];
#pragma unroll
    for (int j = 0; j < 4; ++j) { const int c = 512 * j + 8 * lane; gg[j][0] = *(const f32x4*)(g + c); gg[j][1] = *(const f32x4*)(g + c + 4); bb[j][0] = *(const f32x4*)(bta + c); bb[j][1] = *(const f32x4*)(bta + c + 4); }
    h16x8 xv[4];
    if (gw < M) {
#pragma unroll
        for (int j = 0; j < 4; ++j) xv[j] = ((const h16x8*)(xb + (size_t)gw * D) + lane)[64 * j]; }
    for (int row = gw; row < M; row += NGW) {
        float v[4][8]; float s = 0.f;
#pragma unroll
        for (int j = 0; j < 4; ++j)
#pragma unroll
            for (int e = 0; e < 8; ++e) { v[j][e] = (float)xv[j][e]; s += v[j][e]; }
        const int nrow = row + NGW;
        if (nrow < M) {
#pragma unroll
            for (int j = 0; j < 4; ++j) xv[j] = ((const h16x8*)(xb + (size_t)nrow * D) + lane)[64 * j]; }
        const float mean = wave_sum(s) * (1.0f / D); float s2 = 0.f;
#pragma unroll
        for (int j = 0; j < 4; ++j)
#pragma unroll
            for (int e = 0; e < 8; ++e) { v[j][e] -= mean; s2 += v[j][e] * v[j][e]; }
        const float rstd = 1.0f / sqrtf(wave_sum(s2) * (1.0f / D) + LN_EPS);
#pragma unroll
        for (int j = 0; j < 4; ++j) {
            const int c = 512 * j + 8 * lane;
            f32x4 y0, y1;
#pragma unroll
            for (int e = 0; e < 4; ++e) { y0[e] = v[j][e] * rstd * gg[j][0][e] + bb[j][0][e]; y1[e] = v[j][e + 4] * rstd * gg[j][1][e] + bb[j][1][e]; }
            if (FINAL) { float* o = out + (size_t)row * D + c; *(f32x4*)o = y0; *(f32x4*)(o + 4) = y1; }
            else store_h8(xb + (size_t)row * D + c, y0, y1);
            if (WA256) {
                u32x4 w; w.x = pk_h2(y0[0], y0[1]); w.y = pk_h2(y0[2], y0[3]); w.z = pk_h2(y1[0], y1[1]); w.w = pk_h2(y1[2], y1[3]);
                const h16x8 hv = __builtin_bit_cast(h16x8, w); float a = 0.f;
#pragma unroll
                for (int e = 0; e < 8; e += 2) a += (float)hv[e] - (float)hv[e + 1];
                a = wave_sum(a);
                if (lane == 0) A256[((size_t)(row >> 11) * 4 + j) * 2048 + (row & 2047)] = (h16)a;
            }
        }
    }
}

template <bool KEEPZ> __device__ __forceinline__ void norm_phase_x8(Frame& F, h16* xb, signed char* x8, float* sx, const float* g, const float* bta, float* stats) {
    const int lane_ = mk_lane();
    const int gw = F.vcu * 8 + F.wave, NGW = F.G * 8, lane = lane_;
    f32x4 gg[4][2], bb[4][2];
#pragma unroll
    for (int j = 0; j < 4; ++j) { const int c = 512 * j + 8 * lane; gg[j][0] = *(const f32x4*)(g + c); gg[j][1] = *(const f32x4*)(g + c + 4); bb[j][0] = *(const f32x4*)(bta + c); bb[j][1] = *(const f32x4*)(bta + c + 4); }
    h16x8 xv[4];
    if (gw < M) {
#pragma unroll
        for (int j = 0; j < 4; ++j) xv[j] = ((const h16x8*)(xb + (size_t)gw * D) + lane)[64 * j]; }
    for (int row = gw; row < M; row += NGW) {
        float v[4][8]; float s = 0.f;
#pragma unroll
        for (int j = 0; j < 4; ++j)
#pragma unroll
            for (int e = 0; e < 8; ++e) { v[j][e] = (float)xv[j][e]; s += v[j][e]; }
        const int nrow = row + NGW;
        if (nrow < M) {
#pragma unroll
            for (int j = 0; j < 4; ++j) xv[j] = ((const h16x8*)(xb + (size_t)nrow * D) + lane)[64 * j]; }
        const float mean = wave_sum(s) * (1.0f / D); float s2 = 0.f;
#pragma unroll
        for (int j = 0; j < 4; ++j)
#pragma unroll
            for (int e = 0; e < 8; ++e) { v[j][e] -= mean; s2 += v[j][e] * v[j][e]; }
        const float rstd = 1.0f / sqrtf(wave_sum(s2) * (1.0f / D) + LN_EPS);
        float amax = 0.f;
#pragma unroll
        for (int j = 0; j < 4; ++j) {
            const int c = 512 * j + 8 * lane;
            f32x4 y0, y1;
#pragma unroll
            for (int e = 0; e < 4; ++e) { y0[e] = v[j][e] * rstd * gg[j][0][e] + bb[j][0][e]; y1[e] = v[j][e + 4] * rstd * gg[j][1][e] + bb[j][1][e]; v[j][e] = y0[e]; v[j][e + 4] = y1[e];
                amax = fmaxf(amax, fmaxf(fabsf(y0[e]), fabsf(y1[e]))); }
            if constexpr (!KEEPZ) store_h8(xb + (size_t)row * D + c, y0, y1);
        }
        amax = wave_max(amax);
        const float inv = amax > 0.f ? 127.0f / amax : 0.f;
#pragma unroll
        for (int j = 0; j < 4; ++j) *(u32x2*)(x8 + (size_t)row * D + 512 * j + 8 * lane) = pack8_i8(v[j][0], v[j][1], v[j][2], v[j][3], v[j][4], v[j][5], v[j][6], v[j][7], inv);
        if (lane == 0) { sx[row] = amax * (1.0f / 127.0f); if constexpr (KEEPZ) { f32x2 st; st.x = mean; st.y = rstd; *(f32x2*)(stats + 2 * (size_t)row) = st; } }
    }
}

__device__ __forceinline__ void actq_phase(Frame& F, const h16* act, signed char* a8, float* sa) {
    const int lane = mk_lane();
    int vcu_ = F.vcu; asm volatile("" : "+s"(vcu_));
    const int gw = vcu_ * 8 + F.wave, NGW = F.G * 8;
    h16x8 cur[11];
    if (gw < M) {
#pragma unroll
        for (int j = 0; j < 11; ++j) cur[j] = *(const h16x8*)(act + (size_t)gw * FF + 512 * j + 8 * lane); }
    for (int row = gw; row < M; row += NGW) {
        h16x8 nxt[11];
        const int nrow = row + NGW;
#pragma unroll
        for (int j = 0; j < 11; ++j) nxt[j] = cur[j];
        if (nrow < M) {
#pragma unroll
            for (int j = 0; j < 11; ++j) nxt[j] = *(const h16x8*)(act + (size_t)nrow * FF + 512 * j + 8 * lane); }
        const float sc = rowq_rot(cur, a8 + (size_t)row * FF, lane);
        if (lane == 0) sa[row] = sc;
#pragma unroll
        for (int j = 0; j < 11; ++j) cur[j] = nxt[j];
    }
}

constexpr int N_PHASES = 35;
__global__ void __launch_bounds__(512, 2) mk_fwd(Args args) {
    extern __shared__ __attribute__((aligned(16))) unsigned char lds_raw[];
    Frame F;
    F.lds = (LAS unsigned char*)lds_raw;
    F.MISC = (volatile LAS unsigned*)(F.lds + LDS_MISC);
    const int tid0 = threadIdx.x; F.wave = __builtin_amdgcn_readfirstlane(tid0 >> 6);
    F.G = gridDim.x; { const int bx = blockIdx.x; F.vcu = (F.G % 8 == 0) ? (bx % 8) * (F.G / 8) + bx / 8 : bx; }
    F.ws = args.ws; F.ctl = (unsigned*)(args.ws + WS_CTL);
    if (tid0 < 32) F.MISC[tid0] = 0u;
    __syncthreads();
#if MK_ONE_LAUNCH
    constexpr int lo = 0, hi = N_PHASES;
#else
    const int lo = args.ph_lo, hi = args.ph_hi;
#endif
    XcdBarrier bar; bar.bar = F.ctl + CW_BAR; bar.x = 0; bar.st = nullptr;
    if (hi - lo > 1) bar = xcd_barrier_post(F.ctl + CW_BAR, F.MISC + 8);
    bar.w = F.wave;
#ifndef MK_SITES
#define MK_SITES 0xffffffffu
#endif
#define SITE(n) ((MK_SITES >> (n)) & 1u)
#ifndef MK_REP_MASK
#define MK_REP_MASK 0u
#endif
#define RPT(n) _Pragma("unroll") for (int rep_ = 0; rep_ < 1 + (int)((MK_REP_MASK >> (n)) & 1u); ++rep_)
#define RPB() do { if (rep_) xcd_barrier(bar); } while (0)
#if MK_ONE_LAUNCH
#define IN(k) true
#define SEAM(k) xcd_barrier(bar)
#else
#define IN(k) (lo <= (k) && (k) < hi)
#define SEAM(k) do { if (IN(k) && IN((k) + 1)) xcd_barrier(bar); } while (0)
#endif
    const float* ln_mix_g = args.in[6]; const float* ln_mix_b = args.in[7]; const float* ln_ffn_g = args.in[11]; const float* ln_ffn_b = args.in[12];
    const int bx = (int)blockIdx.x;

    RPT(0) if (SITE(0) && IN(0)) { RPB(); p0_colmax(F, args.in[8], args.in[2]); p0_prologue<0>(F, args); xcd_barrier(bar); p0_prologue<1>(F, args); } SEAM(0);

    for (int pair = 0; pair < 2; ++pair) {
        const int pb = 1 + 17 * pair;
        for (int half = 0; half < 2; ++half) {
            const int l = 2 * pair + half;
            size_t zoff = 0; asm volatile("" : "+s"(zoff));
            unsigned char* ws = args.ws + zoff;
            h16* xb = (h16*)(ws + WS_R2);
            const int pm0 = pb + (half ? 9 : 0);
            int pn_;
            if (half == 0) {
                RPT(1) if (SITE(1) && IN(pm0 + 0)) { RPB();
                    { ProbStd P; P.A = (const char*)xb; P.B = (const char*)(ws + WS_WIN) + (size_t)pair * DIN * D * 2; P.K = D; P.lda = D; P.ldb = D; P.upmap = false; P.S.init(M / 256, 3072 / 256, F.G, bx);
                      EpiIn E{(h16*)(ws + WS_R1), (h16*)(ws + WS_R1 + R1_HQKV), (const float*)(ws + WS_ROPE), (const float*)(ws + WS_ROPE) + 2048 * 64};
                      pg8::gemm_phase<ProbStd, EpiIn>(F.lds, F.wave, P, E); }
                    __syncthreads();
                    { ProbStd P; P.A = (const char*)(ws + WS_X8); P.B = (const char*)(ws + WS_WIN8) + (size_t)pair * 3072 * D; P.K = D / 2; P.lda = D / 2; P.ldb = D / 2; P.upmap = false; P.S.init(M / 256, 3072 / 256, F.G, bx);
                      EpiInQ E{(h16*)(ws + WS_R1 + R1_HQKV), (const float*)(ws + WS_ROPE), (const float*)(ws + WS_ROPE) + 2048 * 64, (const float*)(ws + WS_VEC) + V_SX, (const float*)(ws + WS_VEC) + V_SWQ + pair * 3072};
                      pg8::gemm_phase<ProbStd, EpiInQ, true>(F.lds, F.wave, P, E); }
                }
                SEAM(pm0 + 0);
                RPT(2) if (SITE(2) && IN(pm0 + 1)) { RPB(); attn_phase(F, (h16*)args.out); }
                SEAM(pm0 + 1);
                RPT(3) if (SITE(3) && IN(pm0 + 2)) { RPB(); merge_phase(F, (const h16*)args.out, args.in[3] + (size_t)pair * 3 * CONV); }
                SEAM(pm0 + 2);
                RPT(4) if (SITE(4) && IN(pm0 + 3)) { RPB();
                    ProbStd P; P.A = (const char*)(ws + WS_R1 + R1_HQKV); P.B = (const char*)(ws + WS_WOM) + (size_t)pair * D * D * 2; P.K = D; P.lda = D; P.ldb = D; P.upmap = false; P.S.init(M / 256, D / 256, F.G, bx);
                    EpiRes E{xb, nullptr, nullptr, nullptr};
                    pg8::gemm_phase<ProbStd, EpiRes>(F.lds, F.wave, P, E);
                }
                SEAM(pm0 + 3);
                pn_ = pm0 + 4;
            } else {
                RPT(5) if (SITE(5) && IN(pm0 + 0)) { RPB();
                    ProbDftC P; P.Dm = (const char*)(ws + WS_DM); P.zb = (const char*)xb; P.G = F.G; P.c = bx;
                    EpiDftC E{(h16*)(ws + WS_R1)};
                    pg8::gemm_phase<ProbDftC, EpiDftC>(F.lds, F.wave, P, E);
                }
                SEAM(pm0 + 0);
                RPT(6) if (SITE(6) && IN(pm0 + 1)) { RPB();
                    ProbDftS P; P.Fmat = (const char*)(ws + WS_FMAT); P.Bt = (const char*)(ws + WS_R1); P.G = F.G; P.c = bx;
                    EpiDftS2 E{(h16*)(ws + WS_R1 + R1_F), args.out + (size_t)blockIdx.x * 65536};
                    pg8::gemm_phase<ProbDftS, EpiDftS2>(F.lds, F.wave, P, E);
                    dfts_side(F, (const h16*)(ws + WS_R1), (const h16*)(ws + WS_STATS), (const h16*)(ws + WS_FMAT), (h16*)(ws + WS_R1 + R1_F));
                }
                SEAM(pm0 + 1);
                RPT(7) if (SITE(7) && IN(pm0 + 2)) { RPB();
                    ProbStd P; P.A = (const char*)(ws + WS_R1 + R1_F); P.B = (const char*)(ws + WS_WOF) + (size_t)pair * D * D * 2; P.K = D; P.lda = D; P.ldb = D; P.upmap = false; P.S.init(M / 256, D / 256, F.G, bx);
                    EpiRes E{xb, nullptr, nullptr, nullptr};
                    pg8::gemm_phase<ProbStd, EpiRes>(F.lds, F.wave, P, E);
                }
                SEAM(pm0 + 2);
                pn_ = pm0 + 3;
            }
            RPT(8) if (SITE(8) && IN(pn_)) { RPB(); norm_phase_x8<true>(F, xb, (signed char*)(ws + WS_X8), (float*)(ws + WS_VEC) + V_SX, ln_mix_g + l * D, ln_mix_b + l * D, (float*)(ws + WS_LSE)); }
            SEAM(pn_);
            const int pf = pn_ + 1;
            const bool i8 = (kI8Mask >> l) & 1u;
            const char* Wup = i8 ? (const char*)(ws + WS_W8) + (size_t)l * FF2 * D : (const char*)(ws + WS_WUP) + (size_t)l * FF2 * D * 2;
            const float* swl = (const float*)(ws + WS_VEC) + V_SW + l * FF2; const float* sxv = (const float*)(ws + WS_VEC) + V_SX;
            RPT(9) if (SITE(9) && IN(pf + 0)) { RPB();
                if (kI8Mask == 0xFu || (kI8Mask != 0u && i8)) { ProbHalo P; P.A = (const char*)(ws + WS_X8); P.B = Wup; P.K = D / 2; P.lda = D / 2; P.ldb = D / 2; P.G = F.G; P.c = bx;
                    EpiHalo<true> E{(float*)(ws + WS_HALO), sxv, swl};
                    pg8::gemm_phase<ProbHalo, EpiHalo<true>, true>(F.lds, F.wave, P, E); }
                else if constexpr (kI8Mask != 0xFu) { ProbHalo P; P.A = (const char*)xb; P.B = Wup; P.K = D; P.lda = D; P.ldb = D; P.G = F.G; P.c = bx;
                    EpiHalo<false> E{(float*)(ws + WS_HALO), sxv, swl};
                    pg8::gemm_phase<ProbHalo, EpiHalo<false>, false>(F.lds, F.wave, P, E); }
            }
            SEAM(pf + 0);
            RPT(10) if (SITE(10) && IN(pf + 1)) { RPB();
                if (kI8Mask == 0xFu || (kI8Mask != 0u && i8)) { ProbStd P; P.A = (const char*)(ws + WS_X8); P.B = Wup; P.K = D / 2; P.lda = D / 2; P.ldb = D / 2; P.upmap = true; P.S.init(M / 256, FF2 / 256, F.G, bx);
                    EpiUp<true> E{(h16*)(ws + WS_R1), (const float*)(ws + WS_HALO), args.in[9] + (size_t)l * 3 * FF2, sxv, swl};
                    pg8::gemm_phase<ProbStd, EpiUp<true>, true>(F.lds, F.wave, P, E); }
                else if constexpr (kI8Mask != 0xFu) { ProbStd P; P.A = (const char*)xb; P.B = Wup; P.K = D; P.lda = D; P.ldb = D; P.upmap = true; P.S.init(M / 256, FF2 / 256, F.G, bx);
                    EpiUp<false> E{(h16*)(ws + WS_R1), (const float*)(ws + WS_HALO), args.in[9] + (size_t)l * 3 * FF2, sxv, swl};
                    pg8::gemm_phase<ProbStd, EpiUp<false>, false>(F.lds, F.wave, P, E); }
            }
            SEAM(pf + 1);
            const bool d8 = (kD8Mask >> l) & 1u;
            if (kD8Mask != 0u && d8) { actq_phase(F, (const h16*)(ws + WS_R1), (signed char*)args.out, (float*)(ws + WS_VEC) + V_SA); xcd_barrier(bar); }
            RPT(11) if (SITE(11) && IN(pf + 2)) { RPB();
                if (kD8Mask != 0u && d8) {
                    ProbStd P; P.A = (const char*)args.out; P.B = (const char*)(ws + WS_WDN8) + (size_t)l * D * FF; P.K = FF / 2; P.lda = FF / 2; P.ldb = FF / 2; P.upmap = false; P.S.init(M / 256, D / 256, F.G, bx);
                    EpiResT<true, true> E{xb, (const float*)(ws + WS_LSE), ln_mix_g + l * D, ln_mix_b + l * D, (const float*)(ws + WS_VEC) + V_SA, (const float*)(ws + WS_VEC) + V_SWD + l * D};
                    pg8::gemm_phase<ProbStd, EpiResT<true, true>, true>(F.lds, F.wave, P, E);
                } else if constexpr (kD8Mask != 0xFu) {
                    ProbStd P; P.A = (const char*)(ws + WS_R1); P.B = (const char*)(ws + WS_WDN) + (size_t)l * D * FF * 2; P.K = FF; P.lda = FF; P.ldb = FF; P.upmap = false; P.S.init(M / 256, D / 256, F.G, bx);
                    EpiResT<true> E{xb, (const float*)(ws + WS_LSE), ln_mix_g + l * D, ln_mix_b + l * D};
                    pg8::gemm_phase<ProbStd, EpiResT<true>>(F.lds, F.wave, P, E);
                }
            }
            SEAM(pf + 2);
            if (l < 3) { RPT(12) if (SITE(12) && IN(pf + 3)) { RPB(); if (half == 0) norm_phase<false, true>(F, xb, args.out, ln_ffn_g + l * D, ln_ffn_b + l * D, (h16*)(ws + WS_STATS)); else norm_phase_x8<false>(F, xb, (signed char*)(ws + WS_X8), (float*)(ws + WS_VEC) + V_SX, ln_ffn_g + l * D, ln_ffn_b + l * D, nullptr); } SEAM(pf + 3); }
            else { RPT(13) if (SITE(13) && IN(pf + 3)) norm_phase<true>(F, xb, args.out, ln_ffn_g + l * D, ln_ffn_b + l * D); }
        }
    }
#undef IN
#undef SEAM
}

extern "C" void kernel_launch(void* const* d_in, const int* in_sizes, int n_in, void* d_out, int out_size, void* d_ws, size_t ws_size, hipStream_t stream) {
    static int grid = 0;
    if (grid == 0) {
        if (n_in != 13 || out_size != M * D || ws_size < WS_END) { fprintf(stderr, "kernel_launch: unexpected problem (n_in %d, out %d, ws %zu)\n", n_in, out_size, ws_size); grid = -1; return; }
        int dev = 0, cus = 0, per_cu = 0;
        if (hipGetDevice(&dev) != hipSuccess || hipDeviceGetAttribute(&cus, hipDeviceAttributeMultiprocessorCount, dev) != hipSuccess) { grid = -1; return; }
        if (hipFuncSetAttribute((const void*)mk_fwd, hipFuncAttributeMaxDynamicSharedMemorySize, LDS_BYTES) != hipSuccess) { fprintf(stderr, "kernel_launch: hipFuncSetAttribute failed\n"); grid = -1; return; }
        if (hipOccupancyMaxActiveBlocksPerMultiprocessor(&per_cu, (const void*)mk_fwd, 512, LDS_BYTES) != hipSuccess || per_cu < 1) { fprintf(stderr, "kernel_launch: occupancy query says %d\n", per_cu); }
        (void)hipGetLastError();
        grid = cus;
    }
    if (grid < 0) return;
    (void)hipMemsetAsync((char*)d_ws + WS_CTL, 0, CTL_ZERO_BYTES, stream);
    Args a{};
    for (int i = 0; i < 13; ++i) a.in[i] = (const float*)d_in[i];
    a.out = (float*)d_out; a.ws = (unsigned char*)d_ws;
#if MK_ONE_LAUNCH
    a.ph_lo = 0; a.ph_hi = N_PHASES;
    hipLaunchKernelGGL(mk_fwd, dim3(grid), dim3(512), LDS_BYTES, stream, a);
#else
    for (int k = 0; k < N_PHASES; ++k) { a.ph_lo = k; a.ph_hi = k + 1; hipLaunchKernelGGL(mk_fwd, dim3(grid), dim3(512), LDS_BYTES, stream, a); }
#endif
}
```

```cpp
#include <hip/hip_runtime.h>
#include <cstdio>
#include <cstdint>

#ifndef MK_ONE_LAUNCH
#define MK_ONE_LAUNCH 1
#endif

#define LAS __attribute__((address_space(3)))
#define GAS __attribute__((address_space(1)))
typedef _Float16 h16;
typedef _Float16 h16x8 __attribute__((ext_vector_type(8)));
typedef _Float16 h16x4 __attribute__((ext_vector_type(4)));
typedef _Float16 h16x2 __attribute__((ext_vector_type(2)));
typedef float f32x4 __attribute__((ext_vector_type(4)));
typedef float f32x2 __attribute__((ext_vector_type(2)));
typedef unsigned u32x4 __attribute__((ext_vector_type(4)));
typedef unsigned u32x2 __attribute__((ext_vector_type(2)));
typedef short s16x4 __attribute__((ext_vector_type(4)));

constexpr int D = 2048, SEQ = 2048, NSEQ = 24, M = NSEQ * SEQ;
constexpr int M_PROMPT = 16 * SEQ;
constexpr int CONV = 1024, ATT = 1024, NH = 8, HD = 128, DIN = 6144, FF = 5632, FF2 = 11264;
constexpr int NHALO = 2 * (M / 128);
constexpr float ALPHA = 1.6817928305074290861f;
constexpr float LN_EPS = 1e-5f;
constexpr float QSCALE = 0.08838834764831844055f * 1.44269504088896341f;

constexpr size_t MiB = 1u << 20;
constexpr size_t WS_CTL = 0, CTL_ZERO_BYTES = 256 * 1024;
constexpr size_t WS_ROPE = 1 * MiB;
constexpr size_t WS_VEC = 2 * MiB;
constexpr size_t WS_PART = 3 * MiB;
constexpr size_t WS_STATS = 19 * MiB;
constexpr size_t WS_LSE = 27 * MiB;
constexpr size_t WS_HALO = 32 * MiB;
constexpr size_t WS_FMAT = 66 * MiB;
constexpr size_t WS_DM = 82 * MiB;
constexpr size_t WS_WIN = 90 * MiB;
constexpr size_t WS_WOM = 138 * MiB;
constexpr size_t WS_WOF = 154 * MiB;
constexpr size_t WS_WUP = 170 * MiB;
constexpr size_t WS_WDN = 346 * MiB;
constexpr size_t WS_R2 = 434 * MiB;
constexpr size_t WS_R1 = 722 * MiB;
constexpr size_t WS_X8 = 1298 * MiB;
constexpr size_t WS_W8 = 1394 * MiB;
constexpr size_t WS_END = 1482 * MiB;
constexpr size_t WS_WDN8 = WS_WUP + 16 * MiB;
constexpr size_t WS_WIN8 = WS_WUP;
#ifndef I8MASK
#define I8MASK 0xF
#endif
constexpr unsigned kI8Mask = I8MASK;
constexpr size_t R1_HQKV = (size_t)M * 3072 * 2;
constexpr int BTP = 4096 + 64;
constexpr size_t R1_F = (size_t)NSEQ * 2048 * 4096 * 2;
constexpr int V_CSUM_IN = 0, V_BIAS_IN = V_CSUM_IN + 2 * DIN, V_CSUM_UP = V_BIAS_IN + 2 * DIN, V_BIAS_UP = V_CSUM_UP + 4 * FF2,
              V_CSUM_D = V_BIAS_UP + 4 * FF2, V_BIAS_D = V_CSUM_D + 2 * 4 * 1024, V_ONES = V_BIAS_D + 2 * 4 * 1024, V_ZEROS = V_ONES + D, V_END = V_ZEROS + D;
static_assert(V_END * 4 <= (int)MiB, "vector region");
constexpr int V_SW = 0;
constexpr int V_SX = 65536;
constexpr int V_SWQ = 4 * FF2;
constexpr int PM_STRIDE = 4 * FF2 + 2 * 3072;
constexpr int V_SWD = V_SWQ + 2 * 3072;
constexpr int V_SA = 131072;
static_assert(V_SWD + 4 * D <= V_SX && (V_SX + M) <= V_SA && (V_SA + M) * 4 <= (int)MiB, "scale vectors");
#ifndef D8MASK
#define D8MASK 0x7
#endif
constexpr unsigned kD8Mask = D8MASK;
static_assert(MK_ONE_LAUNCH || kD8Mask == 0u, "the activation-quantisation phase has no phase id of its own");
__host__ __device__ constexpr size_t part_off(int mi) { return mi < 2 ? (size_t)mi * 32 * 2 * DIN : (size_t)2 * 32 * 2 * DIN + (size_t)(mi - 2) * 32 * 2 * FF2; }
static_assert(part_off(6) * 4 <= 16 * MiB, "partial region");

constexpr int CW_BAR = 1024;
constexpr int CW_SMAX = 16384;
constexpr int LDS_BYTES = 147456;
constexpr int LDS_TAB = 131072;
constexpr int LDS_RED = 133120;
constexpr int LDS_MISC = LDS_BYTES - 128;
constexpr int ATT_K = 0, ATT_V = 65536;
static_assert(ATT_V + 272 * 256 <= LDS_MISC, "attention LDS");

__device__ __forceinline__ unsigned pk_h2(float lo, float hi) { f32x2 v = {lo, hi}; h16x2 h = __builtin_convertvector(v, h16x2); return __builtin_bit_cast(unsigned, h); }
__device__ __forceinline__ int mk_lane() { int l; asm volatile("v_mbcnt_lo_u32_b32 %0, -1, 0\n\tv_mbcnt_hi_u32_b32 %0, -1, %0" : "=v"(l)); return l; }
template <int O> __device__ __forceinline__ float shx(float v) {
    if constexpr (O < 32) return __builtin_bit_cast(float, __builtin_amdgcn_ds_swizzle(__builtin_bit_cast(int, v), (O << 10) | 0x1f));
    else return __builtin_bit_cast(float, __builtin_amdgcn_ds_bpermute((mk_lane() ^ 32) << 2, __builtin_bit_cast(int, v)));
}
template <int CTRL, int RM> __device__ __forceinline__ float dpp_f(float ident, float v) {
    return __builtin_bit_cast(float, __builtin_amdgcn_update_dpp(__builtin_bit_cast(int, ident), __builtin_bit_cast(int, v), CTRL, RM, 0xF, false));
}
__device__ __forceinline__ float wave_sum(float v) {
    v += dpp_f<0xB1, 0xF>(0.f, v); v += dpp_f<0x4E, 0xF>(0.f, v); v += dpp_f<0x141, 0xF>(0.f, v); v += dpp_f<0x140, 0xF>(0.f, v);
    v += dpp_f<0x142, 0xA>(0.f, v); v += dpp_f<0x143, 0xC>(0.f, v);
    return __builtin_bit_cast(float, __builtin_amdgcn_readlane(__builtin_bit_cast(int, v), 63));
}
__device__ __forceinline__ float wave_max(float v) {
    v = fmaxf(v, dpp_f<0xB1, 0xF>(0.f, v)); v = fmaxf(v, dpp_f<0x4E, 0xF>(0.f, v)); v = fmaxf(v, dpp_f<0x141, 0xF>(0.f, v)); v = fmaxf(v, dpp_f<0x140, 0xF>(0.f, v));
    v = fmaxf(v, dpp_f<0x142, 0xA>(0.f, v)); v = fmaxf(v, dpp_f<0x143, 0xC>(0.f, v));
    return __builtin_bit_cast(float, __builtin_amdgcn_readlane(__builtin_bit_cast(int, v), 63));
}
__device__ __forceinline__ void rot128(float (&v)[8], float s1, float s2, float s3, float s4) {
#pragma unroll
    for (int h = 1; h < 8; h <<= 1)
#pragma unroll
        for (int i = 0; i < 8; ++i) if ((i & h) == 0) { const float a = v[i], b = v[i + h]; v[i] = a + b; v[i + h] = a - b; }
    asm volatile(
        "s_nop 1\n\t"
        "v_fmac_f32_dpp %0, %0, %8 quad_perm:[1,0,3,2] row_mask:0xf bank_mask:0xf\n\t"
        "v_fmac_f32_dpp %1, %1, %8 quad_perm:[1,0,3,2] row_mask:0xf bank_mask:0xf\n\t"
        "v_fmac_f32_dpp %2, %2, %8 quad_perm:[1,0,3,2] row_mask:0xf bank_mask:0xf\n\t"
        "v_fmac_f32_dpp %3, %3, %8 quad_perm:[1,0,3,2] row_mask:0xf bank_mask:0xf\n\t"
        "v_fmac_f32_dpp %4, %4, %8 quad_perm:[1,0,3,2] row_mask:0xf bank_mask:0xf\n\t"
        "v_fmac_f32_dpp %5, %5, %8 quad_perm:[1,0,3,2] row_mask:0xf bank_mask:0xf\n\t"
        "v_fmac_f32_dpp %6, %6, %8 quad_perm:[1,0,3,2] row_mask:0xf bank_mask:0xf\n\t"
        "v_fmac_f32_dpp %7, %7, %8 quad_perm:[1,0,3,2] row_mask:0xf bank_mask:0xf\n\t"
        "v_fmac_f32_dpp %0, %0, %9 quad_perm:[2,3,0,1] row_mask:0xf bank_mask:0xf\n\t"
        "v_fmac_f32_dpp %1, %1, %9 quad_perm:[2,3,0,1] row_mask:0xf bank_mask:0xf\n\t"
        "v_fmac_f32_dpp %2, %2, %9 quad_perm:[2,3,0,1] row_mask:0xf bank_mask:0xf\n\t"
        "v_fmac_f32_dpp %3, %3, %9 quad_perm:[2,3,0,1] row_mask:0xf bank_mask:0xf\n\t"
        "v_fmac_f32_dpp %4, %4, %9 quad_perm:[2,3,0,1] row_mask:0xf bank_mask:0xf\n\t"
        "v_fmac_f32_dpp %5, %5, %9 quad_perm:[2,3,0,1] row_mask:0xf bank_mask:0xf\n\t"
        "v_fmac_f32_dpp %6, %6, %9 quad_perm:[2,3,0,1] row_mask:0xf bank_mask:0xf\n\t"
        "v_fmac_f32_dpp %7, %7, %9 quad_perm:[2,3,0,1] row_mask:0xf bank_mask:0xf\n\t"
        "v_fmac_f32_dpp %0, %0, %10 row_half_mirror row_mask:0xf bank_mask:0xf\n\t"
        "v_fmac_f32_dpp %1, %1, %10 row_half_mirror row_mask:0xf bank_mask:0xf\n\t"
        "v_fmac_f32_dpp %2, %2, %10 row_half_mirror row_mask:0xf bank_mask:0xf\n\t"
        "v_fmac_f32_dpp %3, %3, %10 row_half_mirror row_mask:0xf bank_mask:0xf\n\t"
        "v_fmac_f32_dpp %4, %4, %10 row_half_mirror row_mask:0xf bank_mask:0xf\n\t"
        "v_fmac_f32_dpp %5, %5, %10 row_half_mirror row_mask:0xf bank_mask:0xf\n\t"
        "v_fmac_f32_dpp %6, %6, %10 row_half_mirror row_mask:0xf bank_mask:0xf\n\t"
        "v_fmac_f32_dpp %7, %7, %10 row_half_mirror row_mask:0xf bank_mask:0xf\n\t"
        "v_fmac_f32_dpp %0, %0, %11 row_mirror row_mask:0xf bank_mask:0xf\n\t"
        "v_fmac_f32_dpp %1, %1, %11 row_mirror row_mask:0xf bank_mask:0xf\n\t"
        "v_fmac_f32_dpp %2, %2, %11 row_mirror row_mask:0xf bank_mask:0xf\n\t"
        "v_fmac_f32_dpp %3, %3, %11 row_mirror row_mask:0xf bank_mask:0xf\n\t"
        "v_fmac_f32_dpp %4, %4, %11 row_mirror row_mask:0xf bank_mask:0xf\n\t"
        "v_fmac_f32_dpp %5, %5, %11 row_mirror row_mask:0xf bank_mask:0xf\n\t"
        "v_fmac_f32_dpp %6, %6, %11 row_mirror row_mask:0xf bank_mask:0xf\n\t"
        "v_fmac_f32_dpp %7, %7, %11 row_mirror row_mask:0xf bank_mask:0xf\n\t"
        : "+v"(v[0]), "+v"(v[1]), "+v"(v[2]), "+v"(v[3]), "+v"(v[4]), "+v"(v[5]), "+v"(v[6]), "+v"(v[7])
        : "v"(s1), "v"(s2), "v"(s3), "v"(s4));
}
__device__ __forceinline__ u32x2 pack8_i8(float a0, float a1, float a2, float a3, float a4, float a5, float a6, float a7, float inv) {
    const unsigned b0 = __builtin_bit_cast(unsigned, __builtin_fmaf(a0, inv, 12582912.0f)), b1 = __builtin_bit_cast(unsigned, __builtin_fmaf(a1, inv, 12582912.0f)),
                   b2 = __builtin_bit_cast(unsigned, __builtin_fmaf(a2, inv, 12582912.0f)), b3 = __builtin_bit_cast(unsigned, __builtin_fmaf(a3, inv, 12582912.0f)),
                   b4 = __builtin_bit_cast(unsigned, __builtin_fmaf(a4, inv, 12582912.0f)), b5 = __builtin_bit_cast(unsigned, __builtin_fmaf(a5, inv, 12582912.0f)),
                   b6 = __builtin_bit_cast(unsigned, __builtin_fmaf(a6, inv, 12582912.0f)), b7 = __builtin_bit_cast(unsigned, __builtin_fmaf(a7, inv, 12582912.0f));
    u32x2 o;
    o.x = __builtin_amdgcn_perm(b1, b0, 0x0c0c0400u) | __builtin_amdgcn_perm(b3, b2, 0x04000c0cu);
    o.y = __builtin_amdgcn_perm(b5, b4, 0x0c0c0400u) | __builtin_amdgcn_perm(b7, b6, 0x04000c0cu);
    return o;
}
__device__ __forceinline__ float rowq_rot(const h16x8 (&in)[11], signed char* dst, int lane) {
    const float s1 = (lane & 1) ? -1.0f : 1.0f, s2 = (lane & 2) ? -1.0f : 1.0f, s3 = (lane & 4) ? -1.0f : 1.0f, s4 = (lane & 8) ? -1.0f : 1.0f;
    float v[11][8]; float amax = 0.f;
#pragma unroll
    for (int j = 0; j < 11; ++j) {
#pragma unroll
        for (int e = 0; e < 8; ++e) v[j][e] = (float)in[j][e];
        rot128(v[j], s1, s2, s3, s4);
#pragma unroll
        for (int e = 0; e < 8; ++e) amax = fmaxf(amax, fabsf(v[j][e]));
    }
    amax = wave_max(amax);
    const float inv = amax > 0.f ? 127.0f / amax : 0.f;
#pragma unroll
    for (int j = 0; j < 11; ++j) *(u32x2*)(dst + 512 * j + 8 * lane) = pack8_i8(v[j][0], v[j][1], v[j][2], v[j][3], v[j][4], v[j][5], v[j][6], v[j][7], inv);
    return amax * (1.0f / 127.0f);
}
#define LDS_FENCE_BAR() do { asm volatile("s_waitcnt lgkmcnt(0)" ::: "memory"); __builtin_amdgcn_s_barrier(); asm volatile("" ::: "memory"); } while (0)

#define XB_TMO      128
#define XB_XCNT(j)  (256  + 64 * (j))
#define XB_XSUB(j)  (1280 + 64 * (j))
#define XB_XGEN(j)  (2304 + 64 * (j))
#define XB_TOP      3328
#define XB_TOPGEN   3392
#define XCD_BAR_WORDS 3456
#define XB_SPIN_CAP (1u << 22)
static_assert(kI8Mask == 0xFu, "WS_WIN8 lives in the fp16 up-weight region");
static_assert(CW_BAR + XCD_BAR_WORDS <= CW_SMAX && (CW_SMAX + 4 * FF2) * 4 <= (int)CTL_ZERO_BYTES, "control words inside the memset region");
__device__ __forceinline__ unsigned xb_ld(unsigned* p)              { return __hip_atomic_load(p, __ATOMIC_RELAXED, __HIP_MEMORY_SCOPE_AGENT); }
__device__ __forceinline__ unsigned xb_add(unsigned* p, unsigned v) { return __hip_atomic_fetch_add(p, v, __ATOMIC_RELAXED, __HIP_MEMORY_SCOPE_AGENT); }
__device__ __forceinline__ unsigned xb_xcc_id() { return (unsigned)__builtin_amdgcn_s_getreg((3 << 11) | 20) & 0xFu; }
#define XB_SPIN(cond, bar) do { unsigned _sp = 0; while (cond) { __builtin_amdgcn_s_sleep(1); \
    if ((++_sp & 255u) == 0u) { if (xb_ld(&(bar)[XB_TMO])) break; if (_sp > XB_SPIN_CAP) { atomicAdd(&(bar)[XB_TMO], 1u); break; } } } } while (0)
struct XcdBarrier { unsigned* bar; unsigned x; volatile LAS unsigned* st; int w; };
__device__ __forceinline__ XcdBarrier xcd_barrier_post(unsigned* bar, volatile LAS unsigned* st) {
    XcdBarrier b; b.bar = bar; b.x = xb_xcc_id(); b.st = st; b.w = 0;
    if (threadIdx.x == 0) (void)xb_add(&bar[XB_XCNT(b.x)], 1u);
    return b;
}
__device__ __forceinline__ void xcd_barrier_complete(unsigned* bar, unsigned x, unsigned& nloc, unsigned& nx) {
    const unsigned G = gridDim.x * gridDim.y * gridDim.z;
    unsigned sum, cnt, mine, sp = 0u;
    for (;;) {
        sum = 0u; cnt = 0u; mine = 0u;
#pragma unroll
        for (unsigned j = 0; j < 16; ++j) { const unsigned c = xb_ld(&bar[XB_XCNT(j)]); sum += c; cnt += (c > 0u) ? 1u : 0u; mine = (j == x) ? c : mine; }
        if (sum == G) break;
        __builtin_amdgcn_s_sleep(1);
        if ((++sp & 255u) == 0u) { if (xb_ld(&bar[XB_TMO])) break; if (sp > XB_SPIN_CAP) { atomicAdd(&bar[XB_TMO], 1u); break; } }
    }
    nloc = mine > 0u ? mine : 1u; nx = cnt > 0u ? cnt : 1u;
}
__device__ __forceinline__ void xcd_barrier(const XcdBarrier& b) {
    asm volatile("s_waitcnt vmcnt(0)" ::: "memory");
    __syncthreads();
    if (b.w == 0 && mk_lane() == 0) {
        unsigned* bar = b.bar;
        __builtin_amdgcn_s_waitcnt(0);
        unsigned nloc = b.st[0], nx = b.st[1];
        if (nloc == 0u) { xcd_barrier_complete(bar, b.x, nloc, nx); b.st[0] = nloc; b.st[1] = nx; }
        const unsigned old = xb_add(&bar[XB_XSUB(b.x)], 1u);
        const unsigned gen = old / nloc;
        if (old + 1u == (gen + 1u) * nloc) {
            __builtin_amdgcn_fence(__ATOMIC_RELEASE, "agent");
            asm volatile("s_waitcnt vmcnt(0)" ::: "memory");
            const unsigned og = xb_add(&bar[XB_TOP], 1u);
            const unsigned tg = og / nx;
            if (og + 1u == (tg + 1u) * nx) xb_add(&bar[XB_TOPGEN], 1u);
            else XB_SPIN(xb_ld(&bar[XB_TOPGEN]) == tg, bar);
            __builtin_amdgcn_fence(__ATOMIC_ACQUIRE, "agent");
            xb_add(&bar[XB_XGEN(b.x)], 1u);
            asm volatile("s_waitcnt vmcnt(0)" ::: "memory");
        } else {
            XB_SPIN(xb_ld(&bar[XB_XGEN(b.x)]) == gen, bar);
            __builtin_amdgcn_fence(__ATOMIC_ACQUIRE, "agent");
            asm volatile("s_waitcnt vmcnt(0)" ::: "memory");
        }
    }
    __syncthreads();
}

namespace pg8 {
constexpr int BM = 256, BK = 64, HALF = 128, HTB = HALF * BK * 2, STAGE_BYTES = 8 * HTB, NXCD = 8, WGM = 4;
__device__ __forceinline__ int lds_byte(int r, int c) { const int st = (r >> 4) * 2 + (c >> 5), rr = r & 15, cc = c & 31, ob = rr * 64 + cc * 2; return st * 1024 + (ob ^ (((ob >> 9) & 1) << 5)); }
__device__ __forceinline__ void stage_rc(int b, int& R, int& C) { const int st = b / 1024, sb = b % 1024, swz = sb ^ (((sb >> 9) & 1) << 5); R = (st >> 1) * 16 + swz / 64; C = (st & 1) * 32 + (swz % 64) / 2; }
__device__ __forceinline__ int perm32(int rho) { const int n = rho >> 4, i = rho & 15; return 8 * (i >> 2) + 4 * n + (i & 3); }
struct Unit { int pm, pn, g; int part, keep; };
typedef f32x4 Acc[2][2][4][2];
__device__ __forceinline__ void glds16_s(const void* sbase, unsigned voff, unsigned lds_dst) {
    unsigned keep;
    asm volatile("s_mov_b32 %0, m0\n\ts_mov_b32 m0, %3\n\ts_nop 0\n\tglobal_load_lds_dwordx4 %1, %2\n\ts_mov_b32 m0, %0" : "=&s"(keep) : "v"(voff), "s"(sbase), "s"(lds_dst) : "memory");
}

struct StaticOrder {
    int nM, nN, nwg, G, c;
    __device__ void init(int nM_, int nN_, int G_, int c_) { nM = nM_; nN = nN_; nwg = nM * nN; G = G_; c = c_; }
    __device__ bool next(int i, Unit& u) const {
        const long L = (long)i * G + c; if (L >= nwg) return false;
        int wgid = (int)L; { const int q = nwg / NXCD, r = nwg % NXCD, xcd = wgid % NXCD, off = wgid / NXCD; wgid = (xcd < r ? xcd * (q + 1) : r * (q + 1) + (xcd - r) * q) + off; }
        const int nig = WGM * nN, gid = wgid / nig, fm = gid * WGM, gsz = (nM - fm) < WGM ? (nM - fm) : WGM;
        u.pm = fm + ((wgid % nig) % gsz); u.pn = (wgid % nig) / gsz; u.g = 0; u.part = 0; u.keep = 0; return true;
    }
};

typedef int i32x4 __attribute__((ext_vector_type(4)));
template <bool I8> __device__ __forceinline__ f32x4 mma_step(const h16x8& b, const h16x8& a, const f32x4& c) {
    if constexpr (I8) return __builtin_bit_cast(f32x4, __builtin_amdgcn_mfma_i32_16x16x64_i8(__builtin_bit_cast(i32x4, b), __builtin_bit_cast(i32x4, a), __builtin_bit_cast(i32x4, c), 0, 0, 0));
    else return __builtin_amdgcn_mfma_f32_16x16x32_f16(b, a, c, 0, 0, 0);
}
template <class Prob, class Epi, bool I8 = false, bool ALIGN_EPI = true, bool SP2 = true>
__device__ __forceinline__ void gemm_phase(LAS unsigned char* lds, int wave, const Prob& P, const Epi& E) {
    const int tid_ = wave * 64 + mk_lane();
    const int tid = tid_, wid = __builtin_amdgcn_readfirstlane(tid >> 6), lane = tid & 63, wr = wid >> 2, wc = wid & 3, fr = lane & 15, fq = lane >> 4;
    const int K = P.K, nt = K / BK;
    unsigned voffA[2], voffB[2];
#pragma unroll
    for (int i = 0; i < 2; ++i) { int R, C; stage_rc(tid * 16 + i * 8192, R, C); const int Rb = (R & ~31) + perm32(R & 31);
        voffA[i] = P.a_rowoff(R) + (unsigned)C * 2u; voffB[i] = P.b_rowoff(Rb) + (unsigned)C * 2u; }
    const size_t kstep = (size_t)(BK * 2);
    const size_t hstepA = P.a_hstep(), hstepB = P.b_hstep();
    const unsigned ldsw = (unsigned)wid * 1024u;
    const unsigned ldsb = (unsigned)(size_t)lds + ldsw;
    const int aoff = lds_byte(wr * 64 + fr, fq * 8), boff = lds_byte(wc * 32 + fr, fq * 8);
#define PG8_SA(b, h) (((b) * 2 + (h)) * HTB)
#define PG8_SB(b, h) ((4 + (b) * 2 + (h)) * HTB)
#define PG8_STAGE(bufoff, gbase, voff) do { _Pragma("unroll") for (int _i = 0; _i < 2; ++_i) glds16_s((gbase), (voff)[_i], ldsb + (unsigned)((bufoff) + _i * 8192)); } while (0)
#define PG8_LDA(dst, b, h) do { _Pragma("unroll") for (int m = 0; m < 4; ++m) _Pragma("unroll") for (int k = 0; k < 2; ++k) dst[m][k] = *(const LAS h16x8*)(lds + PG8_SA(b, h) + aoff + m * 2048 + k * 1024); } while (0)
#define PG8_LDB(dst, b, h) do { _Pragma("unroll") for (int n = 0; n < 2; ++n) _Pragma("unroll") for (int k = 0; k < 2; ++k) dst[n][k] = *(const LAS h16x8*)(lds + PG8_SB(b, h) + boff + n * 2048 + k * 1024); } while (0)
#define PG8_MMA(ai, bj, At, Bt) do { __builtin_amdgcn_s_setprio(1); _Pragma("unroll") for (int m = 0; m < 4; ++m) _Pragma("unroll") for (int n = 0; n < 2; ++n) _Pragma("unroll") for (int k = 0; k < 2; ++k) \
        acc[ai][bj][m][n] = mma_step<I8>(Bt[n][k], At[m][k], acc[ai][bj][m][n]); __builtin_amdgcn_s_setprio(0); } while (0)
#define PG8_WAIT_V(n) asm volatile("s_waitcnt vmcnt(" #n ")" ::: "memory")
#define PG8_WAIT_L(n) asm volatile("s_waitcnt lgkmcnt(" #n ")" ::: "memory")
#define PG8_BAR __builtin_amdgcn_s_barrier()
#define PG8_SCHED __builtin_amdgcn_sched_barrier(0)
    Unit cur, nxt; int ui = 0;
    if (!P.next(0, cur)) return;
    Acc acc;
#pragma unroll
    for (int a = 0; a < 2; ++a)
#pragma unroll
        for (int b = 0; b < 2; ++b)
#pragma unroll
            for (int m = 0; m < 4; ++m)
#pragma unroll
                for (int n = 0; n < 2; ++n) acc[a][b][m][n] = (f32x4){0.f, 0.f, 0.f, 0.f};
    h16x8 At[4][2], B0[2][2], B1[2][2];
    const char* cA = P.a_tile(cur); const char* cB = P.b_tile(cur);
    if constexpr (SP2) {
        PG8_STAGE(PG8_SB(0, 0), cB, voffB); PG8_STAGE(PG8_SB(0, 1), cB + hstepB, voffB); PG8_STAGE(PG8_SA(0, 0), cA, voffA); PG8_STAGE(PG8_SA(0, 1), cA + hstepA, voffA);
        if (wr == 1) PG8_BAR;
        PG8_WAIT_V(2); PG8_BAR;
        PG8_STAGE(PG8_SB(1, 0), cB + kstep, voffB); PG8_STAGE(PG8_SA(1, 0), cA + kstep, voffA); PG8_STAGE(PG8_SB(1, 1), cB + hstepB + kstep, voffB);
        PG8_WAIT_V(6); PG8_BAR;
    } else {
        PG8_STAGE(PG8_SB(0, 0), cB, voffB); PG8_STAGE(PG8_SA(0, 0), cA, voffA); PG8_STAGE(PG8_SB(0, 1), cB + hstepB, voffB); PG8_STAGE(PG8_SA(0, 1), cA + hstepA, voffA);
        if (wr == 1) PG8_BAR;
        PG8_WAIT_V(4); PG8_BAR;
        PG8_STAGE(PG8_SB(1, 0), cB + kstep, voffB); PG8_STAGE(PG8_SA(1, 0), cA + kstep, voffA); PG8_STAGE(PG8_SB(1, 1), cB + hstepB + kstep, voffB);
        PG8_WAIT_V(6); PG8_BAR;
    }
    for (;;) {
        const bool has_next = P.next(ui + 1, nxt);
        const char* nA = has_next ? P.a_tile(nxt) : cA; const char* nB = has_next ? P.b_tile(nxt) : cB;
        for (int t = 0; t < nt; t += 2) {
            const bool last = (t == nt - 2);
            const char* a1 = cA + (size_t)(t + 1) * kstep;
            const char* a2 = last ? nA : cA + (size_t)(t + 2) * kstep; const char* b2 = last ? nB : cB + (size_t)(t + 2) * kstep;
            const char* a3 = a2 + kstep; const char* b3 = b2 + kstep;
            if constexpr (SP2) {
            PG8_LDB(B0, 0, 0); PG8_LDB(B1, 0, 1); PG8_SCHED; PG8_LDA(At, 0, 0); PG8_STAGE(PG8_SA(1, 1), a1 + hstepA, voffA);
            PG8_WAIT_V(8); PG8_WAIT_L(0); PG8_BAR; PG8_MMA(0, 0, At, B0); PG8_MMA(0, 1, At, B1); PG8_BAR; PG8_SCHED;
            PG8_LDA(At, 0, 1); PG8_STAGE(PG8_SB(0, 0), b2, voffB); PG8_STAGE(PG8_SB(0, 1), b2 + hstepB, voffB); PG8_STAGE(PG8_SA(0, 0), a2, voffA);
            PG8_WAIT_V(8); PG8_WAIT_L(0); PG8_BAR; PG8_MMA(1, 0, At, B0); PG8_MMA(1, 1, At, B1); PG8_BAR; PG8_SCHED;
            PG8_LDB(B0, 1, 0); PG8_LDB(B1, 1, 1); PG8_SCHED; PG8_LDA(At, 1, 0); PG8_STAGE(PG8_SA(0, 1), a2 + hstepA, voffA);
            PG8_WAIT_V(8); PG8_WAIT_L(0); PG8_BAR; PG8_MMA(0, 0, At, B0); PG8_MMA(0, 1, At, B1); PG8_BAR; PG8_SCHED;
            PG8_LDA(At, 1, 1); PG8_STAGE(PG8_SB(1, 0), b3, voffB); PG8_STAGE(PG8_SB(1, 1), b3 + hstepB, voffB); PG8_STAGE(PG8_SA(1, 0), a3, voffA);
            PG8_WAIT_V(8); PG8_WAIT_L(0); PG8_BAR; PG8_MMA(1, 0, At, B0); PG8_MMA(1, 1, At, B1); PG8_BAR; PG8_SCHED;
            } else {
            PG8_LDB(B0, 0, 0); PG8_SCHED; PG8_LDA(At, 0, 0); PG8_STAGE(PG8_SA(1, 1), a1 + hstepA, voffA);
            PG8_WAIT_L(8); PG8_BAR; PG8_WAIT_L(0); PG8_MMA(0, 0, At, B0); PG8_BAR; PG8_SCHED;
            PG8_LDB(B1, 0, 1); PG8_STAGE(PG8_SB(0, 0), b2, voffB);
            PG8_BAR; PG8_WAIT_L(0); PG8_MMA(0, 1, At, B1); PG8_BAR;
            PG8_LDA(At, 0, 1); PG8_STAGE(PG8_SA(0, 0), a2, voffA);
            PG8_BAR; PG8_WAIT_L(0); PG8_MMA(1, 0, At, B0); PG8_BAR; PG8_SCHED;
            PG8_STAGE(PG8_SB(0, 1), b2 + hstepB, voffB);
            PG8_WAIT_V(6); PG8_BAR; PG8_MMA(1, 1, At, B1); PG8_BAR;
            PG8_LDB(B0, 1, 0); PG8_SCHED; PG8_LDA(At, 1, 0); PG8_STAGE(PG8_SA(0, 1), a2 + hstepA, voffA);
            PG8_WAIT_L(8); PG8_BAR; PG8_WAIT_L(0); PG8_MMA(0, 0, At, B0); PG8_BAR; PG8_SCHED;
            PG8_LDB(B1, 1, 1); PG8_STAGE(PG8_SB(1, 0), b3, voffB);
            PG8_BAR; PG8_WAIT_L(0); PG8_MMA(0, 1, At, B1); PG8_BAR;
            PG8_LDA(At, 1, 1); PG8_STAGE(PG8_SA(1, 0), a3, voffA);
            PG8_BAR; PG8_WAIT_L(0); PG8_MMA(1, 0, At, B0); PG8_BAR; PG8_SCHED;
            PG8_STAGE(PG8_SB(1, 1), b3 + hstepB, voffB);
            PG8_WAIT_V(6); PG8_BAR; PG8_MMA(1, 1, At, B1); PG8_BAR;
            }
        }
        if constexpr (ALIGN_EPI) { if (wr == 0) PG8_BAR; }
        { const int l_tid = wave * 64 + mk_lane();
          const int l_lane = l_tid & 63; E(acc, cur, wr, wc, l_lane & 15, l_lane >> 4, lds, l_tid); }
        if (!has_next) break;
        if (!cur.keep) {
#pragma unroll
        for (int a = 0; a < 2; ++a)
#pragma unroll
            for (int b = 0; b < 2; ++b)
#pragma unroll
                for (int m = 0; m < 4; ++m)
#pragma unroll
                    for (int n = 0; n < 2; ++n) acc[a][b][m][n] = (f32x4){0.f, 0.f, 0.f, 0.f};
        }
        cur = nxt; cA = nA; cB = nB; ++ui;
        if constexpr (ALIGN_EPI) { if (wr == 1) PG8_BAR; }
    }
    PG8_WAIT_V(0);
    if constexpr (!ALIGN_EPI) { if (wr == 0) PG8_BAR; }
    PG8_BAR;
#undef PG8_SA
#undef PG8_SB
#undef PG8_STAGE
#undef PG8_LDA
#undef PG8_LDB
#undef PG8_MMA
#undef PG8_WAIT_V
#undef PG8_WAIT_L
#undef PG8_BAR
#undef PG8_SCHED
}
}
using pg8::Unit; using pg8::Acc;

struct ProbStd {
    const char* A; const char* B; int K, lda, ldb; bool upmap; pg8::StaticOrder S;
    __device__ bool next(int i, Unit& u) const { return S.next(i, u); }
    __device__ const char* a_tile(const Unit& u) const { return A + (size_t)u.pm * 256 * lda * 2; }
    __device__ const char* b_tile(const Unit& u) const { return B + (size_t)u.pn * 256 * ldb * 2; }
    __device__ unsigned a_rowoff(int R) const { const int r = upmap ? (128 * (R >> 6) + 8 * (R & 15) + ((R >> 4) & 3)) : R; return (unsigned)r * (unsigned)lda * 2u; }
    __device__ unsigned b_rowoff(int R) const { return (unsigned)R * (unsigned)ldb * 2u; }
    __device__ size_t a_hstep() const { return (size_t)(upmap ? 4 : 128) * lda * 2; }
    __device__ size_t b_hstep() const { return (size_t)128 * ldb * 2; }
};
struct ProbHalo {
    const char* A; const char* B; int K, lda, ldb; int G, c;
    __device__ bool next(int i, Unit& u) const { const int L = i * G + c; if (L >= 3 * 44) return false; u.pm = L % 3; u.pn = L / 3; u.g = 0; u.part = 0; u.keep = 0; return true; }
    __device__ const char* a_tile(const Unit& u) const { return A + ((long)64 * 256 * u.pm - 1) * (long)lda * 2; }
    __device__ const char* b_tile(const Unit& u) const { return B + (size_t)u.pn * 256 * ldb * 2; }
    __device__ unsigned a_rowoff(int R) const { return (unsigned)(64 * R + 65 * (R & 1)) * (unsigned)lda * 2u; }
    __device__ unsigned b_rowoff(int R) const { return (unsigned)R * (unsigned)ldb * 2u; }
    __device__ size_t a_hstep() const { return (size_t)64 * 128 * lda * 2; }
    __device__ size_t b_hstep() const { return (size_t)128 * ldb * 2; }
};
struct ProbDftC {
    const char* Dm; const char* zb; int G, c;
    static constexpr int K = 512;
    __device__ bool next(int i, Unit& u) const { const int L0 = i * G + c; if (L0 >= 1536) return false; const int L = (L0 % 8) * 192 + L0 / 8;
        u.pm = L & 1; u.g = (L >> 1) & 3; u.pn = L >> 3; u.part = 0; u.keep = 0; return true; }
    __device__ const char* a_tile(const Unit& u) const { return Dm + (size_t)u.pm * 512 * 512 * 2; }
    __device__ const char* b_tile(const Unit& u) const { return zb + ((size_t)u.pn * 256 * D + 512 * u.g) * 2; }
    __device__ unsigned a_rowoff(int R) const { return (unsigned)R * 512u * 2u; }
    __device__ unsigned b_rowoff(int R) const { return (unsigned)R * (unsigned)D * 2u; }
    __device__ size_t a_hstep() const { return (size_t)128 * 512 * 2; }
    __device__ size_t b_hstep() const { return (size_t)128 * D * 2; }
};
struct ProbDftS {
    const char* Fmat; const char* Bt; int G, c;
    static constexpr int K = 2048;
    __device__ bool next(int i, Unit& u) const { const int L0 = (i >> 1) * G + c; if (L0 >= 384) return false;
        const int L = (L0 % 8) * 48 + L0 / 8; u.pn = L & 3; u.pm = (L >> 2) & 3; u.g = L >> 4; u.part = i & 1; u.keep = (i & 1) ^ 1; return true; }
    __device__ const char* a_tile(const Unit& u) const { return Fmat + ((size_t)u.pm * 256 * 4096 + (size_t)u.part * 2048) * 2; }
    __device__ const char* b_tile(const Unit& u) const { return Bt + (((size_t)u.g * 1024 + (size_t)u.pn * 256) * BTP + (size_t)u.part * 2048) * 2; }
    __device__ unsigned a_rowoff(int R) const { return (unsigned)R * 4096u * 2u; }
    __device__ unsigned b_rowoff(int R) const { return (unsigned)R * (unsigned)BTP * 2u; }
    __device__ size_t a_hstep() const { return (size_t)128 * 4096 * 2; }
    __device__ size_t b_hstep() const { return (size_t)128 * BTP * 2; }
};

__device__ __forceinline__ void store_h8(h16* p, const f32x4& v0, const f32x4& v1) {
    u32x4 w; w.x = pk_h2(v0[0], v0[1]); w.y = pk_h2(v0[2], v0[3]); w.z = pk_h2(v1[0], v1[1]); w.w = pk_h2(v1[2], v1[3]);
    *(u32x4*)p = w;
}

__device__ __forceinline__ f32x4 ldf4(const float* base, unsigned idx) { return *(const f32x4*)((const char*)base + (idx << 2)); }
struct EpiIn {
    h16* Hc; h16* Hq; const float* ropec; const float* ropes;
    __device__ __forceinline__ void operator()(Acc& acc, const Unit& u, int wr, int wc, int fr, int fq, LAS unsigned char* lds, int tid) const {
        const unsigned row0 = u.pm * 256, pn = u.pn, colt = pn * 256 + wc * 32 + 8 * fq;
        const bool rope = (pn >= 12 && pn < 20);
        const float sc = (pn >= 12 && pn < 16) ? QSCALE : 1.0f;
#pragma unroll
        for (int ai = 0; ai < 2; ++ai)
#pragma unroll
            for (int m = 0; m < 4; ++m) {
                const unsigned row = row0 + ai * 128 + wr * 64 + m * 16 + fr;
                if (rope) {
                    const unsigned t = row & (SEQ - 1), d0 = 32 * (wc & 1) + 8 * fq;
                    const float* cp = ropec + t * 64 + d0; const float* sp = ropes + t * 64 + d0;
                    f32x4 v[2][2];
#pragma unroll
                    for (int n = 0; n < 2; ++n) { const f32x4 c = *(const f32x4*)(cp + 4 * n), s = *(const f32x4*)(sp + 4 * n);
                        const f32x4 x1 = acc[ai][0][m][n], x2 = acc[ai][1][m][n];
                        v[0][n] = (x1 * c - x2 * s) * sc; v[1][n] = (x2 * c + x1 * s) * sc; }
                    h16* o = Hq + (size_t)row * 3072 + (256 * (pn - 12) + 128 * (wc >> 1) + d0);
                    store_h8(o, v[0][0], v[0][1]); store_h8(o + 64, v[1][0], v[1][1]);
                } else {
                    if (pn >= 4 && pn < 12) {
                        store_h8(Hc + (size_t)row * 3072 + 1024 + (pn - 4) * 128 + wc * 32 + 8 * fq, acc[ai][0][m][0] * acc[ai][1][m][0], acc[ai][0][m][1] * acc[ai][1][m][1]);
                    } else {
                    h16* o = (pn < 12) ? (Hc + (size_t)row * 3072 + colt) : (Hq + (size_t)row * 3072 + (colt - 3072));
                    store_h8(o, acc[ai][0][m][0], acc[ai][0][m][1]); store_h8(o + 128, acc[ai][1][m][0], acc[ai][1][m][1]); }
                }
                asm volatile("" ::: "memory");
            }
    }
};

struct EpiInQ {
    h16* Hq; const float* ropec; const float* ropes; const float* sx; const float* sw;
    __device__ __forceinline__ void operator()(Acc& acc, const Unit& u, int wr, int wc, int fr, int fq, LAS unsigned char* lds, int tid) const {
        const unsigned row0 = u.pm * 256, pn = u.pn, colt = pn * 256 + wc * 32 + 8 * fq;
        const bool rope = pn < 8;
        const float sc = pn < 4 ? QSCALE : 1.0f;
        f32x4 swv[2][2];
#pragma unroll
        for (int bj = 0; bj < 2; ++bj)
#pragma unroll
            for (int n = 0; n < 2; ++n) swv[bj][n] = ldf4(sw, colt + 128u * bj + 4u * n) * sc;
#pragma unroll
        for (int ai = 0; ai < 2; ++ai)
#pragma unroll
            for (int m = 0; m < 4; ++m) {
                const unsigned row = row0 + ai * 128 + wr * 64 + m * 16 + fr;
                const float rs = *(const float*)((const char*)sx + (row << 2));
                f32x4 x[2][2];
#pragma unroll
                for (int bj = 0; bj < 2; ++bj)
#pragma unroll
                    for (int n = 0; n < 2; ++n) { const pg8::i32x4 iv = __builtin_bit_cast(pg8::i32x4, acc[ai][bj][m][n]); x[bj][n] = __builtin_convertvector(iv, f32x4) * (swv[bj][n] * rs); }
                if (rope) {
                    const unsigned t = row & (SEQ - 1), d0 = 32 * (wc & 1) + 8 * fq;
                    f32x4 v[2][2];
#pragma unroll
                    for (int n = 0; n < 2; ++n) { const f32x4 c = ldf4(ropec, t * 64 + d0 + 4u * n), s = ldf4(ropes, t * 64 + d0 + 4u * n);
                        v[0][n] = x[0][n] * c - x[1][n] * s; v[1][n] = x[1][n] * c + x[0][n] * s; }
                    h16* o = Hq + (size_t)row * 3072 + (256 * pn + 128 * (wc >> 1) + d0);
                    store_h8(o, v[0][0], v[0][1]); store_h8(o + 64, v[1][0], v[1][1]);
                } else {
                    h16* o = Hq + (size_t)row * 3072 + colt;
                    store_h8(o, x[0][0], x[0][1]); store_h8(o + 128, x[1][0], x[1][1]);
                }
                asm volatile("" ::: "memory");
            }
    }
};

template <bool LNX, bool I8 = false> struct EpiResT {
    h16* X; const float* stats; const float* g; const float* bta;
    const float* sa; const float* swd;
    __device__ __forceinline__ void operator()(Acc& acc, const Unit& u, int wr, int wc, int fr, int fq, LAS unsigned char* lds, int tid) const {
#pragma unroll
        for (int bj = 0; bj < 2; ++bj) {
            const unsigned colt = u.pn * 256 + 128u * bj + wc * 32 + 8 * fq;
            f32x4 ga[2], ba[2], cs[2];
            if constexpr (LNX) {
#pragma unroll
                for (int n = 0; n < 2; ++n) { ga[n] = ldf4(g, colt + 4u * n) * ALPHA; ba[n] = ldf4(bta, colt + 4u * n) * ALPHA; }
            }
            if constexpr (I8) {
#pragma unroll
                for (int n = 0; n < 2; ++n) cs[n] = ldf4(swd, colt + 4u * n);
            }
#pragma unroll
            for (int ai = 0; ai < 2; ++ai) {
                h16x8 xv[4];
                f32x2 st[4]; float rs[4];
#pragma unroll
                for (int m = 0; m < 4; ++m) { const unsigned row = u.pm * 256 + ai * 128 + wr * 64 + m * 16 + fr; xv[m] = *(const h16x8*)(X + (size_t)row * D + colt);
                    if constexpr (LNX) st[m] = *(const f32x2*)((const char*)stats + (row << 3));
                    if constexpr (I8) rs[m] = *(const float*)((const char*)sa + (row << 2)); }
                asm volatile("" ::: "memory");
#pragma unroll
                for (int m = 0; m < 4; ++m) {
                    const unsigned row = u.pm * 256 + ai * 128 + wr * 64 + m * 16 + fr;
                    f32x4 z[2];
#pragma unroll
                    for (int n = 0; n < 2; ++n) {
                        f32x4 a = acc[ai][bj][m][n];
                        if constexpr (I8) { const pg8::i32x4 iv = __builtin_bit_cast(pg8::i32x4, a); a = __builtin_convertvector(iv, f32x4) * (cs[n] * rs[m]); }
#pragma unroll
                        for (int e = 0; e < 4; ++e) {
                            if constexpr (LNX) { const float t = ((float)xv[m][4 * n + e] - st[m].x) * st[m].y; z[n][e] = t * ga[n][e] + (ba[n][e] + a[e]); }
                            else z[n][e] = (float)xv[m][4 * n + e] * ALPHA + a[e]; }
                    }
                    store_h8(X + (size_t)row * D + colt, z[0], z[1]);
                }
                asm volatile("" ::: "memory");
            }
        }
    }
};
typedef EpiResT<false> EpiRes;

template <bool I8> struct EpiHalo {
    float* HALO; const float* sx; const float* sw;
    __device__ __forceinline__ void operator()(Acc& acc, const Unit& u, int wr, int wc, int fr, int fq, LAS unsigned char* lds, int tid) const {
        const unsigned h0 = u.pm * 256, colt = u.pn * 256 + wc * 32 + 8 * fq;
        if constexpr (I8) {
#pragma unroll
            for (int ai = 0; ai < 2; ++ai)
#pragma unroll
                for (int m = 0; m < 4; ++m) { const int hidx = (int)(h0 + ai * 128 + wr * 64 + m * 16 + fr); int tok = 64 * hidx + 65 * (hidx & 1) - 1; tok = tok < 0 ? 0 : (tok >= M ? M - 1 : tok);
                    const float rs = sx[tok];
#pragma unroll
                    for (int bj = 0; bj < 2; ++bj)
#pragma unroll
                        for (int n = 0; n < 2; ++n) { const pg8::i32x4 iv = __builtin_bit_cast(pg8::i32x4, acc[ai][bj][m][n]); acc[ai][bj][m][n] = __builtin_convertvector(iv, f32x4) * rs; } } }
#pragma unroll
        for (int ai = 0; ai < 2; ++ai)
#pragma unroll
            for (int m = 0; m < 4; ++m) {
                const unsigned rl = ai * 128 + wr * 64 + m * 16 + fr;
                float* o = HALO + (size_t)(h0 + rl) * FF2 + colt;
#pragma unroll
                for (int bj = 0; bj < 2; ++bj)
#pragma unroll
                    for (int n = 0; n < 2; ++n) *(f32x4*)(o + bj * 128 + 4 * n) = acc[ai][bj][m][n];
            }
    }
};

__device__ __forceinline__ float dpp_shr1(float oldv, float src) {
    return __builtin_bit_cast(float, __builtin_amdgcn_update_dpp(__builtin_bit_cast(int, oldv), __builtin_bit_cast(int, src), 0x111, 0xf, 0xf, false));
}
__device__ __forceinline__ float dpp_shl1(float oldv, float src) {
    return __builtin_bit_cast(float, __builtin_amdgcn_update_dpp(__builtin_bit_cast(int, oldv), __builtin_bit_cast(int, src), 0x101, 0xf, 0xf, false));
}
__device__ __forceinline__ float silu_f(float x) { return x * __builtin_amdgcn_rcpf(1.0f + __expf(-x)); }

template <bool I8> struct EpiUp {
    h16* ACT; const float* HALO; const float* cw;
    const float* sx; const float* sw;
    __device__ __forceinline__ void operator()(Acc& acc, const Unit& u, int wr, int wc, int fr, int fq, LAS unsigned char* lds, int tid) const {
        const unsigned tok0 = u.pm * 256;
        const unsigned tl0 = 128 * wr + 8 * fr;
        if constexpr (I8) {
#pragma unroll
            for (int ai = 0; ai < 2; ++ai) { const f32x4 sa = ldf4(sx, tok0 + tl0 + 4u * ai);
#pragma unroll
                for (int m = 0; m < 4; ++m)
#pragma unroll
                    for (int bj = 0; bj < 2; ++bj)
#pragma unroll
                        for (int n = 0; n < 2; ++n) { const pg8::i32x4 iv = __builtin_bit_cast(pg8::i32x4, acc[ai][bj][m][n]); acc[ai][bj][m][n] = __builtin_convertvector(iv, f32x4) * sa[m]; }
                asm volatile("" ::: "memory"); }
        }
        const unsigned bk = 2 * u.pm + wr;
        const bool lvalid = (bk & 15) != 0, rvalid = (bk & 15) != 15;
#pragma unroll
        for (int bj = 0; bj < 2; ++bj) {
            const unsigned colp = u.pn * 256 + bj * 128 + wc * 32 + 8 * fq;
            const unsigned coll = bj * FF + u.pn * 128 + wc * 32 + 8 * fq;
#pragma unroll
            for (int n = 0; n < 2; ++n) {
                f32x4 c0 = ldf4(cw, coll + 4u * n), c1 = ldf4(cw, (unsigned)FF2 + coll + 4u * n), c2 = ldf4(cw, 2u * FF2 + coll + 4u * n);
                if constexpr (I8) { const f32x4 swv = ldf4(sw, colp + 4u * n); c0 = c0 * swv; c1 = c1 * swv; c2 = c2 * swv; }
                f32x4 hl = {0.f, 0.f, 0.f, 0.f}, hr = {0.f, 0.f, 0.f, 0.f};
                if (fr == 0 && lvalid) hl = ldf4(HALO, (2u * bk) * (unsigned)FF2 + colp + 4u * n);
                if (fr == 15 && rvalid) hr = ldf4(HALO, (2u * bk + 1u) * (unsigned)FF2 + colp + 4u * n);
#pragma unroll
                for (int e = 0; e < 4; ++e) {
                    const float prev = dpp_shr1(hl[e], acc[1][bj][3][n][e]);
                    const float next = dpp_shl1(hr[e], acc[0][bj][0][n][e]);
                    float left = prev;
#pragma unroll
                    for (int j = 0; j < 8; ++j) {
                        const float cur = acc[j >> 2][bj][j & 3][n][e];
                        const float nx = (j < 7) ? acc[(j + 1) >> 2][bj][(j + 1) & 3][n][e] : next;
                        acc[j >> 2][bj][j & 3][n][e] = c0[e] * left + c1[e] * cur + c2[e] * nx;
                        left = cur;
                    }
                }
                asm volatile("" ::: "memory");
            }
        }
        const unsigned colo = u.pn * 128 + wc * 32 + 8 * fq;
#pragma unroll
        for (int ai = 0; ai < 2; ++ai)
#pragma unroll
            for (int m = 0; m < 4; ++m) {
                f32x4 a[2];
#pragma unroll
                for (int n = 0; n < 2; ++n)
#pragma unroll
                    for (int e = 0; e < 4; ++e) a[n][e] = silu_f(acc[ai][0][m][n][e]) * acc[ai][1][m][n][e];
                store_h8((h16*)((char*)ACT + (((tok0 + tl0 + 4u * ai + m) * (unsigned)FF + colo) << 1)), a[0], a[1]);
                asm volatile("" ::: "memory");
            }
    }
};

struct EpiDftC {
    h16* BtAB;
    __device__ __forceinline__ void operator()(Acc& acc, const Unit& u, int wr, int wc, int fr, int fq, LAS unsigned char* lds, int tid) const {
        const unsigned b = u.pn >> 3, s0 = (u.pn & 7) * 256;
#pragma unroll
        for (int ai = 0; ai < 2; ++ai)
#pragma unroll
            for (int m = 0; m < 4; ++m) {
                const unsigned rl = ai * 128 + wr * 64 + m * 16 + fr;
                h16* o = BtAB + ((size_t)(b * 1024 + u.g * 256 + rl)) * BTP + (u.pm * 2048 + s0 + wc * 32 + 8 * fq);
                store_h8(o, acc[ai][0][m][0], acc[ai][0][m][1]); store_h8(o + 128, acc[ai][1][m][0], acc[ai][1][m][1]);
            }
    }
};

__device__ __forceinline__ void store_h8_skip0(h16* p, const f32x4& v0, const f32x4& v1) {
    const unsigned w0 = pk_h2(v0[0], v0[1]), w1 = pk_h2(v0[2], v0[3]); u32x2 w23; w23.x = pk_h2(v1[0], v1[1]); w23.y = pk_h2(v1[2], v1[3]);
    *(unsigned short*)(p + 1) = (unsigned short)(w0 >> 16); *(unsigned*)(p + 2) = w1; *(u32x2*)(p + 4) = w23;
}
struct EpiDftS2 {
    h16* F; float* scratch;
    __device__ __forceinline__ void operator()(Acc& acc, const Unit& u, int wr, int wc, int fr, int fq, LAS unsigned char* lds, int tid) const {
        f32x4* ps = (f32x4*)scratch + tid;
        if (u.part == 0) {
#pragma unroll
            for (int ai = 0; ai < 2; ++ai)
#pragma unroll
                for (int m = 0; m < 4; ++m)
#pragma unroll
                    for (int bj = 0; bj < 2; ++bj)
#pragma unroll
                        for (int n = 0; n < 2; ++n) ps[(((ai * 4 + m) * 2 + bj) * 2 + n) * 512] = acc[ai][bj][m][n];
            return;
        }
        const float sc = 0.0009765625f;
        const unsigned jl = wc * 32 + 8 * fq;
#pragma unroll
        for (int ai = 0; ai < 2; ++ai)
#pragma unroll
            for (int m = 0; m < 4; ++m) {
                const unsigned kk = u.pm * 256 + ai * 128 + wr * 64 + m * 16 + fr;
                h16* o = F + (size_t)(u.g * 2048 + kk) * D + u.pn * 512 + jl;
                h16* om = F + (size_t)(u.g * 2048 + 2048 - kk) * D + u.pn * 512 + jl;
#pragma unroll
                for (int bj = 0; bj < 2; ++bj) {
                    const f32x4 p0 = ps[(((ai * 4 + m) * 2 + bj) * 2 + 0) * 512], p1 = ps[(((ai * 4 + m) * 2 + bj) * 2 + 1) * 512];
                    const f32x4 y0 = acc[ai][bj][m][0] * sc, y1 = acc[ai][bj][m][1] * sc;
                    const f32x4 z0 = (p0 * 2.0f - acc[ai][bj][m][0]) * sc, z1 = (p1 * 2.0f - acc[ai][bj][m][1]) * sc;
                    const bool j0 = (bj == 0) && (jl == 0);
                    store_h8(o + bj * 128, y0, y1);
                    if (j0) store_h8_skip0(o + 256, z0, z1); else store_h8(o + 256 + bj * 128, z0, z1);
                    if (kk != 0) {
                        store_h8(om + bj * 128, z0, z1);
                        if (j0) store_h8_skip0(om + 256, y0, y1); else store_h8(om + 256 + bj * 128, y0, y1);
                    }
                }
                asm volatile("" ::: "memory");
            }
    }
};

struct Args { const float* in[13]; float* out; unsigned char* ws; int ph_lo, ph_hi; };
struct Frame {
    LAS unsigned char* lds; volatile LAS unsigned* MISC; unsigned* ctl;
    int wave, vcu, G;
    unsigned char* ws;
};

__device__ __forceinline__ void dftc_side(Frame& F, const h16* xb, h16* A256) {
    const int lane_ = mk_lane();
    const int gw = F.vcu * 8 + F.wave, NGW = F.G * 8, lane = lane_;
    for (int t = gw; t < M; t += NGW) {
        const h16x8* xr = (const h16x8*)(xb + (size_t)t * D) + lane; float s[4];
#pragma unroll
        for (int j = 0; j < 4; ++j) { const h16x8 v = xr[64 * j]; float a = 0.f;
#pragma unroll
            for (int e = 0; e < 8; e += 2) a += (float)v[e] - (float)v[e + 1];
            s[j] = wave_sum(a); }
        if (lane < 4) { const float v = lane == 0 ? s[0] : (lane == 1 ? s[1] : (lane == 2 ? s[2] : s[3])); A256[((size_t)(t >> 11) * 4 + lane) * 2048 + (t & 2047)] = (h16)v; }
    }
}
__device__ __forceinline__ void dfts_side(Frame& F, const h16* BtAB, const h16* A256, const h16* Fmat, h16* Fo) {
    const int lane_ = mk_lane();
    const int nheavy = (F.G < 384 && 2 * F.G > 384) ? 384 - F.G : 0, bxi = (int)blockIdx.x;
    if (bxi < nheavy) return;
    const int gw = (bxi - nheavy) * 8 + F.wave, NGW = (F.G - nheavy) * 8, lane = lane_;
    for (int J = gw; J < 96 * 32; J += NGW) {
        const int pair = J >> 5, ch = J & 31, b = pair >> 2, grp = pair & 3;
        const h16x8* ap = (const h16x8*)(A256 + (size_t)pair * 2048) + lane; float av[4][8];
#pragma unroll
        for (int j = 0; j < 4; ++j) { const h16x8 v = ap[64 * j];
#pragma unroll
            for (int e = 0; e < 8; ++e) av[j][e] = (float)v[e]; }
        for (int k0 = ch * 33; k0 < ch * 33 + 33; k0 += 3) {
            float a3[3] = {0.f, 0.f, 0.f};
#pragma unroll
            for (int q = 0; q < 3; ++q) { const int kk = (k0 + q) <= 1024 ? (k0 + q) : 1024; const h16x8* fp = (const h16x8*)(Fmat + (size_t)kk * 4096) + lane;
#pragma unroll
                for (int j = 0; j < 4; ++j) { const h16x8 v = fp[64 * j];
#pragma unroll
                    for (int e = 0; e < 8; ++e) a3[q] += (float)v[e] * av[j][e]; } }
#pragma unroll
            for (int q = 0; q < 3; ++q) { const int kk = k0 + q; const float a = wave_sum(a3[q]) * 0.0009765625f;
                if (lane == 0 && kk <= 1024) { Fo[((size_t)b * 2048 + kk) * D + grp * 512 + 256] = (h16)a; if (kk >= 1 && kk <= 1023) Fo[((size_t)b * 2048 + 2048 - kk) * D + grp * 512 + 256] = (h16)a; } }
        }
    }
    for (int r = gw; r < NSEQ * 1024; r += NGW) {
        const h16x8* p = (const h16x8*)(BtAB + (size_t)r * BTP) + lane; float s = 0.f;
#pragma unroll
        for (int j = 0; j < 4; ++j) { const h16x8 v = p[64 * j];
#pragma unroll
            for (int e = 0; e < 8; e += 2) s += (float)v[e] - (float)v[e + 1]; }
        s = wave_sum(s) * 0.0009765625f;
        if (lane == 0) { const int b = r >> 10, n = r & 1023, grp = n >> 8, j = n & 255; h16* o = Fo + ((size_t)b * 2048 + 1024) * D + grp * 512;
            o[j] = (h16)s; if (j >= 1) o[256 + j] = (h16)s; }
    }
}

__device__ __forceinline__ int fpos_chan(int kpos) { const int p = kpos & 511; return (kpos & ~511) + (p <= 256 ? p : 768 - p); }
template <bool KMAP = false>
__device__ __forceinline__ void p0_transpose_item(const float* W, int K, int N, h16* WT, int kb, int np0, int scol0, LAS float* scr, int lane) {
    const int k0 = 64 * kb;
#pragma unroll 8
    for (int i = 0; i < 32; ++i) { const int kk = 2 * i + (lane >> 5); const int ksrc = KMAP ? fpos_chan(k0 + kk) : (k0 + kk); scr[kk * 33 + (lane & 31)] = W[(size_t)ksrc * N + scol0 + (lane & 31)]; }
    asm volatile("s_waitcnt lgkmcnt(0)" ::: "memory");
    const int c = lane & 7;
#pragma unroll
    for (int j = 0; j < 4; ++j) { const int n = (lane >> 3) + 8 * j; const LAS float* s = scr + (8 * c) * 33 + n;
        u32x4 o; o.x = pk_h2(s[0 * 33], s[1 * 33]); o.y = pk_h2(s[2 * 33], s[3 * 33]); o.z = pk_h2(s[4 * 33], s[5 * 33]); o.w = pk_h2(s[6 * 33], s[7 * 33]);
        *(u32x4*)(WT + (size_t)(np0 + n) * K + k0 + 8 * c) = o; }
    asm volatile("s_waitcnt lgkmcnt(0)" ::: "memory");
}
__device__ __forceinline__ float colmax_of(const float* pmax, int idx) { float m = 0.f;
#pragma unroll
    for (int rb = 0; rb < 8; ++rb) m = fmaxf(m, pmax[(size_t)rb * PM_STRIDE + idx]); return m; }
__device__ __forceinline__ void p0_transpose_item_i8(const float* W, int K, int N, signed char* WT, int kb, int np0, int scol0, const float* pmax, int cidx0, LAS float* scr, int lane) {
    const int k0 = 64 * kb;
#pragma unroll 8
    for (int i = 0; i < 32; ++i) { const int kk = 2 * i + (lane >> 5); scr[kk * 33 + (lane & 31)] = W[(size_t)(k0 + kk) * N + scol0 + (lane & 31)]; }
    asm volatile("s_waitcnt lgkmcnt(0)" ::: "memory");
    const int c = lane & 7;
#pragma unroll
    for (int j = 0; j < 4; ++j) { const int n = (lane >> 3) + 8 * j; const LAS float* s = scr + (8 * c) * 33 + n;
        const float mx = colmax_of(pmax, cidx0 + n); const float inv = mx > 0.f ? 127.0f / mx : 0.f;
        *(u32x2*)(WT + (size_t)(np0 + n) * K + k0 + 8 * c) = pack8_i8(s[0 * 33], s[1 * 33], s[2 * 33], s[3 * 33], s[4 * 33], s[5 * 33], s[6 * 33], s[7 * 33], inv); }
    asm volatile("s_waitcnt lgkmcnt(0)" ::: "memory");
}
__device__ __forceinline__ void p0_colmax(Frame& F, const float* w_up, const float* w_in) {
    const int lane = mk_lane();
    LAS float* red = (LAS float*)F.lds;
    float* pmax = (float*)(F.ws + WS_PART);
    constexpr int NCM_UP = 4 * 44 * 8, NCM_IN = 2 * 12 * 8;
    for (int it = F.vcu; it < NCM_UP + NCM_IN; it += F.G) {
        const float* p; int pidx, rb; size_t pitch;
        if (it < NCM_UP) { const int l = it / 352, r = it % 352, cg = r % 44; rb = r / 44; pitch = FF2; pidx = l * FF2 + cg * 256;
            p = w_up + (size_t)l * D * FF2 + (size_t)(rb * 256 + F.wave * 32) * FF2 + cg * 256 + 4 * lane; }
        else { const int j = it - NCM_UP, i = j / 96, r = j % 96, cg = r % 12; rb = r / 12; pitch = DIN; pidx = 4 * FF2 + i * 3072 + cg * 256;
            p = w_in + (size_t)i * D * DIN + (size_t)(rb * 256 + F.wave * 32) * DIN + 3072 + cg * 256 + 4 * lane; }
        f32x4 m = {0.f, 0.f, 0.f, 0.f};
#pragma unroll
        for (int k = 0; k < 32; ++k) { const f32x4 v = *(const f32x4*)(p + (size_t)k * pitch);
#pragma unroll
            for (int e = 0; e < 4; ++e) m[e] = fmaxf(m[e], fabsf(v[e])); }
        *(LAS f32x4*)(red + F.wave * 256 + 4 * lane) = m;
        LDS_FENCE_BAR();
        if (F.wave < 4) { const int c = F.wave * 64 + lane; float mm = 0.f;
#pragma unroll
            for (int w = 0; w < 8; ++w) mm = fmaxf(mm, red[w * 256 + c]);
            pmax[(size_t)rb * PM_STRIDE + pidx + c] = mm; }
        LDS_FENCE_BAR();
    }
}
__device__ __forceinline__ int in_srccol(int np) {
    if (np >= 1024 && np < 3072) { const int pn = np >> 8, p = np & 255; return ((p >> 7) ? 2048 : 1024) + (pn - 4) * 128 + (p & 127); }
    if (np < 1024 || np >= 5120) return np;
    const int pn = np >> 8, p = np & 255, bj = p >> 7, w = p & 127;
    return pn * 256 + 128 * (w >> 6) + 64 * bj + (w & 63);
}
__device__ __forceinline__ int up_srccol(int np) { const int pn = np >> 8, p = np & 255, bj = p >> 7, w = p & 127; return bj * FF + pn * 128 + w; }

template <int PART> __device__ __forceinline__ void p0_prologue(Frame& F, const Args& a) {
    const float* x_prompt = a.in[0]; const float* x_sample = a.in[1]; const float* w_in = a.in[2]; const float* w_om = a.in[4]; const float* w_of = a.in[5];
    const float* w_up = a.in[8]; const float* w_dn = a.in[10];
    unsigned char* ws = F.ws;
    LAS float* scr = (LAS float*)(F.lds + F.wave * 16384);
    const int gw = F.vcu * 8 + F.wave, NGW = F.G * 8, lane0 = mk_lane();
    const long gt = (long)gw * 64 + lane0, NGT = (long)NGW * 64;
    constexpr int I_IN = 32 * (DIN / 32), I_SQ = 32 * (D / 32), I_UP = 32 * (FF2 / 32), I_DN = (FF / 64) * (D / 32);
    constexpr int NITEMS = 2 * I_IN + 2 * I_SQ + 2 * I_SQ + 4 * I_UP + 4 * I_DN;
    for (int it = gw; it < NITEMS; it += NGW) {
        int r = it;
        if (r < 2 * I_IN) { const int i = r / I_IN; r -= i * I_IN; const int nb = r % (DIN / 32), kb = r / (DIN / 32), np0 = nb * 32;
            if ((np0 >= 3072) != (PART != 0)) continue;
            if (PART) p0_transpose_item_i8(w_in + (size_t)i * D * DIN, D, DIN, (signed char*)(ws + WS_WIN8) + ((long)i * 3072 - 3072) * D, kb, np0, in_srccol(np0), (const float*)(ws + WS_PART), 4 * FF2 + i * 3072 + in_srccol(np0) - 3072, scr, lane0);
            else p0_transpose_item(w_in + (size_t)i * D * DIN, D, DIN, (h16*)(ws + WS_WIN) + (size_t)i * DIN * D, kb, np0, in_srccol(np0), scr, lane0);
            continue; }
        r -= 2 * I_IN;
        if (PART && r < 4 * I_SQ) continue;
        if (r < 2 * I_SQ) { const int i = r / I_SQ; r -= i * I_SQ; const int nb = r % (D / 32), kb = r / (D / 32);
            p0_transpose_item(w_om + (size_t)i * D * D, D, D, (h16*)(ws + WS_WOM) + (size_t)i * D * D, kb, nb * 32, nb * 32, scr, lane0); continue; }
        r -= 2 * I_SQ;
        if (r < 2 * I_SQ) { const int i = r / I_SQ; r -= i * I_SQ; const int nb = r % (D / 32), kb = r / (D / 32);
            p0_transpose_item<true>(w_of + (size_t)i * D * D, D, D, (h16*)(ws + WS_WOF) + (size_t)i * D * D, kb, nb * 32, nb * 32, scr, lane0); continue; }
        r -= 2 * I_SQ;
        if (r < 4 * I_UP) { const int l = r / I_UP; r -= l * I_UP; const int nb = r % (FF2 / 32), kb = r / (FF2 / 32), np0 = nb * 32;
            if (((kI8Mask >> l) & 1u) != (unsigned)PART) continue;
            if (PART) p0_transpose_item_i8(w_up + (size_t)l * D * FF2, D, FF2, (signed char*)(ws + WS_W8) + (size_t)l * FF2 * D, kb, np0, up_srccol(np0), (const float*)(ws + WS_PART), l * FF2 + up_srccol(np0), scr, lane0);
            else p0_transpose_item(w_up + (size_t)l * D * FF2, D, FF2, (h16*)(ws + WS_WUP) + (size_t)l * FF2 * D, kb, np0, up_srccol(np0), scr, lane0);
            continue; }
        r -= 4 * I_UP;
        if (PART) break;
        { const int l = r / I_DN; r -= l * I_DN; const int nb = r % (D / 32), kb = r / (D / 32);
            p0_transpose_item(w_dn + (size_t)l * FF * D, FF, D, (h16*)(ws + WS_WDN) + (size_t)l * D * FF, kb, nb * 32, nb * 32, scr, lane0); }
    }
    if constexpr (PART == 1) {
      float* vec = (float*)(ws + WS_VEC); const float* pmax = (const float*)(ws + WS_PART);
      for (long i = gt; i < 4 * FF2; i += NGT) { const int l = (int)i / FF2, np = (int)i % FF2; vec[V_SW + i] = colmax_of(pmax, l * FF2 + up_srccol(np)) * (1.0f / 127.0f); }
      for (long i = gt; i < 2 * 3072; i += NGT) { const int li = (int)i / 3072, np = 3072 + (int)i % 3072; vec[V_SWQ + i] = colmax_of(pmax, 4 * FF2 + li * 3072 + in_srccol(np) - 3072) * (1.0f / 127.0f); }
      if constexpr (kD8Mask != 0u) {
        const h16* wt = (const h16*)(ws + WS_WDN); signed char* w8 = (signed char*)(ws + WS_WDN8);
        for (int r = gw; r < 4 * D; r += NGW) { if (!((kD8Mask >> (r / D)) & 1u)) continue;
            h16x8 in[11];
#pragma unroll
            for (int j = 0; j < 11; ++j) in[j] = *(const h16x8*)(wt + (size_t)r * FF + 512 * j + 8 * lane0);
            const float sc = rowq_rot(in, w8 + (size_t)r * FF, lane0);
            if (lane0 == 0) vec[V_SWD + r] = sc * (1.0f / 128.0f); } }
      return; }
    { h16* Fm = (h16*)(ws + WS_FMAT);
      for (long ch = gt; ch < (long)2048 * 512; ch += NGT) { const int k = (int)(ch >> 9), c8 = (int)(ch & 511) * 8, p = c8 >> 11, s0 = c8 & 2047; unsigned w[4];
#pragma unroll
          for (int e = 0; e < 4; ++e) { float v[2];
#pragma unroll
              for (int q = 0; q < 2; ++q) { const int s = s0 + 2 * e + q; const int ph = (k * s) & 2047; float sn, cs; sincospif((float)ph * (1.0f / 1024.0f), &sn, &cs); v[q] = p ? -sn : cs; }
              w[e] = pk_h2(v[0], v[1]); }
          u32x4 o; o.x = w[0]; o.y = w[1]; o.z = w[2]; o.w = w[3]; *(u32x4*)(Fm + (size_t)k * 4096 + c8) = o; } }
    { h16* Dm = (h16*)(ws + WS_DM);
      for (long ch = gt; ch < 1024 * 64; ch += NGT) { const int n = (int)(ch >> 6), c0 = (int)(ch & 63) * 8, jj = n & 511; const bool issin = n >= 512; unsigned w[4];
#pragma unroll
          for (int e = 0; e < 4; ++e) { float v[2];
#pragma unroll
              for (int q = 0; q < 2; ++q) { const int c = c0 + 2 * e + q; const int ph = (jj * c) & 511; float sn, cs; sincospif((float)ph * (1.0f / 256.0f), &sn, &cs); v[q] = issin ? sn : cs; }
              w[e] = pk_h2(v[0], v[1]); }
          u32x4 o; o.x = w[0]; o.y = w[1]; o.z = w[2]; o.w = w[3]; *(u32x4*)(Dm + (size_t)n * 512 + c0) = o; } }
    { float* rc = (float*)(ws + WS_ROPE); float* rs = rc + 2048 * 64;
      for (long i = gt; i < 2048 * 64; i += NGT) { const int t = (int)(i >> 6), d = (int)(i & 63); const double inv = exp2(-(double)d * (13.287712379549449 / 64.0)); const double ang = (double)t * inv;
          rc[i] = (float)cos(ang); rs[i] = (float)sin(ang); } }
    { h16* xb = (h16*)(ws + WS_R2); signed char* x8 = (signed char*)(ws + WS_X8); float* sx = (float*)(ws + WS_VEC) + V_SX;
      for (int row = gw; row < M; row += NGW) {
          const float* src = row < M_PROMPT ? x_prompt + (size_t)row * D : x_sample + (size_t)(row - M_PROMPT) * D;
          f32x4 v[4][2]; float amax = 0.f;
#pragma unroll
          for (int j = 0; j < 4; ++j) { const int c = 512 * j + 8 * lane0; v[j][0] = *(const f32x4*)(src + c); v[j][1] = *(const f32x4*)(src + c + 4); }
#pragma unroll
          for (int j = 0; j < 4; ++j) { store_h8(xb + (size_t)row * D + 512 * j + 8 * lane0, v[j][0], v[j][1]);
#pragma unroll
              for (int e = 0; e < 4; ++e) amax = fmaxf(amax, fmaxf(fabsf(v[j][0][e]), fabsf(v[j][1][e]))); }
          amax = wave_max(amax);
          const float inv = amax > 0.f ? 127.0f / amax : 0.f;
#pragma unroll
          for (int j = 0; j < 4; ++j) *(u32x2*)(x8 + (size_t)row * D + 512 * j + 8 * lane0) = pack8_i8(v[j][0][0], v[j][0][1], v[j][0][2], v[j][0][3], v[j][1][0], v[j][1][1], v[j][1][2], v[j][1][3], inv);
          if (lane0 == 0) sx[row] = amax * (1.0f / 127.0f);
      } }
}

__device__ __forceinline__ unsigned att_off(unsigned row, unsigned ch) { return 256u * row + 16u * (ch ^ (((row & 3) << 2) | ((row >> 2) & 3))); }
struct AttItem { int br, r, p, idx0, L, h; size_t rowb; };
__device__ __forceinline__ AttItem att_decode(int I) {
    AttItem t; const int bh = I / 48, it = I % 48; t.h = bh & 7; t.rowb = (size_t)(bh >> 3) * SEQ; int blk;
    if (it < 16) { t.br = 0; t.r = 1; t.p = 0; blk = it; } else if (it < 32) { t.br = 1; t.r = 4; t.p = (it - 16) >> 2; blk = (it - 16) & 3; } else { t.br = 2; t.r = 16; t.p = it - 32; blk = 0; }
    t.L = SEQ / t.r; t.idx0 = 128 * blk; return t;
}
#define ATT_ISSUE(T) do { \
        const int ch_ = tid & 15, r4_ = tid >> 4; \
        const h16* base_ = Hq + (T).h * 128 + 8 * ch_; \
        _Pragma("unroll") for (int j = 0; j < 17; ++j) { const bool isv_ = j >= 8; const int rr_ = isv_ ? r4_ + 32 * (j - 8) : r4_ + 32 * j; \
            int kidx_ = (T).idx0 - 64 + rr_; kidx_ = kidx_ < 0 ? 0 : (kidx_ >= (T).L ? (T).L - 1 : kidx_); \
            if (j < 16 || tid < 256) kv[j] = *(const u32x4*)(base_ + ((T).rowb + (T).p + (T).r * kidx_) * 3072 + (isv_ ? 2048 : 1024)); } \
        const int qtok_ = (T).p + (T).r * ((T).idx0 + 16 * w + q16); const h16* qp_ = Hq + ((T).rowb + qtok_) * 3072 + (T).h * 128 + 8 * g; \
        _Pragma("unroll") for (int s = 0; s < 4; ++s) qn[s] = *(const h16x8*)(qp_ + 32 * s); } while (0)
__device__ __forceinline__ void attn_phase(Frame& F, h16* Obr) {
    const h16* Hq = (const h16*)(F.ws + WS_R1 + R1_HQKV); float* Lse = (float*)(F.ws + WS_LSE);
    const int tid_ = F.wave * 64 + mk_lane();
    LAS unsigned char* lds = F.lds; const int tid = tid_, lane = tid & 63, w = F.wave, q16 = lane & 15, g = lane >> 4;
    constexpr int NITEM = NSEQ * NH * 48;
    int i_lo, i_hi, i_st;
    if (F.G % 8 == 0) { const int per = F.G / 8, x = F.vcu / per, j = F.vcu % per; i_lo = x * (NITEM / 8) + j; i_hi = (x + 1) * (NITEM / 8); i_st = per; }
    else { i_lo = (int)((long)F.vcu * NITEM / F.G); i_hi = (int)((long)(F.vcu + 1) * NITEM / F.G); i_st = 1; }
    if (i_lo >= i_hi) return;
    u32x4 kv[17]; h16x8 qn[4];
    AttItem nx = att_decode(i_lo);
    ATT_ISSUE(nx);
    for (int I = i_lo; I < i_hi; I += i_st) {
        const AttItem cu = nx;
        __syncthreads();
        {   const int ch = tid & 15, r4 = tid >> 4;
#pragma unroll
            for (int j = 0; j < 17; ++j) { const bool isv = j >= 8; const int rr = isv ? r4 + 32 * (j - 8) : r4 + 32 * j;
                if (j < 16 || tid < 256) *(LAS u32x4*)(lds + (isv ? ATT_V : ATT_K) + att_off(rr, ch)) = kv[j]; } }
        h16x8 Qf[4];
#pragma unroll
        for (int s = 0; s < 4; ++s) Qf[s] = qn[s];
        __syncthreads();
        if (I + i_st < i_hi) { nx = att_decode(I + i_st); ATT_ISSUE(nx); }
        const int idx0 = cu.idx0, L = cu.L;
        const int qtok = cu.p + cu.r * (idx0 + 16 * w + q16);
        f32x4 sc[9];
        h16x8 kfb[2][4];
#pragma unroll
        for (int s = 0; s < 4; ++s) kfb[0][s] = *(const LAS h16x8*)(lds + ATT_K + att_off(16 * w + q16, 4 * s + g));
#pragma unroll
        for (int tt = 0; tt < 9; ++tt) {
            if (tt + 1 < 9) {
#pragma unroll
                for (int s = 0; s < 4; ++s) kfb[(tt + 1) & 1][s] = *(const LAS h16x8*)(lds + ATT_K + att_off(16 * (w + tt + 1) + q16, 4 * s + g)); }
            asm volatile("" ::: "memory");
            f32x4 a = {0.f, 0.f, 0.f, 0.f};
#pragma unroll
            for (int s = 0; s < 4; ++s) a = __builtin_amdgcn_mfma_f32_16x16x32_f16(kfb[tt & 1][s], Qf[s], a, 0, 0, 0);
            sc[tt] = a; }
        const int ql = 16 * w + q16;
        const int clo = ql > 64 - idx0 ? ql : 64 - idx0, chi = (ql + 128) < (L + 63 - idx0) ? (ql + 128) : (L + 63 - idx0);
        const unsigned span = (unsigned)(chi - clo); const int cb = 16 * w + 4 * g - clo;
        float mx = -3.0e38f;
#pragma unroll
        for (int tt = 0; tt < 9; ++tt)
#pragma unroll
            for (int e = 0; e < 4; ++e) { const bool ok = (unsigned)(cb + 16 * tt + e) <= span; sc[tt][e] = ok ? sc[tt][e] : -3.0e38f; mx = fmaxf(mx, sc[tt][e]); }
        mx = fmaxf(mx, shx<16>(mx)); mx = fmaxf(mx, shx<32>(mx));
        float den = 0.f;
#pragma unroll
        for (int tt = 0; tt < 9; ++tt)
#pragma unroll
            for (int e = 0; e < 4; ++e) { const float pv = __builtin_amdgcn_exp2f(sc[tt][e] - mx); sc[tt][e] = pv; den += pv; }
        den += shx<16>(den); den += shx<32>(den);
        h16x8 Pf[5];
#pragma unroll
        for (int ks = 0; ks < 5; ++ks) { u32x4 wv; wv.x = pk_h2(sc[2 * ks][0], sc[2 * ks][1]); wv.y = pk_h2(sc[2 * ks][2], sc[2 * ks][3]);
            if (ks < 4) { wv.z = pk_h2(sc[2 * ks + 1][0], sc[2 * ks + 1][1]); wv.w = pk_h2(sc[2 * ks + 1][2], sc[2 * ks + 1][3]); } else { wv.z = 0u; wv.w = 0u; }
            Pf[ks] = __builtin_bit_cast(h16x8, wv); }
        const float rden = 1.0f / den;
        unsigned char* op = (unsigned char*)Obr + ((size_t)cu.br * M + cu.rowb + qtok) * 1024 + cu.h * 128 + 4 * g;
        const float rs16 = rden * 16.0f;
        const int qq = q16 >> 2, pp = q16 & 3;
        typedef short s16x8 __attribute__((ext_vector_type(8)));
        s16x4 vlo[2][5], vhi[2][5];
#define ATT_LDV(B, C8) do { _Pragma("unroll") for (int ks = 0; ks < 5; ++ks) { const unsigned r0 = 16 * (w + 2 * ks) + 4 * g + qq, r1 = r0 + 16; \
            vlo[B][ks] = __builtin_bit_cast(s16x4, __builtin_amdgcn_ds_read_tr16_b64_v4i16((LAS s16x4*)(lds + ATT_V + att_off(r0, 2 * (C8) + (pp >> 1)) + 8 * (pp & 1)))); \
            vhi[B][ks] = __builtin_bit_cast(s16x4, __builtin_amdgcn_ds_read_tr16_b64_v4i16((LAS s16x4*)(lds + ATT_V + att_off(r1, 2 * (C8) + (pp >> 1)) + 8 * (pp & 1)))); } } while (0)
        ATT_LDV(0, 0);
#pragma unroll
        for (int c8 = 0; c8 < 8; ++c8) {
            if (c8 + 1 < 8) ATT_LDV((c8 + 1) & 1, c8 + 1);
            asm volatile("" ::: "memory");
            f32x4 o = {0.f, 0.f, 0.f, 0.f};
#pragma unroll
            for (int ks = 0; ks < 5; ++ks) {
                const s16x8 vv = __builtin_shufflevector(vlo[c8 & 1][ks], vhi[c8 & 1][ks], 0, 1, 2, 3, 4, 5, 6, 7);
                o = __builtin_amdgcn_mfma_f32_16x16x32_f16(__builtin_bit_cast(h16x8, vv), Pf[ks], o, 0, 0, 0); }
            int ov = __builtin_amdgcn_cvt_pk_fp8_f32(o[0] * rs16, o[1] * rs16, 0, false); ov = __builtin_amdgcn_cvt_pk_fp8_f32(o[2] * rs16, o[3] * rs16, ov, true);
            *(int*)(op + 16 * c8) = ov; }
#undef ATT_LDV
        if (g == 0) Lse[((size_t)cu.br * M + cu.rowb + qtok) * 8 + cu.h] = (mx + __log2f(den)) * 0.69314718055994531f;
    }
}
#undef ATT_ISSUE

__device__ __forceinline__ void load8(const h16* p, float (&v)[8]) { const h16x8 hv = *(const h16x8*)p;
#pragma unroll
    for (int e = 0; e < 8; ++e) v[e] = (float)hv[e]; }
struct MRow { h16x8 bg[2], pn[2]; u32x2 o[3][2]; float l[3][2]; };
__device__ __forceinline__ MRow merge_load_row(const h16* Hc, const h16* Obr, const float* Lse, int row, int lane) {
    MRow r;
#pragma unroll
    for (int q = 0; q < 2; ++q) {
        const int c = 512 * q + 8 * lane, h = c >> 7;
        r.bg[q] = *(const h16x8*)(Hc + (size_t)row * 3072 + c);
        const int rn = row + 1 < M ? row + 1 : row;
        r.pn[q] = *(const h16x8*)(Hc + (size_t)rn * 3072 + 1024 + c);
#pragma unroll
        for (int b = 0; b < 3; ++b) { r.o[b][q] = *(const u32x2*)((const unsigned char*)Obr + ((size_t)b * M + row) * 1024 + c); r.l[b][q] = Lse[((size_t)b * M + row) * 8 + h]; }
    }
    return r;
}
__device__ __forceinline__ void merge_phase(Frame& F, const h16* Obr, const float* cws  ) {
    const h16* Hc = (const h16*)(F.ws + WS_R1); const float* Lse = (const float*)(F.ws + WS_LSE); h16* YC = (h16*)(F.ws + WS_R1 + R1_HQKV);
    const int lane_ = mk_lane();
    int vcu_ = F.vcu; asm volatile("" : "+s"(vcu_));
    const int gw = vcu_ * 8 + F.wave, NGW = F.G * 8, lane = lane_;
    const int per = (M + NGW - 1) / NGW; const int r_lo = gw * per, r_hi = (r_lo + per) < M ? (r_lo + per) : M;
    if (r_lo >= r_hi) return;
    float w0[2][8], w1[2][8], w2[2][8];
#pragma unroll
    for (int q = 0; q < 2; ++q)
#pragma unroll
        for (int e = 0; e < 8; ++e) { const int c = 512 * q + 8 * lane + e; w0[q][e] = cws[c]; w1[q][e] = cws[1024 + c]; w2[q][e] = cws[2048 + c]; }
    float pl[2][8], pc[2][8];
#pragma unroll
    for (int q = 0; q < 2; ++q) { const int c = 512 * q + 8 * lane;
        load8(Hc + (size_t)r_lo * 3072 + 1024 + c, pc[q]);
        const int rp = r_lo > 0 ? r_lo - 1 : 0;
        load8(Hc + (size_t)rp * 3072 + 1024 + c, pl[q]); }
    MRow cur = merge_load_row(Hc, Obr, Lse, r_lo, lane);
    for (int row = r_lo; row < r_hi; ++row) {
        MRow nxt = cur;
        if (row + 1 < r_hi) nxt = merge_load_row(Hc, Obr, Lse, row + 1, lane);
        asm volatile("" ::: "memory");
        const int t = row & (SEQ - 1);
        const float ml = t > 0 ? 1.0f : 0.0f, mr = t < SEQ - 1 ? 1.0f : 0.0f;
        h16* yo = YC + (size_t)row * D;
#pragma unroll
        for (int q = 0; q < 2; ++q) {
            const int c = 512 * q + 8 * lane;
            f32x4 o0, o1;
#pragma unroll
            for (int e = 0; e < 8; ++e) { const float pr = (float)cur.pn[q][e];
                const float y = (float)cur.bg[q][e] * (w0[q][e] * (ml * pl[q][e]) + w1[q][e] * pc[q][e] + w2[q][e] * (mr * pr)); if (e < 4) o0[e] = y; else o1[e - 4] = y;
                pl[q][e] = pc[q][e]; pc[q][e] = pr; }
            store_h8(yo + c, o0, o1);
        }
#pragma unroll
        for (int q = 0; q < 2; ++q) {
            const int c = 512 * q + 8 * lane;
            const float l0 = cur.l[0][q], l1 = cur.l[1][q], l2 = cur.l[2][q];
            const float mx = fmaxf(l0, fmaxf(l1, l2)); float e0 = __expf(l0 - mx), e1 = __expf(l1 - mx), e2 = __expf(l2 - mx); const float rs = 0.0625f / (e0 + e1 + e2); e0 *= rs; e1 *= rs; e2 *= rs;
            f32x4 o0, o1;
#pragma unroll
            for (int hw = 0; hw < 2; ++hw) {
                const int x0 = (int)(hw ? cur.o[0][q].y : cur.o[0][q].x), x1 = (int)(hw ? cur.o[1][q].y : cur.o[1][q].x), x2 = (int)(hw ? cur.o[2][q].y : cur.o[2][q].x);
                const f32x2 ylo = __builtin_amdgcn_cvt_pk_f32_fp8(x0, false) * e0 + __builtin_amdgcn_cvt_pk_f32_fp8(x1, false) * e1 + __builtin_amdgcn_cvt_pk_f32_fp8(x2, false) * e2;
                const f32x2 yhi = __builtin_amdgcn_cvt_pk_f32_fp8(x0, true) * e0 + __builtin_amdgcn_cvt_pk_f32_fp8(x1, true) * e1 + __builtin_amdgcn_cvt_pk_f32_fp8(x2, true) * e2;
                if (hw == 0) { o0[0] = ylo.x; o0[1] = ylo.y; o0[2] = yhi.x; o0[3] = yhi.y; } else { o1[0] = ylo.x; o1[1] = ylo.y; o1[2] = yhi.x; o1[3] = yhi.y; } }
            store_h8(yo + 1024 + c, o0, o1);
        }
        cur = nxt;
    }
}

template <bool FINAL, bool WA256 = false>
__device__ __forceinline__ void norm_phase(Frame& F, h16* xb, float* out, const float* g, const float* bta, h16* A256 = nullptr) {
    const int lane_ = mk_lane();
    const int gw = F.vcu * 8 + F.wave, NGW = F.G * 8, lane = lane_;
    f32x4 gg[4][2], bb[4][2];
#pragma unroll
    for (int j = 0; j < 4; ++j) { const int c = 512 * j + 8 * lane; gg[j][0] = *(const f32x4*)(g + c); gg[j][1] = *(const f32x4*)(g + c + 4); bb[j][0] = *(const f32x4*)(bta + c); bb[j][1] = *(const f32x4*)(bta + c + 4); }
    h16x8 xv[4];
    if (gw < M) {
#pragma unroll
        for (int j = 0; j < 4; ++j) xv[j] = ((const h16x8*)(xb + (size_t)gw * D) + lane)[64 * j]; }
    for (int row = gw; row < M; row += NGW) {
        float v[4][8]; float s = 0.f;
#pragma unroll
        for (int j = 0; j < 4; ++j)
#pragma unroll
            for (int e = 0; e < 8; ++e) { v[j][e] = (float)xv[j][e]; s += v[j][e]; }
        const int nrow = row + NGW;
        if (nrow < M) {
#pragma unroll
            for (int j = 0; j < 4; ++j) xv[j] = ((const h16x8*)(xb + (size_t)nrow * D) + lane)[64 * j]; }
        const float mean = wave_sum(s) * (1.0f / D); float s2 = 0.f;
#pragma unroll
        for (int j = 0; j < 4; ++j)
#pragma unroll
            for (int e = 0; e < 8; ++e) { v[j][e] -= mean; s2 += v[j][e] * v[j][e]; }
        const float rstd = 1.0f / sqrtf(wave_sum(s2) * (1.0f / D) + LN_EPS);
#pragma unroll
        for (int j = 0; j < 4; ++j) {
            const int c = 512 * j + 8 * lane;
            f32x4 y0, y1;
#pragma unroll
            for (int e = 0; e < 4; ++e) { y0[e] = v[j][e] * rstd * gg[j][0][e] + bb[j][0][e]; y1[e] = v[j][e + 4] * rstd * gg[j][1][e] + bb[j][1][e]; }
            if (FINAL) { float* o = out + (size_t)row * D + c; *(f32x4*)o = y0; *(f32x4*)(o + 4) = y1; }
            else store_h8(xb + (size_t)row * D + c, y0, y1);
            if (WA256) {
                u32x4 w; w.x = pk_h2(y0[0], y0[1]); w.y = pk_h2(y0[2], y0[3]); w.z = pk_h2(y1[0], y1[1]); w.w = pk_h2(y1[2], y1[3]);
                const h16x8 hv = __builtin_bit_cast(h16x8, w); float a = 0.f;
#pragma unroll
                for (int e = 0; e < 8; e += 2) a += (float)hv[e] - (float)hv[e + 1];
                a = wave_sum(a);
                if (lane == 0) A256[((size_t)(row >> 11) * 4 + j) * 2048 + (row & 2047)] = (h16)a;
            }
        }
    }
}

template <bool KEEPZ> __device__ __forceinline__ void norm_phase_x8(Frame& F, h16* xb, signed char* x8, float* sx, const float* g, const float* bta, float* stats) {
    const int lane_ = mk_lane();
    const int gw = F.vcu * 8 + F.wave, NGW = F.G * 8, lane = lane_;
    f32x4 gg[4][2], bb[4][2];
#pragma unroll
    for (int j = 0; j < 4; ++j) { const int c = 512 * j + 8 * lane; gg[j][0] = *(const f32x4*)(g + c); gg[j][1] = *(const f32x4*)(g + c + 4); bb[j][0] = *(const f32x4*)(bta + c); bb[j][1] = *(const f32x4*)(bta + c + 4); }
    h16x8 xv[4];
    if (gw < M) {
#pragma unroll
        for (int j = 0; j < 4; ++j) xv[j] = ((const h16x8*)(xb + (size_t)gw * D) + lane)[64 * j]; }
    for (int row = gw; row < M; row += NGW) {
        float v[4][8]; float s = 0.f;
#pragma unroll
        for (int j = 0; j < 4; ++j)
#pragma unroll
            for (int e = 0; e < 8; ++e) { v[j][e] = (float)xv[j][e]; s += v[j][e]; }
        const int nrow = row + NGW;
        if (nrow < M) {
#pragma unroll
            for (int j = 0; j < 4; ++j) xv[j] = ((const h16x8*)(xb + (size_t)nrow * D) + lane)[64 * j]; }
        const float mean = wave_sum(s) * (1.0f / D); float s2 = 0.f;
#pragma unroll
        for (int j = 0; j < 4; ++j)
#pragma unroll
            for (int e = 0; e < 8; ++e) { v[j][e] -= mean; s2 += v[j][e] * v[j][e]; }
        const float rstd = 1.0f / sqrtf(wave_sum(s2) * (1.0f / D) + LN_EPS);
        float amax = 0.f;
#pragma unroll
        for (int j = 0; j < 4; ++j) {
            const int c = 512 * j + 8 * lane;
            f32x4 y0, y1;
#pragma unroll
            for (int e = 0; e < 4; ++e) { y0[e] = v[j][e] * rstd * gg[j][0][e] + bb[j][0][e]; y1[e] = v[j][e + 4] * rstd * gg[j][1][e] + bb[j][1][e]; v[j][e] = y0[e]; v[j][e + 4] = y1[e];
                amax = fmaxf(amax, fmaxf(fabsf(y0[e]), fabsf(y1[e]))); }
            if constexpr (!KEEPZ) store_h8(xb + (size_t)row * D + c, y0, y1);
        }
        amax = wave_max(amax);
        const float inv = amax > 0.f ? 127.0f / amax : 0.f;
#pragma unroll
        for (int j = 0; j < 4; ++j) *(u32x2*)(x8 + (size_t)row * D + 512 * j + 8 * lane) = pack8_i8(v[j][0], v[j][1], v[j][2], v[j][3], v[j][4], v[j][5], v[j][6], v[j][7], inv);
        if (lane == 0) { sx[row] = amax * (1.0f / 127.0f); if constexpr (KEEPZ) { f32x2 st; st.x = mean; st.y = rstd; *(f32x2*)(stats + 2 * (size_t)row) = st; } }
    }
}

__device__ __forceinline__ void actq_phase(Frame& F, const h16* act, signed char* a8, float* sa) {
    const int lane = mk_lane();
    int vcu_ = F.vcu; asm volatile("" : "+s"(vcu_));
    const int gw = vcu_ * 8 + F.wave, NGW = F.G * 8;
    h16x8 cur[11];
    if (gw < M) {
#pragma unroll
        for (int j = 0; j < 11; ++j) cur[j] = *(const h16x8*)(act + (size_t)gw * FF + 512 * j + 8 * lane); }
    for (int row = gw; row < M; row += NGW) {
        h16x8 nxt[11];
        const int nrow = row + NGW;
#pragma unroll
        for (int j = 0; j < 11; ++j) nxt[j] = cur[j];
        if (nrow < M) {
#pragma unroll
            for (int j = 0; j < 11; ++j) nxt[j] = *(const h16x8*)(act + (size_t)nrow * FF + 512 * j + 8 * lane); }
        const float sc = rowq_rot(cur, a8 + (size_t)row * FF, lane);
        if (lane == 0) sa[row] = sc;
#pragma unroll
        for (int j = 0; j < 11; ++j) cur[j] = nxt[j];
    }
}

constexpr int N_PHASES = 35;
__global__ void __launch_bounds__(512, 2) mk_fwd(Args args) {
    extern __shared__ __attribute__((aligned(16))) unsigned char lds_raw[];
    Frame F;
    F.lds = (LAS unsigned char*)lds_raw;
    F.MISC = (volatile LAS unsigned*)(F.lds + LDS_MISC);
    const int tid0 = threadIdx.x; F.wave = __builtin_amdgcn_readfirstlane(tid0 >> 6);
    F.G = gridDim.x; { const int bx = blockIdx.x; F.vcu = (F.G % 8 == 0) ? (bx % 8) * (F.G / 8) + bx / 8 : bx; }
    F.ws = args.ws; F.ctl = (unsigned*)(args.ws + WS_CTL);
    if (tid0 < 32) F.MISC[tid0] = 0u;
    __syncthreads();
#if MK_ONE_LAUNCH
    constexpr int lo = 0, hi = N_PHASES;
#else
    const int lo = args.ph_lo, hi = args.ph_hi;
#endif
    XcdBarrier bar; bar.bar = F.ctl + CW_BAR; bar.x = 0; bar.st = nullptr;
    if (hi - lo > 1) bar = xcd_barrier_post(F.ctl + CW_BAR, F.MISC + 8);
    bar.w = F.wave;
#ifndef MK_SITES
#define MK_SITES 0xffffffffu
#endif
#define SITE(n) ((MK_SITES >> (n)) & 1u)
#ifndef MK_REP_MASK
#define MK_REP_MASK 0u
#endif
#define RPT(n) _Pragma("unroll") for (int rep_ = 0; rep_ < 1 + (int)((MK_REP_MASK >> (n)) & 1u); ++rep_)
#define RPB() do { if (rep_) xcd_barrier(bar); } while (0)
#if MK_ONE_LAUNCH
#define IN(k) true
#define SEAM(k) xcd_barrier(bar)
#else
#define IN(k) (lo <= (k) && (k) < hi)
#define SEAM(k) do { if (IN(k) && IN((k) + 1)) xcd_barrier(bar); } while (0)
#endif
    const float* ln_mix_g = args.in[6]; const float* ln_mix_b = args.in[7]; const float* ln_ffn_g = args.in[11]; const float* ln_ffn_b = args.in[12];
    const int bx = (int)blockIdx.x;

    RPT(0) if (SITE(0) && IN(0)) { RPB(); p0_colmax(F, args.in[8], args.in[2]); p0_prologue<0>(F, args); xcd_barrier(bar); p0_prologue<1>(F, args); } SEAM(0);

    for (int pair = 0; pair < 2; ++pair) {
        const int pb = 1 + 17 * pair;
        for (int half = 0; half < 2; ++half) {
            const int l = 2 * pair + half;
            size_t zoff = 0; asm volatile("" : "+s"(zoff));
            unsigned char* ws = args.ws + zoff;
            h16* xb = (h16*)(ws + WS_R2);
            const int pm0 = pb + (half ? 9 : 0);
            int pn_;
            if (half == 0) {
                RPT(1) if (SITE(1) && IN(pm0 + 0)) { RPB();
                    { ProbStd P; P.A = (const char*)xb; P.B = (const char*)(ws + WS_WIN) + (size_t)pair * DIN * D * 2; P.K = D; P.lda = D; P.ldb = D; P.upmap = false; P.S.init(M / 256, 3072 / 256, F.G, bx);
                      EpiIn E{(h16*)(ws + WS_R1), (h16*)(ws + WS_R1 + R1_HQKV), (const float*)(ws + WS_ROPE), (const float*)(ws + WS_ROPE) + 2048 * 64};
                      pg8::gemm_phase<ProbStd, EpiIn>(F.lds, F.wave, P, E); }
                    __syncthreads();
                    { ProbStd P; P.A = (const char*)(ws + WS_X8); P.B = (const char*)(ws + WS_WIN8) + (size_t)pair * 3072 * D; P.K = D / 2; P.lda = D / 2; P.ldb = D / 2; P.upmap = false; P.S.init(M / 256, 3072 / 256, F.G, bx);
                      EpiInQ E{(h16*)(ws + WS_R1 + R1_HQKV), (const float*)(ws + WS_ROPE), (const float*)(ws + WS_ROPE) + 2048 * 64, (const float*)(ws + WS_VEC) + V_SX, (const float*)(ws + WS_VEC) + V_SWQ + pair * 3072};
                      pg8::gemm_phase<ProbStd, EpiInQ, true>(F.lds, F.wave, P, E); }
                }
                SEAM(pm0 + 0);
                RPT(2) if (SITE(2) && IN(pm0 + 1)) { RPB(); attn_phase(F, (h16*)args.out); }
                SEAM(pm0 + 1);
                RPT(3) if (SITE(3) && IN(pm0 + 2)) { RPB(); merge_phase(F, (const h16*)args.out, args.in[3] + (size_t)pair * 3 * CONV); }
                SEAM(pm0 + 2);
                RPT(4) if (SITE(4) && IN(pm0 + 3)) { RPB();
                    ProbStd P; P.A = (const char*)(ws + WS_R1 + R1_HQKV); P.B = (const char*)(ws + WS_WOM) + (size_t)pair * D * D * 2; P.K = D; P.lda = D; P.ldb = D; P.upmap = false; P.S.init(M / 256, D / 256, F.G, bx);
                    EpiRes E{xb, nullptr, nullptr, nullptr};
                    pg8::gemm_phase<ProbStd, EpiRes>(F.lds, F.wave, P, E);
                }
                SEAM(pm0 + 3);
                pn_ = pm0 + 4;
            } else {
                RPT(5) if (SITE(5) && IN(pm0 + 0)) { RPB();
                    ProbDftC P; P.Dm = (const char*)(ws + WS_DM); P.zb = (const char*)xb; P.G = F.G; P.c = bx;
                    EpiDftC E{(h16*)(ws + WS_R1)};
                    pg8::gemm_phase<ProbDftC, EpiDftC>(F.lds, F.wave, P, E);
                }
                SEAM(pm0 + 0);
                RPT(6) if (SITE(6) && IN(pm0 + 1)) { RPB();
                    ProbDftS P; P.Fmat = (const char*)(ws + WS_FMAT); P.Bt = (const char*)(ws + WS_R1); P.G = F.G; P.c = bx;
                    EpiDftS2 E{(h16*)(ws + WS_R1 + R1_F), args.out + (size_t)blockIdx.x * 65536};
                    pg8::gemm_phase<ProbDftS, EpiDftS2>(F.lds, F.wave, P, E);
                    dfts_side(F, (const h16*)(ws + WS_R1), (const h16*)(ws + WS_STATS), (const h16*)(ws + WS_FMAT), (h16*)(ws + WS_R1 + R1_F));
                }
                SEAM(pm0 + 1);
                RPT(7) if (SITE(7) && IN(pm0 + 2)) { RPB();
                    ProbStd P; P.A = (const char*)(ws + WS_R1 + R1_F); P.B = (const char*)(ws + WS_WOF) + (size_t)pair * D * D * 2; P.K = D; P.lda = D; P.ldb = D; P.upmap = false; P.S.init(M / 256, D / 256, F.G, bx);
                    EpiRes E{xb, nullptr, nullptr, nullptr};
                    pg8::gemm_phase<ProbStd, EpiRes>(F.lds, F.wave, P, E);
                }
                SEAM(pm0 + 2);
                pn_ = pm0 + 3;
            }
            RPT(8) if (SITE(8) && IN(pn_)) { RPB(); norm_phase_x8<true>(F, xb, (signed char*)(ws + WS_X8), (float*)(ws + WS_VEC) + V_SX, ln_mix_g + l * D, ln_mix_b + l * D, (float*)(ws + WS_LSE)); }
            SEAM(pn_);
            const int pf = pn_ + 1;
            const bool i8 = (kI8Mask >> l) & 1u;
            const char* Wup = i8 ? (const char*)(ws + WS_W8) + (size_t)l * FF2 * D : (const char*)(ws + WS_WUP) + (size_t)l * FF2 * D * 2;
            const float* swl = (const float*)(ws + WS_VEC) + V_SW + l * FF2; const float* sxv = (const float*)(ws + WS_VEC) + V_SX;
            RPT(9) if (SITE(9) && IN(pf + 0)) { RPB();
                if (kI8Mask == 0xFu || (kI8Mask != 0u && i8)) { ProbHalo P; P.A = (const char*)(ws + WS_X8); P.B = Wup; P.K = D / 2; P.lda = D / 2; P.ldb = D / 2; P.G = F.G; P.c = bx;
                    EpiHalo<true> E{(float*)(ws + WS_HALO), sxv, swl};
                    pg8::gemm_phase<ProbHalo, EpiHalo<true>, true>(F.lds, F.wave, P, E); }
                else if constexpr (kI8Mask != 0xFu) { ProbHalo P; P.A = (const char*)xb; P.B = Wup; P.K = D; P.lda = D; P.ldb = D; P.G = F.G; P.c = bx;
                    EpiHalo<false> E{(float*)(ws + WS_HALO), sxv, swl};
                    pg8::gemm_phase<ProbHalo, EpiHalo<false>, false>(F.lds, F.wave, P, E); }
            }
            SEAM(pf + 0);
            RPT(10) if (SITE(10) && IN(pf + 1)) { RPB();
                if (kI8Mask == 0xFu || (kI8Mask != 0u && i8)) { ProbStd P; P.A = (const char*)(ws + WS_X8); P.B = Wup; P.K = D / 2; P.lda = D / 2; P.ldb = D / 2; P.upmap = true; P.S.init(M / 256, FF2 / 256, F.G, bx);
                    EpiUp<true> E{(h16*)(ws + WS_R1), (const float*)(ws + WS_HALO), args.in[9] + (size_t)l * 3 * FF2, sxv, swl};
                    pg8::gemm_phase<ProbStd, EpiUp<true>, true>(F.lds, F.wave, P, E); }
                else if constexpr (kI8Mask != 0xFu) { ProbStd P; P.A = (const char*)xb; P.B = Wup; P.K = D; P.lda = D; P.ldb = D; P.upmap = true; P.S.init(M / 256, FF2 / 256, F.G, bx);
                    EpiUp<false> E{(h16*)(ws + WS_R1), (const float*)(ws + WS_HALO), args.in[9] + (size_t)l * 3 * FF2, sxv, swl};
                    pg8::gemm_phase<ProbStd, EpiUp<false>, false>(F.lds, F.wave, P, E); }
            }
            SEAM(pf + 1);
            const bool d8 = (kD8Mask >> l) & 1u;
            if (kD8Mask != 0u && d8) { actq_phase(F, (const h16*)(ws + WS_R1), (signed char*)args.out, (float*)(ws + WS_VEC) + V_SA); xcd_barrier(bar); }
            RPT(11) if (SITE(11) && IN(pf + 2)) { RPB();
                if (kD8Mask != 0u && d8) {
                    ProbStd P; P.A = (const char*)args.out; P.B = (const char*)(ws + WS_WDN8) + (size_t)l * D * FF; P.K = FF / 2; P.lda = FF / 2; P.ldb = FF / 2; P.upmap = false; P.S.init(M / 256, D / 256, F.G, bx);
                    EpiResT<true, true> E{xb, (const float*)(ws + WS_LSE), ln_mix_g + l * D, ln_mix_b + l * D, (const float*)(ws + WS_VEC) + V_SA, (const float*)(ws + WS_VEC) + V_SWD + l * D};
                    pg8::gemm_phase<ProbStd, EpiResT<true, true>, true>(F.lds, F.wave, P, E);
                } else if constexpr (kD8Mask != 0xFu) {
                    ProbStd P; P.A = (const char*)(ws + WS_R1); P.B = (const char*)(ws + WS_WDN) + (size_t)l * D * FF * 2; P.K = FF; P.lda = FF; P.ldb = FF; P.upmap = false; P.S.init(M / 256, D / 256, F.G, bx);
                    EpiResT<true> E{xb, (const float*)(ws + WS_LSE), ln_mix_g + l * D, ln_mix_b + l * D};
                    pg8::gemm_phase<ProbStd, EpiResT<true>>(F.lds, F.wave, P, E);
                }
            }
            SEAM(pf + 2);
            if (l < 3) { RPT(12) if (SITE(12) && IN(pf + 3)) { RPB(); if (half == 0) norm_phase<false, true>(F, xb, args.out, ln_ffn_g + l * D, ln_ffn_b + l * D, (h16*)(ws + WS_STATS)); else norm_phase_x8<false>(F, xb, (signed char*)(ws + WS_X8), (float*)(ws + WS_VEC) + V_SX, ln_ffn_g + l * D, ln_ffn_b + l * D, nullptr); } SEAM(pf + 3); }
            else { RPT(13) if (SITE(13) && IN(pf + 3)) norm_phase<true>(F, xb, args.out, ln_ffn_g + l * D, ln_ffn_b + l * D); }
        }
    }
#undef IN
#undef SEAM
}

extern "C" void kernel_launch(void* const* d_in, const int* in_sizes, int n_in, void* d_out, int out_size, void* d_ws, size_t ws_size, hipStream_t stream) {
    static int grid = 0;
    if (grid == 0) {
        if (n_in != 13 || out_size != M * D || ws_size < WS_END) { fprintf(stderr, "kernel_launch: unexpected problem (n_in %d, out %d, ws %zu)\n", n_in, out_size, ws_size); grid = -1; return; }
        int dev = 0, cus = 0, per_cu = 0;
        if (hipGetDevice(&dev) != hipSuccess || hipDeviceGetAttribute(&cus, hipDeviceAttributeMultiprocessorCount, dev) != hipSuccess) { grid = -1; return; }
        if (hipFuncSetAttribute((const void*)mk_fwd, hipFuncAttributeMaxDynamicSharedMemorySize, LDS_BYTES) != hipSuccess) { fprintf(stderr, "kernel_launch: hipFuncSetAttribute failed\n"); grid = -1; return; }
        if (hipOccupancyMaxActiveBlocksPerMultiprocessor(&per_cu, (const void*)mk_fwd, 512, LDS_BYTES) != hipSuccess || per_cu < 1) { fprintf(stderr, "kernel_launch: occupancy query says %d\n", per_cu); }
        (void)hipGetLastError();
        grid = cus;
    }
    if (grid < 0) return;
    (void)hipMemsetAsync((char*)d_ws + WS_CTL, 0, CTL_ZERO_BYTES, stream);
    Args a{};
    for (int i = 0; i < 13; ++i) a.in[i] = (const float*)d_in[i];
    a.out = (float*)d_out; a.ws = (unsigned char*)d_ws;
#if MK_ONE_LAUNCH
    a.ph_lo = 0; a.ph_hi = N_PHASES;
    hipLaunchKernelGGL(mk_fwd, dim3(grid), dim3(512), LDS_BYTES, stream, a);
#else
    for (int k = 0; k < N_PHASES; ++k) { a.ph_lo = k; a.ph_hi = k + 1; hipLaunchKernelGGL(mk_fwd, dim3(grid), dim3(512), LDS_BYTES, stream, a); }
#endif
}
```

```cpp
#include <hip/hip_runtime.h>
#include <cstdio>
#include <cstdint>

#ifndef MK_ONE_LAUNCH
#define MK_ONE_LAUNCH 1
#endif

#define LAS __attribute__((address_space(3)))
#define GAS __attribute__((address_space(1)))
typedef _Float16 h16;
typedef _Float16 h16x8 __attribute__((ext_vector_type(8)));
typedef _Float16 h16x4 __attribute__((ext_vector_type(4)));
typedef _Float16 h16x2 __attribute__((ext_vector_type(2)));
typedef float f32x4 __attribute__((ext_vector_type(4)));
typedef float f32x2 __attribute__((ext_vector_type(2)));
typedef unsigned u32x4 __attribute__((ext_vector_type(4)));
typedef unsigned u32x2 __attribute__((ext_vector_type(2)));
typedef short s16x4 __attribute__((ext_vector_type(4)));

constexpr int D = 2048, SEQ = 2048, NSEQ = 24, M = NSEQ * SEQ;
constexpr int M_PROMPT = 16 * SEQ;
constexpr int CONV = 1024, ATT = 1024, NH = 8, HD = 128, DIN = 6144, FF = 5632, FF2 = 11264;
constexpr int NHALO = 2 * (M / 128);
constexpr float ALPHA = 1.6817928305074290861f;
constexpr float LN_EPS = 1e-5f;
constexpr float QSCALE = 0.08838834764831844055f * 1.44269504088896341f;

constexpr size_t MiB = 1u << 20;
constexpr size_t WS_CTL = 0, CTL_ZERO_BYTES = 256 * 1024;
constexpr size_t WS_ROPE = 1 * MiB;
constexpr size_t WS_VEC = 2 * MiB;
constexpr size_t WS_PART = 3 * MiB;
constexpr size_t WS_STATS = 19 * MiB;
constexpr size_t WS_LSE = 27 * MiB;
constexpr size_t WS_HALO = 32 * MiB;
constexpr size_t WS_FMAT = 66 * MiB;
constexpr size_t WS_DM = 82 * MiB;
constexpr size_t WS_WIN = 90 * MiB;
constexpr size_t WS_WOM = 138 * MiB;
constexpr size_t WS_WOF = 154 * MiB;
constexpr size_t WS_WUP = 170 * MiB;
constexpr size_t WS_WDN = 346 * MiB;
constexpr size_t WS_R2 = 434 * MiB;
constexpr size_t WS_R1 = 722 * MiB;
constexpr size_t WS_X8 = 1298 * MiB;
constexpr size_t WS_W8 = 1394 * MiB;
constexpr size_t WS_END = 1482 * MiB;
constexpr size_t WS_WDN8 = WS_WUP + 16 * MiB;
constexpr size_t WS_WIN8 = WS_WUP;
#ifndef I8MASK
#define I8MASK 0xF
#endif
constexpr unsigned kI8Mask = I8MASK;
constexpr size_t R1_HQKV = (size_t)M * 3072 * 2;
constexpr int BTP = 4096 + 64;
constexpr size_t R1_F = (size_t)NSEQ * 2048 * 4096 * 2;
constexpr int V_CSUM_IN = 0, V_BIAS_IN = V_CSUM_IN + 2 * DIN, V_CSUM_UP = V_BIAS_IN + 2 * DIN, V_BIAS_UP = V_CSUM_UP + 4 * FF2,
              V_CSUM_D = V_BIAS_UP + 4 * FF2, V_BIAS_D = V_CSUM_D + 2 * 4 * 1024, V_ONES = V_BIAS_D + 2 * 4 * 1024, V_ZEROS = V_ONES + D, V_END = V_ZEROS + D;
static_assert(V_END * 4 <= (int)MiB, "vector region");
constexpr int V_SW = 0;
constexpr int V_SX = 65536;
constexpr int V_SWQ = 4 * FF2;
constexpr int PM_STRIDE = 4 * FF2 + 2 * 3072;
constexpr int V_SWD = V_SWQ + 2 * 3072;
constexpr int V_SA = 131072;
static_assert(V_SWD + 4 * D <= V_SX && (V_SX + M) <= V_SA && (V_SA + M) * 4 <= (int)MiB, "scale vectors");
#ifndef D8MASK
#define D8MASK 0xF
#endif
constexpr unsigned kD8Mask = D8MASK;
static_assert(MK_ONE_LAUNCH || kD8Mask == 0u, "the activation-quantisation phase has no phase id of its own");
__host__ __device__ constexpr size_t part_off(int mi) { return mi < 2 ? (size_t)mi * 32 * 2 * DIN : (size_t)2 * 32 * 2 * DIN + (size_t)(mi - 2) * 32 * 2 * FF2; }
static_assert(part_off(6) * 4 <= 16 * MiB, "partial region");

constexpr int CW_BAR = 1024;
constexpr int CW_SMAX = 16384;
constexpr int LDS_BYTES = 147456;
constexpr int LDS_TAB = 131072;
constexpr int LDS_RED = 133120;
constexpr int LDS_MISC = LDS_BYTES - 128;
constexpr int ATT_K = 0, ATT_V = 65536;
static_assert(ATT_V + 272 * 256 <= LDS_MISC, "attention LDS");

__device__ __forceinline__ unsigned pk_h2(float lo, float hi) { f32x2 v = {lo, hi}; h16x2 h = __builtin_convertvector(v, h16x2); return __builtin_bit_cast(unsigned, h); }
__device__ __forceinline__ int mk_lane() { int l; asm volatile("v_mbcnt_lo_u32_b32 %0, -1, 0\n\tv_mbcnt_hi_u32_b32 %0, -1, %0" : "=v"(l)); return l; }
template <int O> __device__ __forceinline__ float shx(float v) {
    if constexpr (O < 32) return __builtin_bit_cast(float, __builtin_amdgcn_ds_swizzle(__builtin_bit_cast(int, v), (O << 10) | 0x1f));
    else return __builtin_bit_cast(float, __builtin_amdgcn_ds_bpermute((mk_lane() ^ 32) << 2, __builtin_bit_cast(int, v)));
}
template <int CTRL, int RM> __device__ __forceinline__ float dpp_f(float ident, float v) {
    return __builtin_bit_cast(float, __builtin_amdgcn_update_dpp(__builtin_bit_cast(int, ident), __builtin_bit_cast(int, v), CTRL, RM, 0xF, false));
}
__device__ __forceinline__ float wave_sum(float v) {
    v += dpp_f<0xB1, 0xF>(0.f, v); v += dpp_f<0x4E, 0xF>(0.f, v); v += dpp_f<0x141, 0xF>(0.f, v); v += dpp_f<0x140, 0xF>(0.f, v);
    v += dpp_f<0x142, 0xA>(0.f, v); v += dpp_f<0x143, 0xC>(0.f, v);
    return __builtin_bit_cast(float, __builtin_amdgcn_readlane(__builtin_bit_cast(int, v), 63));
}
__device__ __forceinline__ float wave_max(float v) {
    v = fmaxf(v, dpp_f<0xB1, 0xF>(0.f, v)); v = fmaxf(v, dpp_f<0x4E, 0xF>(0.f, v)); v = fmaxf(v, dpp_f<0x141, 0xF>(0.f, v)); v = fmaxf(v, dpp_f<0x140, 0xF>(0.f, v));
    v = fmaxf(v, dpp_f<0x142, 0xA>(0.f, v)); v = fmaxf(v, dpp_f<0x143, 0xC>(0.f, v));
    return __builtin_bit_cast(float, __builtin_amdgcn_readlane(__builtin_bit_cast(int, v), 63));
}
__device__ __forceinline__ void rot128(float (&v)[8], float s1, float s2, float s3, float s4) {
#pragma unroll
    for (int h = 1; h < 8; h <<= 1)
#pragma unroll
        for (int i = 0; i < 8; ++i) if ((i & h) == 0) { const float a = v[i], b = v[i + h]; v[i] = a + b; v[i + h] = a - b; }
    asm volatile(
        "s_nop 1\n\t"
        "v_fmac_f32_dpp %0, %0, %8 quad_perm:[1,0,3,2] row_mask:0xf bank_mask:0xf\n\t"
        "v_fmac_f32_dpp %1, %1, %8 quad_perm:[1,0,3,2] row_mask:0xf bank_mask:0xf\n\t"
        "v_fmac_f32_dpp %2, %2, %8 quad_perm:[1,0,3,2] row_mask:0xf bank_mask:0xf\n\t"
        "v_fmac_f32_dpp %3, %3, %8 quad_perm:[1,0,3,2] row_mask:0xf bank_mask:0xf\n\t"
        "v_fmac_f32_dpp %4, %4, %8 quad_perm:[1,0,3,2] row_mask:0xf bank_mask:0xf\n\t"
        "v_fmac_f32_dpp %5, %5, %8 quad_perm:[1,0,3,2] row_mask:0xf bank_mask:0xf\n\t"
        "v_fmac_f32_dpp %6, %6, %8 quad_perm:[1,0,3,2] row_mask:0xf bank_mask:0xf\n\t"
        "v_fmac_f32_dpp %7, %7, %8 quad_perm:[1,0,3,2] row_mask:0xf bank_mask:0xf\n\t"
        "v_fmac_f32_dpp %0, %0, %9 quad_perm:[2,3,0,1] row_mask:0xf bank_mask:0xf\n\t"
        "v_fmac_f32_dpp %1, %1, %9 quad_perm:[2,3,0,1] row_mask:0xf bank_mask:0xf\n\t"
        "v_fmac_f32_dpp %2, %2, %9 quad_perm:[2,3,0,1] row_mask:0xf bank_mask:0xf\n\t"
        "v_fmac_f32_dpp %3, %3, %9 quad_perm:[2,3,0,1] row_mask:0xf bank_mask:0xf\n\t"
        "v_fmac_f32_dpp %4, %4, %9 quad_perm:[2,3,0,1] row_mask:0xf bank_mask:0xf\n\t"
        "v_fmac_f32_dpp %5, %5, %9 quad_perm:[2,3,0,1] row_mask:0xf bank_mask:0xf\n\t"
        "v_fmac_f32_dpp %6, %6, %9 quad_perm:[2,3,0,1] row_mask:0xf bank_mask:0xf\n\t"
        "v_fmac_f32_dpp %7, %7, %9 quad_perm:[2,3,0,1] row_mask:0xf bank_mask:0xf\n\t"
        "v_fmac_f32_dpp %0, %0, %10 row_half_mirror row_mask:0xf bank_mask:0xf\n\t"
        "v_fmac_f32_dpp %1, %1, %10 row_half_mirror row_mask:0xf bank_mask:0xf\n\t"
        "v_fmac_f32_dpp %2, %2, %10 row_half_mirror row_mask:0xf bank_mask:0xf\n\t"
        "v_fmac_f32_dpp %3, %3, %10 row_half_mirror row_mask:0xf bank_mask:0xf\n\t"
        "v_fmac_f32_dpp %4, %4, %10 row_half_mirror row_mask:0xf bank_mask:0xf\n\t"
        "v_fmac_f32_dpp %5, %5, %10 row_half_mirror row_mask:0xf bank_mask:0xf\n\t"
        "v_fmac_f32_dpp %6, %6, %10 row_half_mirror row_mask:0xf bank_mask:0xf\n\t"
        "v_fmac_f32_dpp %7, %7, %10 row_half_mirror row_mask:0xf bank_mask:0xf\n\t"
        "v_fmac_f32_dpp %0, %0, %11 row_mirror row_mask:0xf bank_mask:0xf\n\t"
        "v_fmac_f32_dpp %1, %1, %11 row_mirror row_mask:0xf bank_mask:0xf\n\t"
        "v_fmac_f32_dpp %2, %2, %11 row_mirror row_mask:0xf bank_mask:0xf\n\t"
        "v_fmac_f32_dpp %3, %3, %11 row_mirror row_mask:0xf bank_mask:0xf\n\t"
        "v_fmac_f32_dpp %4, %4, %11 row_mirror row_mask:0xf bank_mask:0xf\n\t"
        "v_fmac_f32_dpp %5, %5, %11 row_mirror row_mask:0xf bank_mask:0xf\n\t"
        "v_fmac_f32_dpp %6, %6, %11 row_mirror row_mask:0xf bank_mask:0xf\n\t"
        "v_fmac_f32_dpp %7, %7, %11 row_mirror row_mask:0xf bank_mask:0xf\n\t"
        : "+v"(v[0]), "+v"(v[1]), "+v"(v[2]), "+v"(v[3]), "+v"(v[4]), "+v"(v[5]), "+v"(v[6]), "+v"(v[7])
        : "v"(s1), "v"(s2), "v"(s3), "v"(s4));
}
__device__ __forceinline__ u32x2 pack8_i8(float a0, float a1, float a2, float a3, float a4, float a5, float a6, float a7, float inv) {
    const unsigned b0 = __builtin_bit_cast(unsigned, __builtin_fmaf(a0, inv, 12582912.0f)), b1 = __builtin_bit_cast(unsigned, __builtin_fmaf(a1, inv, 12582912.0f)),
                   b2 = __builtin_bit_cast(unsigned, __builtin_fmaf(a2, inv, 12582912.0f)), b3 = __builtin_bit_cast(unsigned, __builtin_fmaf(a3, inv, 12582912.0f)),
                   b4 = __builtin_bit_cast(unsigned, __builtin_fmaf(a4, inv, 12582912.0f)), b5 = __builtin_bit_cast(unsigned, __builtin_fmaf(a5, inv, 12582912.0f)),
                   b6 = __builtin_bit_cast(unsigned, __builtin_fmaf(a6, inv, 12582912.0f)), b7 = __builtin_bit_cast(unsigned, __builtin_fmaf(a7, inv, 12582912.0f));
    u32x2 o;
    o.x = __builtin_amdgcn_perm(b1, b0, 0x0c0c0400u) | __builtin_amdgcn_perm(b3, b2, 0x04000c0cu);
    o.y = __builtin_amdgcn_perm(b5, b4, 0x0c0c0400u) | __builtin_amdgcn_perm(b7, b6, 0x04000c0cu);
    return o;
}
__device__ __forceinline__ float rowq_rot(const h16x8 (&in)[11], signed char* dst, int lane) {
    const float s1 = (lane & 1) ? -1.0f : 1.0f, s2 = (lane & 2) ? -1.0f : 1.0f, s3 = (lane & 4) ? -1.0f : 1.0f, s4 = (lane & 8) ? -1.0f : 1.0f;
    float v[11][8];
#pragma unroll
    for (int j = 0; j < 11; ++j) {
#pragma unroll
        for (int e = 0; e < 8; ++e) v[j][e] = (float)in[j][e];
        rot128(v[j], s1, s2, s3, s4);
    }
#pragma unroll
    for (int j = 0; j < 10; j += 2)
#pragma unroll
        for (int e = 0; e < 8; ++e) { const float a = v[j][e], b = v[j + 1][e]; v[j][e] = a + b; v[j + 1][e] = a - b; }
#pragma unroll
    for (int j = 0; j < 8; ++j) if ((j & 2) == 0) {
#pragma unroll
        for (int e = 0; e < 8; ++e) { const float a = v[j][e], b = v[j + 2][e]; v[j][e] = a + b; v[j + 2][e] = a - b; } }
    float m0 = 0.f, m1 = 0.f, m2 = 0.f;
#pragma unroll
    for (int j = 0; j < 11; ++j)
#pragma unroll
        for (int e = 0; e < 8; ++e) { const float a = fabsf(v[j][e]); if (j < 8) m0 = fmaxf(m0, a); else if (j < 10) m1 = fmaxf(m1, a); else m2 = fmaxf(m2, a); }
    float amax = fmaxf(fmaxf(0.5f * m0, 0.70710678118654752f * m1), m2);
    amax = wave_max(amax);
    const float inv = amax > 0.f ? 127.0f / amax : 0.f;
#pragma unroll
    for (int j = 0; j < 11; ++j) { const float fi = inv * (j < 8 ? 0.5f : (j < 10 ? 0.70710678118654752f : 1.0f));
        *(u32x2*)(dst + 512 * j + 8 * lane) = pack8_i8(v[j][0], v[j][1], v[j][2], v[j][3], v[j][4], v[j][5], v[j][6], v[j][7], fi); }
    return amax * (1.0f / 127.0f);
}
#define LDS_FENCE_BAR() do { asm volatile("s_waitcnt lgkmcnt(0)" ::: "memory"); __builtin_amdgcn_s_barrier(); asm volatile("" ::: "memory"); } while (0)

#define XB_TMO      128
#define XB_XCNT(j)  (256  + 64 * (j))
#define XB_XSUB(j)  (1280 + 64 * (j))
#define XB_XGEN(j)  (2304 + 64 * (j))
#define XB_TOP      3328
#define XB_TOPGEN   3392
#define XCD_BAR_WORDS 3456
#define XB_SPIN_CAP (1u << 22)
static_assert(kI8Mask == 0xFu, "WS_WIN8 lives in the fp16 up-weight region");
static_assert(CW_BAR + XCD_BAR_WORDS <= CW_SMAX && (CW_SMAX + 4 * FF2) * 4 <= (int)CTL_ZERO_BYTES, "control words inside the memset region");
__device__ __forceinline__ unsigned xb_ld(unsigned* p)              { return __hip_atomic_load(p, __ATOMIC_RELAXED, __HIP_MEMORY_SCOPE_AGENT); }
__device__ __forceinline__ unsigned xb_add(unsigned* p, unsigned v) { return __hip_atomic_fetch_add(p, v, __ATOMIC_RELAXED, __HIP_MEMORY_SCOPE_AGENT); }
__device__ __forceinline__ unsigned xb_xcc_id() { return (unsigned)__builtin_amdgcn_s_getreg((3 << 11) | 20) & 0xFu; }
#define XB_SPIN(cond, bar) do { unsigned _sp = 0; while (cond) { __builtin_amdgcn_s_sleep(1); \
    if ((++_sp & 255u) == 0u) { if (xb_ld(&(bar)[XB_TMO])) break; if (_sp > XB_SPIN_CAP) { atomicAdd(&(bar)[XB_TMO], 1u); break; } } } } while (0)
struct XcdBarrier { unsigned* bar; unsigned x; volatile LAS unsigned* st; int w; };
__device__ __forceinline__ XcdBarrier xcd_barrier_post(unsigned* bar, volatile LAS unsigned* st) {
    XcdBarrier b; b.bar = bar; b.x = xb_xcc_id(); b.st = st; b.w = 0;
    if (threadIdx.x == 0) (void)xb_add(&bar[XB_XCNT(b.x)], 1u);
    return b;
}
__device__ __forceinline__ void xcd_barrier_complete(unsigned* bar, unsigned x, unsigned& nloc, unsigned& nx) {
    const unsigned G = gridDim.x * gridDim.y * gridDim.z;
    unsigned sum, cnt, mine, sp = 0u;
    for (;;) {
        sum = 0u; cnt = 0u; mine = 0u;
#pragma unroll
        for (unsigned j = 0; j < 16; ++j) { const unsigned c = xb_ld(&bar[XB_XCNT(j)]); sum += c; cnt += (c > 0u) ? 1u : 0u; mine = (j == x) ? c : mine; }
        if (sum == G) break;
        __builtin_amdgcn_s_sleep(1);
        if ((++sp & 255u) == 0u) { if (xb_ld(&bar[XB_TMO])) break; if (sp > XB_SPIN_CAP) { atomicAdd(&bar[XB_TMO], 1u); break; } }
    }
    nloc = mine > 0u ? mine : 1u; nx = cnt > 0u ? cnt : 1u;
}
__device__ __forceinline__ void xcd_barrier(const XcdBarrier& b) {
    asm volatile("s_waitcnt vmcnt(0)" ::: "memory");
    __syncthreads();
    if (b.w == 0 && mk_lane() == 0) {
        unsigned* bar = b.bar;
        __builtin_amdgcn_s_waitcnt(0);
        unsigned nloc = b.st[0], nx = b.st[1];
        if (nloc == 0u) { xcd_barrier_complete(bar, b.x, nloc, nx); b.st[0] = nloc; b.st[1] = nx; }
        const unsigned old = xb_add(&bar[XB_XSUB(b.x)], 1u);
        const unsigned gen = old / nloc;
        if (old + 1u == (gen + 1u) * nloc) {
            __builtin_amdgcn_fence(__ATOMIC_RELEASE, "agent");
            asm volatile("s_waitcnt vmcnt(0)" ::: "memory");
            const unsigned og = xb_add(&bar[XB_TOP], 1u);
            const unsigned tg = og / nx;
            if (og + 1u == (tg + 1u) * nx) xb_add(&bar[XB_TOPGEN], 1u);
            else XB_SPIN(xb_ld(&bar[XB_TOPGEN]) == tg, bar);
            __builtin_amdgcn_fence(__ATOMIC_ACQUIRE, "agent");
            xb_add(&bar[XB_XGEN(b.x)], 1u);
            asm volatile("s_waitcnt vmcnt(0)" ::: "memory");
        } else {
            XB_SPIN(xb_ld(&bar[XB_XGEN(b.x)]) == gen, bar);
            __builtin_amdgcn_fence(__ATOMIC_ACQUIRE, "agent");
            asm volatile("s_waitcnt vmcnt(0)" ::: "memory");
        }
    }
    __syncthreads();
}

namespace pg8 {
constexpr int BM = 256, BK = 64, HALF = 128, HTB = HALF * BK * 2, STAGE_BYTES = 8 * HTB, NXCD = 8, WGM = 4;
__device__ __forceinline__ int lds_byte(int r, int c) { const int st = (r >> 4) * 2 + (c >> 5), rr = r & 15, cc = c & 31, ob = rr * 64 + cc * 2; return st * 1024 + (ob ^ (((ob >> 9) & 1) << 5)); }
__device__ __forceinline__ void stage_rc(int b, int& R, int& C) { const int st = b / 1024, sb = b % 1024, swz = sb ^ (((sb >> 9) & 1) << 5); R = (st >> 1) * 16 + swz / 64; C = (st & 1) * 32 + (swz % 64) / 2; }
__device__ __forceinline__ int perm32(int rho) { const int n = rho >> 4, i = rho & 15; return 8 * (i >> 2) + 4 * n + (i & 3); }
struct Unit { int pm, pn, g; int part, keep; };
typedef f32x4 Acc[2][2][4][2];
__device__ __forceinline__ void glds16_s(const void* sbase, unsigned voff, unsigned lds_dst) {
    unsigned keep;
    asm volatile("s_mov_b32 %0, m0\n\ts_mov_b32 m0, %3\n\ts_nop 0\n\tglobal_load_lds_dwordx4 %1, %2\n\ts_mov_b32 m0, %0" : "=&s"(keep) : "v"(voff), "s"(sbase), "s"(lds_dst) : "memory");
}

struct StaticOrder {
    int nM, nN, nwg, G, c;
    __device__ void init(int nM_, int nN_, int G_, int c_) { nM = nM_; nN = nN_; nwg = nM * nN; G = G_; c = c_; }
    __device__ bool next(int i, Unit& u) const {
        const long L = (long)i * G + c; if (L >= nwg) return false;
        int wgid = (int)L; { const int q = nwg / NXCD, r = nwg % NXCD, xcd = wgid % NXCD, off = wgid / NXCD; wgid = (xcd < r ? xcd * (q + 1) : r * (q + 1) + (xcd - r) * q) + off; }
        const int nig = WGM * nN, gid = wgid / nig, fm = gid * WGM, gsz = (nM - fm) < WGM ? (nM - fm) : WGM;
        u.pm = fm + ((wgid % nig) % gsz); u.pn = (wgid % nig) / gsz; u.g = 0; u.part = 0; u.keep = 0; return true;
    }
};

typedef int i32x4 __attribute__((ext_vector_type(4)));
template <bool I8> __device__ __forceinline__ f32x4 mma_step(const h16x8& b, const h16x8& a, const f32x4& c) {
    if constexpr (I8) return __builtin_bit_cast(f32x4, __builtin_amdgcn_mfma_i32_16x16x64_i8(__builtin_bit_cast(i32x4, b), __builtin_bit_cast(i32x4, a), __builtin_bit_cast(i32x4, c), 0, 0, 0));
    else return __builtin_amdgcn_mfma_f32_16x16x32_f16(b, a, c, 0, 0, 0);
}
template <class Prob, class Epi, bool I8 = false, bool ALIGN_EPI = true, bool SP2 = true>
__device__ __forceinline__ void gemm_phase(LAS unsigned char* lds, int wave, const Prob& P, const Epi& E) {
    const int tid_ = wave * 64 + mk_lane();
    const int tid = tid_, wid = __builtin_amdgcn_readfirstlane(tid >> 6), lane = tid & 63, wr = wid >> 2, wc = wid & 3, fr = lane & 15, fq = lane >> 4;
    const int K = P.K, nt = K / BK;
    unsigned voffA[2], voffB[2];
#pragma unroll
    for (int i = 0; i < 2; ++i) { int R, C; stage_rc(tid * 16 + i * 8192, R, C); const int Rb = (R & ~31) + perm32(R & 31);
        voffA[i] = P.a_rowoff(R) + (unsigned)C * 2u; voffB[i] = P.b_rowoff(Rb) + (unsigned)C * 2u; }
    const size_t kstep = (size_t)(BK * 2);
    const size_t hstepA = P.a_hstep(), hstepB = P.b_hstep();
    const unsigned ldsw = (unsigned)wid * 1024u;
    const unsigned ldsb = (unsigned)(size_t)lds + ldsw;
    const int aoff = lds_byte(wr * 64 + fr, fq * 8), boff = lds_byte(wc * 32 + fr, fq * 8);
#define PG8_SA(b, h) (((b) * 2 + (h)) * HTB)
#define PG8_SB(b, h) ((4 + (b) * 2 + (h)) * HTB)
#define PG8_STAGE(bufoff, gbase, voff) do { _Pragma("unroll") for (int _i = 0; _i < 2; ++_i) glds16_s((gbase), (voff)[_i], ldsb + (unsigned)((bufoff) + _i * 8192)); } while (0)
#define PG8_LDA(dst, b, h) do { _Pragma("unroll") for (int m = 0; m < 4; ++m) _Pragma("unroll") for (int k = 0; k < 2; ++k) dst[m][k] = *(const LAS h16x8*)(lds + PG8_SA(b, h) + aoff + m * 2048 + k * 1024); } while (0)
#define PG8_LDB(dst, b, h) do { _Pragma("unroll") for (int n = 0; n < 2; ++n) _Pragma("unroll") for (int k = 0; k < 2; ++k) dst[n][k] = *(const LAS h16x8*)(lds + PG8_SB(b, h) + boff + n * 2048 + k * 1024); } while (0)
#define PG8_MMA(ai, bj, At, Bt) do { __builtin_amdgcn_s_setprio(1); _Pragma("unroll") for (int m = 0; m < 4; ++m) _Pragma("unroll") for (int n = 0; n < 2; ++n) _Pragma("unroll") for (int k = 0; k < 2; ++k) \
        acc[ai][bj][m][n] = mma_step<I8>(Bt[n][k], At[m][k], acc[ai][bj][m][n]); __builtin_amdgcn_s_setprio(0); } while (0)
#define PG8_WAIT_V(n) asm volatile("s_waitcnt vmcnt(" #n ")" ::: "memory")
#define PG8_WAIT_L(n) asm volatile("s_waitcnt lgkmcnt(" #n ")" ::: "memory")
#define PG8_BAR __builtin_amdgcn_s_barrier()
#define PG8_SCHED __builtin_amdgcn_sched_barrier(0)
    Unit cur, nxt; int ui = 0;
    if (!P.next(0, cur)) return;
    Acc acc;
#pragma unroll
    for (int a = 0; a < 2; ++a)
#pragma unroll
        for (int b = 0; b < 2; ++b)
#pragma unroll
            for (int m = 0; m < 4; ++m)
#pragma unroll
                for (int n = 0; n < 2; ++n) acc[a][b][m][n] = (f32x4){0.f, 0.f, 0.f, 0.f};
    h16x8 At[4][2], B0[2][2], B1[2][2];
    const char* cA = P.a_tile(cur); const char* cB = P.b_tile(cur);
    if constexpr (SP2) {
        PG8_STAGE(PG8_SB(0, 0), cB, voffB); PG8_STAGE(PG8_SB(0, 1), cB + hstepB, voffB); PG8_STAGE(PG8_SA(0, 0), cA, voffA); PG8_STAGE(PG8_SA(0, 1), cA + hstepA, voffA);
        if (wr == 1) PG8_BAR;
        PG8_WAIT_V(2); PG8_BAR;
        PG8_STAGE(PG8_SB(1, 0), cB + kstep, voffB); PG8_STAGE(PG8_SA(1, 0), cA + kstep, voffA); PG8_STAGE(PG8_SB(1, 1), cB + hstepB + kstep, voffB);
        PG8_WAIT_V(6); PG8_BAR;
    } else {
        PG8_STAGE(PG8_SB(0, 0), cB, voffB); PG8_STAGE(PG8_SA(0, 0), cA, voffA); PG8_STAGE(PG8_SB(0, 1), cB + hstepB, voffB); PG8_STAGE(PG8_SA(0, 1), cA + hstepA, voffA);
        if (wr == 1) PG8_BAR;
        PG8_WAIT_V(4); PG8_BAR;
        PG8_STAGE(PG8_SB(1, 0), cB + kstep, voffB); PG8_STAGE(PG8_SA(1, 0), cA + kstep, voffA); PG8_STAGE(PG8_SB(1, 1), cB + hstepB + kstep, voffB);
        PG8_WAIT_V(6); PG8_BAR;
    }
    for (;;) {
        const bool has_next = P.next(ui + 1, nxt);
        const char* nA = has_next ? P.a_tile(nxt) : cA; const char* nB = has_next ? P.b_tile(nxt) : cB;
        for (int t = 0; t < nt; t += 2) {
            const bool last = (t == nt - 2);
            const char* a1 = cA + (size_t)(t + 1) * kstep;
            const char* a2 = last ? nA : cA + (size_t)(t + 2) * kstep; const char* b2 = last ? nB : cB + (size_t)(t + 2) * kstep;
            const char* a3 = a2 + kstep; const char* b3 = b2 + kstep;
            if constexpr (SP2) {
            PG8_LDB(B0, 0, 0); PG8_LDB(B1, 0, 1); PG8_SCHED; PG8_LDA(At, 0, 0); PG8_STAGE(PG8_SA(1, 1), a1 + hstepA, voffA);
            PG8_WAIT_V(8); PG8_WAIT_L(0); PG8_BAR; PG8_MMA(0, 0, At, B0); PG8_MMA(0, 1, At, B1); PG8_BAR; PG8_SCHED;
            PG8_LDA(At, 0, 1); PG8_STAGE(PG8_SB(0, 0), b2, voffB); PG8_STAGE(PG8_SB(0, 1), b2 + hstepB, voffB); PG8_STAGE(PG8_SA(0, 0), a2, voffA);
            PG8_WAIT_V(8); PG8_WAIT_L(0); PG8_BAR; PG8_MMA(1, 0, At, B0); PG8_MMA(1, 1, At, B1); PG8_BAR; PG8_SCHED;
            PG8_LDB(B0, 1, 0); PG8_LDB(B1, 1, 1); PG8_SCHED; PG8_LDA(At, 1, 0); PG8_STAGE(PG8_SA(0, 1), a2 + hstepA, voffA);
            PG8_WAIT_V(8); PG8_WAIT_L(0); PG8_BAR; PG8_MMA(0, 0, At, B0); PG8_MMA(0, 1, At, B1); PG8_BAR; PG8_SCHED;
            PG8_LDA(At, 1, 1); PG8_STAGE(PG8_SB(1, 0), b3, voffB); PG8_STAGE(PG8_SB(1, 1), b3 + hstepB, voffB); PG8_STAGE(PG8_SA(1, 0), a3, voffA);
            PG8_WAIT_V(8); PG8_WAIT_L(0); PG8_BAR; PG8_MMA(1, 0, At, B0); PG8_MMA(1, 1, At, B1); PG8_BAR; PG8_SCHED;
            } else {
            PG8_LDB(B0, 0, 0); PG8_SCHED; PG8_LDA(At, 0, 0); PG8_STAGE(PG8_SA(1, 1), a1 + hstepA, voffA);
            PG8_WAIT_L(8); PG8_BAR; PG8_WAIT_L(0); PG8_MMA(0, 0, At, B0); PG8_BAR; PG8_SCHED;
            PG8_LDB(B1, 0, 1); PG8_STAGE(PG8_SB(0, 0), b2, voffB);
            PG8_BAR; PG8_WAIT_L(0); PG8_MMA(0, 1, At, B1); PG8_BAR;
            PG8_LDA(At, 0, 1); PG8_STAGE(PG8_SA(0, 0), a2, voffA);
            PG8_BAR; PG8_WAIT_L(0); PG8_MMA(1, 0, At, B0); PG8_BAR; PG8_SCHED;
            PG8_STAGE(PG8_SB(0, 1), b2 + hstepB, voffB);
            PG8_WAIT_V(6); PG8_BAR; PG8_MMA(1, 1, At, B1); PG8_BAR;
            PG8_LDB(B0, 1, 0); PG8_SCHED; PG8_LDA(At, 1, 0); PG8_STAGE(PG8_SA(0, 1), a2 + hstepA, voffA);
            PG8_WAIT_L(8); PG8_BAR; PG8_WAIT_L(0); PG8_MMA(0, 0, At, B0); PG8_BAR; PG8_SCHED;
            PG8_LDB(B1, 1, 1); PG8_STAGE(PG8_SB(1, 0), b3, voffB);
            PG8_BAR; PG8_WAIT_L(0); PG8_MMA(0, 1, At, B1); PG8_BAR;
            PG8_LDA(At, 1, 1); PG8_STAGE(PG8_SA(1, 0), a3, voffA);
            PG8_BAR; PG8_WAIT_L(0); PG8_MMA(1, 0, At, B0); PG8_BAR; PG8_SCHED;
            PG8_STAGE(PG8_SB(1, 1), b3 + hstepB, voffB);
            PG8_WAIT_V(6); PG8_BAR; PG8_MMA(1, 1, At, B1); PG8_BAR;
            }
        }
        if constexpr (ALIGN_EPI) { if (wr == 0) PG8_BAR; }
        { const int l_tid = wave * 64 + mk_lane();
          const int l_lane = l_tid & 63; E(acc, cur, wr, wc, l_lane & 15, l_lane >> 4, lds, l_tid); }
        if (!has_next) break;
        if (!cur.keep) {
#pragma unroll
        for (int a = 0; a < 2; ++a)
#pragma unroll
            for (int b = 0; b < 2; ++b)
#pragma unroll
                for (int m = 0; m < 4; ++m)
#pragma unroll
                    for (int n = 0; n < 2; ++n) acc[a][b][m][n] = (f32x4){0.f, 0.f, 0.f, 0.f};
        }
        cur = nxt; cA = nA; cB = nB; ++ui;
        if constexpr (ALIGN_EPI) { if (wr == 1) PG8_BAR; }
    }
    PG8_WAIT_V(0);
    if constexpr (!ALIGN_EPI) { if (wr == 0) PG8_BAR; }
    PG8_BAR;
#undef PG8_SA
#undef PG8_SB
#undef PG8_STAGE
#undef PG8_LDA
#undef PG8_LDB
#undef PG8_MMA
#undef PG8_WAIT_V
#undef PG8_WAIT_L
#undef PG8_BAR
#undef PG8_SCHED
}
}
using pg8::Unit; using pg8::Acc;

struct ProbStd {
    const char* A; const char* B; int K, lda, ldb; bool upmap; pg8::StaticOrder S;
    __device__ bool next(int i, Unit& u) const { return S.next(i, u); }
    __device__ const char* a_tile(const Unit& u) const { return A + (size_t)u.pm * 256 * lda * 2; }
    __device__ const char* b_tile(const Unit& u) const { return B + (size_t)u.pn * 256 * ldb * 2; }
    __device__ unsigned a_rowoff(int R) const { const int r = upmap ? (128 * (R >> 6) + 8 * (R & 15) + ((R >> 4) & 3)) : R; return (unsigned)r * (unsigned)lda * 2u; }
    __device__ unsigned b_rowoff(int R) const { return (unsigned)R * (unsigned)ldb * 2u; }
    __device__ size_t a_hstep() const { return (size_t)(upmap ? 4 : 128) * lda * 2; }
    __device__ size_t b_hstep() const { return (size_t)128 * ldb * 2; }
};
struct ProbHalo {
    const char* A; const char* B; int K, lda, ldb; int G, c;
    __device__ bool next(int i, Unit& u) const { const int L = i * G + c; if (L >= 3 * 44) return false; u.pm = L % 3; u.pn = L / 3; u.g = 0; u.part = 0; u.keep = 0; return true; }
    __device__ const char* a_tile(const Unit& u) const { return A + ((long)64 * 256 * u.pm - 1) * (long)lda * 2; }
    __device__ const char* b_tile(const Unit& u) const { return B + (size_t)u.pn * 256 * ldb * 2; }
    __device__ unsigned a_rowoff(int R) const { return (unsigned)(64 * R + 65 * (R & 1)) * (unsigned)lda * 2u; }
    __device__ unsigned b_rowoff(int R) const { return (unsigned)R * (unsigned)ldb * 2u; }
    __device__ size_t a_hstep() const { return (size_t)64 * 128 * lda * 2; }
    __device__ size_t b_hstep() const { return (size_t)128 * ldb * 2; }
};
struct ProbDftC {
    const char* Dm; const char* zb; int G, c;
    static constexpr int K = 512;
    __device__ bool next(int i, Unit& u) const { const int L0 = i * G + c; if (L0 >= 1536) return false; const int L = (L0 % 8) * 192 + L0 / 8;
        u.pm = L & 1; u.g = (L >> 1) & 3; u.pn = L >> 3; u.part = 0; u.keep = 0; return true; }
    __device__ const char* a_tile(const Unit& u) const { return Dm + (size_t)u.pm * 512 * 512 * 2; }
    __device__ const char* b_tile(const Unit& u) const { return zb + ((size_t)u.pn * 256 * D + 512 * u.g) * 2; }
    __device__ unsigned a_rowoff(int R) const { return (unsigned)R * 512u * 2u; }
    __device__ unsigned b_rowoff(int R) const { return (unsigned)R * (unsigned)D * 2u; }
    __device__ size_t a_hstep() const { return (size_t)128 * 512 * 2; }
    __device__ size_t b_hstep() const { return (size_t)128 * D * 2; }
};
struct ProbDftS {
    const char* Fmat; const char* Bt; int G, c;
    static constexpr int K = 2048;
    __device__ bool next(int i, Unit& u) const { const int L0 = (i >> 1) * G + c; if (L0 >= 384) return false;
        const int L = (L0 % 8) * 48 + L0 / 8; u.pn = L & 3; u.pm = (L >> 2) & 3; u.g = L >> 4; u.part = i & 1; u.keep = (i & 1) ^ 1; return true; }
    __device__ const char* a_tile(const Unit& u) const { return Fmat + ((size_t)u.pm * 256 * 4096 + (size_t)u.part * 2048) * 2; }
    __device__ const char* b_tile(const Unit& u) const { return Bt + (((size_t)u.g * 1024 + (size_t)u.pn * 256) * BTP + (size_t)u.part * 2048) * 2; }
    __device__ unsigned a_rowoff(int R) const { return (unsigned)R * 4096u * 2u; }
    __device__ unsigned b_rowoff(int R) const { return (unsigned)R * (unsigned)BTP * 2u; }
    __device__ size_t a_hstep() const { return (size_t)128 * 4096 * 2; }
    __device__ size_t b_hstep() const { return (size_t)128 * BTP * 2; }
};

__device__ __forceinline__ void store_h8(h16* p, const f32x4& v0, const f32x4& v1) {
    u32x4 w; w.x = pk_h2(v0[0], v0[1]); w.y = pk_h2(v0[2], v0[3]); w.z = pk_h2(v1[0], v1[1]); w.w = pk_h2(v1[2], v1[3]);
    *(u32x4*)p = w;
}

__device__ __forceinline__ f32x4 ldf4(const float* base, unsigned idx) { return *(const f32x4*)((const char*)base + (idx << 2)); }
struct EpiIn {
    h16* Hc; h16* Hq; const float* ropec; const float* ropes;
    __device__ __forceinline__ void operator()(Acc& acc, const Unit& u, int wr, int wc, int fr, int fq, LAS unsigned char* lds, int tid) const {
        const unsigned row0 = u.pm * 256, pn = u.pn, colt = pn * 256 + wc * 32 + 8 * fq;
        const bool rope = (pn >= 12 && pn < 20);
        const float sc = (pn >= 12 && pn < 16) ? QSCALE : 1.0f;
#pragma unroll
        for (int ai = 0; ai < 2; ++ai)
#pragma unroll
            for (int m = 0; m < 4; ++m) {
                const unsigned row = row0 + ai * 128 + wr * 64 + m * 16 + fr;
                if (rope) {
                    const unsigned t = row & (SEQ - 1), d0 = 32 * (wc & 1) + 8 * fq;
                    const float* cp = ropec + t * 64 + d0; const float* sp = ropes + t * 64 + d0;
                    f32x4 v[2][2];
#pragma unroll
                    for (int n = 0; n < 2; ++n) { const f32x4 c = *(const f32x4*)(cp + 4 * n), s = *(const f32x4*)(sp + 4 * n);
                        const f32x4 x1 = acc[ai][0][m][n], x2 = acc[ai][1][m][n];
                        v[0][n] = (x1 * c - x2 * s) * sc; v[1][n] = (x2 * c + x1 * s) * sc; }
                    h16* o = Hq + (size_t)row * 3072 + (256 * (pn - 12) + 128 * (wc >> 1) + d0);
                    store_h8(o, v[0][0], v[0][1]); store_h8(o + 64, v[1][0], v[1][1]);
                } else {
                    if (pn >= 4 && pn < 12) {
                        store_h8(Hc + (size_t)row * 3072 + 1024 + (pn - 4) * 128 + wc * 32 + 8 * fq, acc[ai][0][m][0] * acc[ai][1][m][0], acc[ai][0][m][1] * acc[ai][1][m][1]);
                    } else {
                    h16* o = (pn < 12) ? (Hc + (size_t)row * 3072 + colt) : (Hq + (size_t)row * 3072 + (colt - 3072));
                    store_h8(o, acc[ai][0][m][0], acc[ai][0][m][1]); store_h8(o + 128, acc[ai][1][m][0], acc[ai][1][m][1]); }
                }
                asm volatile("" ::: "memory");
            }
    }
};

struct EpiInQ {
    h16* Hq; const float* ropec; const float* ropes; const float* sx; const float* sw;
    __device__ __forceinline__ void operator()(Acc& acc, const Unit& u, int wr, int wc, int fr, int fq, LAS unsigned char* lds, int tid) const {
        const unsigned row0 = u.pm * 256, pn = u.pn, colt = pn * 256 + wc * 32 + 8 * fq;
        const bool rope = pn < 8;
        const float sc = pn < 4 ? QSCALE : 1.0f;
        f32x4 swv[2][2];
#pragma unroll
        for (int bj = 0; bj < 2; ++bj)
#pragma unroll
            for (int n = 0; n < 2; ++n) swv[bj][n] = ldf4(sw, colt + 128u * bj + 4u * n) * sc;
#pragma unroll
        for (int ai = 0; ai < 2; ++ai)
#pragma unroll
            for (int m = 0; m < 4; ++m) {
                const unsigned row = row0 + ai * 128 + wr * 64 + m * 16 + fr;
                const float rs = *(const float*)((const char*)sx + (row << 2));
                f32x4 x[2][2];
#pragma unroll
                for (int bj = 0; bj < 2; ++bj)
#pragma unroll
                    for (int n = 0; n < 2; ++n) { const pg8::i32x4 iv = __builtin_bit_cast(pg8::i32x4, acc[ai][bj][m][n]); x[bj][n] = __builtin_convertvector(iv, f32x4) * (swv[bj][n] * rs); }
                if (rope) {
                    const unsigned t = row & (SEQ - 1), d0 = 32 * (wc & 1) + 8 * fq;
                    f32x4 v[2][2];
#pragma unroll
                    for (int n = 0; n < 2; ++n) { const f32x4 c = ldf4(ropec, t * 64 + d0 + 4u * n), s = ldf4(ropes, t * 64 + d0 + 4u * n);
                        v[0][n] = x[0][n] * c - x[1][n] * s; v[1][n] = x[1][n] * c + x[0][n] * s; }
                    h16* o = Hq + (size_t)row * 3072 + (256 * pn + 128 * (wc >> 1) + d0);
                    store_h8(o, v[0][0], v[0][1]); store_h8(o + 64, v[1][0], v[1][1]);
                } else {
                    h16* o = Hq + (size_t)row * 3072 + colt;
                    store_h8(o, x[0][0], x[0][1]); store_h8(o + 128, x[1][0], x[1][1]);
                }
                asm volatile("" ::: "memory");
            }
    }
};

template <bool LNX, bool I8 = false> struct EpiResT {
    h16* X; const float* stats; const float* g; const float* bta;
    const float* sa; const float* swd;
    __device__ __forceinline__ void operator()(Acc& acc, const Unit& u, int wr, int wc, int fr, int fq, LAS unsigned char* lds, int tid) const {
#pragma unroll
        for (int bj = 0; bj < 2; ++bj) {
            const unsigned colt = u.pn * 256 + 128u * bj + wc * 32 + 8 * fq;
            f32x4 ga[2], ba[2], cs[2];
            if constexpr (LNX) {
#pragma unroll
                for (int n = 0; n < 2; ++n) { ga[n] = ldf4(g, colt + 4u * n) * ALPHA; ba[n] = ldf4(bta, colt + 4u * n) * ALPHA; }
            }
            if constexpr (I8) {
#pragma unroll
                for (int n = 0; n < 2; ++n) cs[n] = ldf4(swd, colt + 4u * n);
            }
#pragma unroll
            for (int ai = 0; ai < 2; ++ai) {
                h16x8 xv[4];
                f32x2 st[4]; float rs[4];
#pragma unroll
                for (int m = 0; m < 4; ++m) { const unsigned row = u.pm * 256 + ai * 128 + wr * 64 + m * 16 + fr; xv[m] = *(const h16x8*)(X + (size_t)row * D + colt);
                    if constexpr (LNX) st[m] = *(const f32x2*)((const char*)stats + (row << 3));
                    if constexpr (I8) rs[m] = *(const float*)((const char*)sa + (row << 2)); }
                asm volatile("" ::: "memory");
#pragma unroll
                for (int m = 0; m < 4; ++m) {
                    const unsigned row = u.pm * 256 + ai * 128 + wr * 64 + m * 16 + fr;
                    f32x4 z[2];
#pragma unroll
                    for (int n = 0; n < 2; ++n) {
                        f32x4 a = acc[ai][bj][m][n];
                        if constexpr (I8) { const pg8::i32x4 iv = __builtin_bit_cast(pg8::i32x4, a); a = __builtin_convertvector(iv, f32x4) * (cs[n] * rs[m]); }
#pragma unroll
                        for (int e = 0; e < 4; ++e) {
                            if constexpr (LNX) { const float t = ((float)xv[m][4 * n + e] - st[m].x) * st[m].y; z[n][e] = t * ga[n][e] + (ba[n][e] + a[e]); }
                            else z[n][e] = (float)xv[m][4 * n + e] * ALPHA + a[e]; }
                    }
                    store_h8(X + (size_t)row * D + colt, z[0], z[1]);
                }
                asm volatile("" ::: "memory");
            }
        }
    }
};
typedef EpiResT<false> EpiRes;

template <bool I8> struct EpiHalo {
    float* HALO; const float* sx; const float* sw;
    __device__ __forceinline__ void operator()(Acc& acc, const Unit& u, int wr, int wc, int fr, int fq, LAS unsigned char* lds, int tid) const {
        const unsigned h0 = u.pm * 256, colt = u.pn * 256 + wc * 32 + 8 * fq;
        if constexpr (I8) {
#pragma unroll
            for (int ai = 0; ai < 2; ++ai)
#pragma unroll
                for (int m = 0; m < 4; ++m) { const int hidx = (int)(h0 + ai * 128 + wr * 64 + m * 16 + fr); int tok = 64 * hidx + 65 * (hidx & 1) - 1; tok = tok < 0 ? 0 : (tok >= M ? M - 1 : tok);
                    const float rs = sx[tok];
#pragma unroll
                    for (int bj = 0; bj < 2; ++bj)
#pragma unroll
                        for (int n = 0; n < 2; ++n) { const pg8::i32x4 iv = __builtin_bit_cast(pg8::i32x4, acc[ai][bj][m][n]); acc[ai][bj][m][n] = __builtin_convertvector(iv, f32x4) * rs; } } }
#pragma unroll
        for (int ai = 0; ai < 2; ++ai)
#pragma unroll
            for (int m = 0; m < 4; ++m) {
                const unsigned rl = ai * 128 + wr * 64 + m * 16 + fr;
                float* o = HALO + (size_t)(h0 + rl) * FF2 + colt;
#pragma unroll
                for (int bj = 0; bj < 2; ++bj)
#pragma unroll
                    for (int n = 0; n < 2; ++n) *(f32x4*)(o + bj * 128 + 4 * n) = acc[ai][bj][m][n];
            }
    }
};

__device__ __forceinline__ float dpp_shr1(float oldv, float src) {
    return __builtin_bit_cast(float, __builtin_amdgcn_update_dpp(__builtin_bit_cast(int, oldv), __builtin_bit_cast(int, src), 0x111, 0xf, 0xf, false));
}
__device__ __forceinline__ float dpp_shl1(float oldv, float src) {
    return __builtin_bit_cast(float, __builtin_amdgcn_update_dpp(__builtin_bit_cast(int, oldv), __builtin_bit_cast(int, src), 0x101, 0xf, 0xf, false));
}
__device__ __forceinline__ float silu_f(float x) { return x * __builtin_amdgcn_rcpf(1.0f + __expf(-x)); }

template <bool I8> struct EpiUp {
    h16* ACT; const float* HALO; const float* cw;
    const float* sx; const float* sw;
    __device__ __forceinline__ void operator()(Acc& acc, const Unit& u, int wr, int wc, int fr, int fq, LAS unsigned char* lds, int tid) const {
        const unsigned tok0 = u.pm * 256;
        const unsigned tl0 = 128 * wr + 8 * fr;
        if constexpr (I8) {
#pragma unroll
            for (int ai = 0; ai < 2; ++ai) { const f32x4 sa = ldf4(sx, tok0 + tl0 + 4u * ai);
#pragma unroll
                for (int m = 0; m < 4; ++m)
#pragma unroll
                    for (int bj = 0; bj < 2; ++bj)
#pragma unroll
                        for (int n = 0; n < 2; ++n) { const pg8::i32x4 iv = __builtin_bit_cast(pg8::i32x4, acc[ai][bj][m][n]); acc[ai][bj][m][n] = __builtin_convertvector(iv, f32x4) * sa[m]; }
                asm volatile("" ::: "memory"); }
        }
        const unsigned bk = 2 * u.pm + wr;
        const bool lvalid = (bk & 15) != 0, rvalid = (bk & 15) != 15;
#pragma unroll
        for (int bj = 0; bj < 2; ++bj) {
            const unsigned colp = u.pn * 256 + bj * 128 + wc * 32 + 8 * fq;
            const unsigned coll = bj * FF + u.pn * 128 + wc * 32 + 8 * fq;
#pragma unroll
            for (int n = 0; n < 2; ++n) {
                f32x4 c0 = ldf4(cw, coll + 4u * n), c1 = ldf4(cw, (unsigned)FF2 + coll + 4u * n), c2 = ldf4(cw, 2u * FF2 + coll + 4u * n);
                if constexpr (I8) { const f32x4 swv = ldf4(sw, colp + 4u * n); c0 = c0 * swv; c1 = c1 * swv; c2 = c2 * swv; }
                f32x4 hl = {0.f, 0.f, 0.f, 0.f}, hr = {0.f, 0.f, 0.f, 0.f};
                if (fr == 0 && lvalid) hl = ldf4(HALO, (2u * bk) * (unsigned)FF2 + colp + 4u * n);
                if (fr == 15 && rvalid) hr = ldf4(HALO, (2u * bk + 1u) * (unsigned)FF2 + colp + 4u * n);
#pragma unroll
                for (int e = 0; e < 4; ++e) {
                    const float prev = dpp_shr1(hl[e], acc[1][bj][3][n][e]);
                    const float next = dpp_shl1(hr[e], acc[0][bj][0][n][e]);
                    float left = prev;
#pragma unroll
                    for (int j = 0; j < 8; ++j) {
                        const float cur = acc[j >> 2][bj][j & 3][n][e];
                        const float nx = (j < 7) ? acc[(j + 1) >> 2][bj][(j + 1) & 3][n][e] : next;
                        acc[j >> 2][bj][j & 3][n][e] = c0[e] * left + c1[e] * cur + c2[e] * nx;
                        left = cur;
                    }
                }
                asm volatile("" ::: "memory");
            }
        }
        const unsigned colo = u.pn * 128 + wc * 32 + 8 * fq;
#pragma unroll
        for (int ai = 0; ai < 2; ++ai)
#pragma unroll
            for (int m = 0; m < 4; ++m) {
                f32x4 a[2];
#pragma unroll
                for (int n = 0; n < 2; ++n)
#pragma unroll
                    for (int e = 0; e < 4; ++e) a[n][e] = silu_f(acc[ai][0][m][n][e]) * acc[ai][1][m][n][e];
                store_h8((h16*)((char*)ACT + (((tok0 + tl0 + 4u * ai + m) * (unsigned)FF + colo) << 1)), a[0], a[1]);
                asm volatile("" ::: "memory");
            }
    }
};

struct EpiDftC {
    h16* BtAB;
    __device__ __forceinline__ void operator()(Acc& acc, const Unit& u, int wr, int wc, int fr, int fq, LAS unsigned char* lds, int tid) const {
        const unsigned b = u.pn >> 3, s0 = (u.pn & 7) * 256;
#pragma unroll
        for (int ai = 0; ai < 2; ++ai)
#pragma unroll
            for (int m = 0; m < 4; ++m) {
                const unsigned rl = ai * 128 + wr * 64 + m * 16 + fr;
                h16* o = BtAB + ((size_t)(b * 1024 + u.g * 256 + rl)) * BTP + (u.pm * 2048 + s0 + wc * 32 + 8 * fq);
                store_h8(o, acc[ai][0][m][0], acc[ai][0][m][1]); store_h8(o + 128, acc[ai][1][m][0], acc[ai][1][m][1]);
            }
    }
};

__device__ __forceinline__ void store_h8_skip0(h16* p, const f32x4& v0, const f32x4& v1) {
    const unsigned w0 = pk_h2(v0[0], v0[1]), w1 = pk_h2(v0[2], v0[3]); u32x2 w23; w23.x = pk_h2(v1[0], v1[1]); w23.y = pk_h2(v1[2], v1[3]);
    *(unsigned short*)(p + 1) = (unsigned short)(w0 >> 16); *(unsigned*)(p + 2) = w1; *(u32x2*)(p + 4) = w23;
}
struct EpiDftS2 {
    h16* F; float* scratch;
    __device__ __forceinline__ void operator()(Acc& acc, const Unit& u, int wr, int wc, int fr, int fq, LAS unsigned char* lds, int tid) const {
        f32x4* ps = (f32x4*)scratch + tid;
        if (u.part == 0) {
#pragma unroll
            for (int ai = 0; ai < 2; ++ai)
#pragma unroll
                for (int m = 0; m < 4; ++m)
#pragma unroll
                    for (int bj = 0; bj < 2; ++bj)
#pragma unroll
                        for (int n = 0; n < 2; ++n) ps[(((ai * 4 + m) * 2 + bj) * 2 + n) * 512] = acc[ai][bj][m][n];
            return;
        }
        const float sc = 0.0009765625f;
        const unsigned jl = wc * 32 + 8 * fq;
#pragma unroll
        for (int ai = 0; ai < 2; ++ai)
#pragma unroll
            for (int m = 0; m < 4; ++m) {
                const unsigned kk = u.pm * 256 + ai * 128 + wr * 64 + m * 16 + fr;
                h16* o = F + (size_t)(u.g * 2048 + kk) * D + u.pn * 512 + jl;
                h16* om = F + (size_t)(u.g * 2048 + 2048 - kk) * D + u.pn * 512 + jl;
#pragma unroll
                for (int bj = 0; bj < 2; ++bj) {
                    const f32x4 p0 = ps[(((ai * 4 + m) * 2 + bj) * 2 + 0) * 512], p1 = ps[(((ai * 4 + m) * 2 + bj) * 2 + 1) * 512];
                    const f32x4 y0 = acc[ai][bj][m][0] * sc, y1 = acc[ai][bj][m][1] * sc;
                    const f32x4 z0 = (p0 * 2.0f - acc[ai][bj][m][0]) * sc, z1 = (p1 * 2.0f - acc[ai][bj][m][1]) * sc;
                    const bool j0 = (bj == 0) && (jl == 0);
                    store_h8(o + bj * 128, y0, y1);
                    if (j0) store_h8_skip0(o + 256, z0, z1); else store_h8(o + 256 + bj * 128, z0, z1);
                    if (kk != 0) {
                        store_h8(om + bj * 128, z0, z1);
                        if (j0) store_h8_skip0(om + 256, y0, y1); else store_h8(om + 256 + bj * 128, y0, y1);
                    }
                }
                asm volatile("" ::: "memory");
            }
    }
};

struct Args { const float* in[13]; float* out; unsigned char* ws; int ph_lo, ph_hi; };
struct Frame {
    LAS unsigned char* lds; volatile LAS unsigned* MISC; unsigned* ctl;
    int wave, vcu, G;
    unsigned char* ws;
};

__device__ __forceinline__ void dftc_side(Frame& F, const h16* xb, h16* A256) {
    const int lane_ = mk_lane();
    const int gw = F.vcu * 8 + F.wave, NGW = F.G * 8, lane = lane_;
    for (int t = gw; t < M; t += NGW) {
        const h16x8* xr = (const h16x8*)(xb + (size_t)t * D) + lane; float s[4];
#pragma unroll
        for (int j = 0; j < 4; ++j) { const h16x8 v = xr[64 * j]; float a = 0.f;
#pragma unroll
            for (int e = 0; e < 8; e += 2) a += (float)v[e] - (float)v[e + 1];
            s[j] = wave_sum(a); }
        if (lane < 4) { const float v = lane == 0 ? s[0] : (lane == 1 ? s[1] : (lane == 2 ? s[2] : s[3])); A256[((size_t)(t >> 11) * 4 + lane) * 2048 + (t & 2047)] = (h16)v; }
    }
}
__device__ __forceinline__ void dfts_side(Frame& F, const h16* BtAB, const h16* A256, const h16* Fmat, h16* Fo) {
    const int lane_ = mk_lane();
    const int nheavy = (F.G < 384 && 2 * F.G > 384) ? 384 - F.G : 0, bxi = (int)blockIdx.x;
    if (bxi < nheavy) return;
    const int gw = (bxi - nheavy) * 8 + F.wave, NGW = (F.G - nheavy) * 8, lane = lane_;
    for (int J = gw; J < 96 * 32; J += NGW) {
        const int pair = J >> 5, ch = J & 31, b = pair >> 2, grp = pair & 3;
        const h16x8* ap = (const h16x8*)(A256 + (size_t)pair * 2048) + lane; float av[4][8];
#pragma unroll
        for (int j = 0; j < 4; ++j) { const h16x8 v = ap[64 * j];
#pragma unroll
            for (int e = 0; e < 8; ++e) av[j][e] = (float)v[e]; }
        for (int k0 = ch * 33; k0 < ch * 33 + 33; k0 += 3) {
            float a3[3] = {0.f, 0.f, 0.f};
#pragma unroll
            for (int q = 0; q < 3; ++q) { const int kk = (k0 + q) <= 1024 ? (k0 + q) : 1024; const h16x8* fp = (const h16x8*)(Fmat + (size_t)kk * 4096) + lane;
#pragma unroll
                for (int j = 0; j < 4; ++j) { const h16x8 v = fp[64 * j];
#pragma unroll
                    for (int e = 0; e < 8; ++e) a3[q] += (float)v[e] * av[j][e]; } }
#pragma unroll
            for (int q = 0; q < 3; ++q) { const int kk = k0 + q; const float a = wave_sum(a3[q]) * 0.0009765625f;
                if (lane == 0 && kk <= 1024) { Fo[((size_t)b * 2048 + kk) * D + grp * 512 + 256] = (h16)a; if (kk >= 1 && kk <= 1023) Fo[((size_t)b * 2048 + 2048 - kk) * D + grp * 512 + 256] = (h16)a; } }
        }
    }
    for (int r = gw; r < NSEQ * 1024; r += NGW) {
        const h16x8* p = (const h16x8*)(BtAB + (size_t)r * BTP) + lane; float s = 0.f;
#pragma unroll
        for (int j = 0; j < 4; ++j) { const h16x8 v = p[64 * j];
#pragma unroll
            for (int e = 0; e < 8; e += 2) s += (float)v[e] - (float)v[e + 1]; }
        s = wave_sum(s) * 0.0009765625f;
        if (lane == 0) { const int b = r >> 10, n = r & 1023, grp = n >> 8, j = n & 255; h16* o = Fo + ((size_t)b * 2048 + 1024) * D + grp * 512;
            o[j] = (h16)s; if (j >= 1) o[256 + j] = (h16)s; }
    }
}

__device__ __forceinline__ int fpos_chan(int kpos) { const int p = kpos & 511; return (kpos & ~511) + (p <= 256 ? p : 768 - p); }
template <bool KMAP = false>
__device__ __forceinline__ void p0_transpose_item(const float* W, int K, int N, h16* WT, int kb, int np0, int scol0, LAS float* scr, int lane) {
    const int k0 = 64 * kb;
#pragma unroll 8
    for (int i = 0; i < 32; ++i) { const int kk = 2 * i + (lane >> 5); const int ksrc = KMAP ? fpos_chan(k0 + kk) : (k0 + kk); scr[kk * 33 + (lane & 31)] = W[(size_t)ksrc * N + scol0 + (lane & 31)]; }
    asm volatile("s_waitcnt lgkmcnt(0)" ::: "memory");
    const int c = lane & 7;
#pragma unroll
    for (int j = 0; j < 4; ++j) { const int n = (lane >> 3) + 8 * j; const LAS float* s = scr + (8 * c) * 33 + n;
        u32x4 o; o.x = pk_h2(s[0 * 33], s[1 * 33]); o.y = pk_h2(s[2 * 33], s[3 * 33]); o.z = pk_h2(s[4 * 33], s[5 * 33]); o.w = pk_h2(s[6 * 33], s[7 * 33]);
        *(u32x4*)(WT + (size_t)(np0 + n) * K + k0 + 8 * c) = o; }
    asm volatile("s_waitcnt lgkmcnt(0)" ::: "memory");
}
__device__ __forceinline__ float colmax_of(const float* pmax, int idx) { float m = 0.f;
#pragma unroll
    for (int rb = 0; rb < 8; ++rb) m = fmaxf(m, pmax[(size_t)rb * PM_STRIDE + idx]); return m; }
__device__ __forceinline__ void p0_transpose_item_i8(const float* W, int K, int N, signed char* WT, int kb, int np0, int scol0, const float* pmax, int cidx0, LAS float* scr, int lane) {
    const int k0 = 64 * kb;
#pragma unroll 8
    for (int i = 0; i < 32; ++i) { const int kk = 2 * i + (lane >> 5); scr[kk * 33 + (lane & 31)] = W[(size_t)(k0 + kk) * N + scol0 + (lane & 31)]; }
    asm volatile("s_waitcnt lgkmcnt(0)" ::: "memory");
    const int c = lane & 7;
#pragma unroll
    for (int j = 0; j < 4; ++j) { const int n = (lane >> 3) + 8 * j; const LAS float* s = scr + (8 * c) * 33 + n;
        const float mx = colmax_of(pmax, cidx0 + n); const float inv = mx > 0.f ? 127.0f / mx : 0.f;
        *(u32x2*)(WT + (size_t)(np0 + n) * K + k0 + 8 * c) = pack8_i8(s[0 * 33], s[1 * 33], s[2 * 33], s[3 * 33], s[4 * 33], s[5 * 33], s[6 * 33], s[7 * 33], inv); }
    asm volatile("s_waitcnt lgkmcnt(0)" ::: "memory");
}
__device__ __forceinline__ void p0_colmax(Frame& F, const float* w_up, const float* w_in) {
    const int lane = mk_lane();
    LAS float* red = (LAS float*)F.lds;
    float* pmax = (float*)(F.ws + WS_PART);
    constexpr int NCM_UP = 4 * 44 * 8, NCM_IN = 2 * 12 * 8;
    for (int it = F.vcu; it < NCM_UP + NCM_IN; it += F.G) {
        const float* p; int pidx, rb; size_t pitch;
        if (it < NCM_UP) { const int l = it / 352, r = it % 352, cg = r % 44; rb = r / 44; pitch = FF2; pidx = l * FF2 + cg * 256;
            p = w_up + (size_t)l * D * FF2 + (size_t)(rb * 256 + F.wave * 32) * FF2 + cg * 256 + 4 * lane; }
        else { const int j = it - NCM_UP, i = j / 96, r = j % 96, cg = r % 12; rb = r / 12; pitch = DIN; pidx = 4 * FF2 + i * 3072 + cg * 256;
            p = w_in + (size_t)i * D * DIN + (size_t)(rb * 256 + F.wave * 32) * DIN + 3072 + cg * 256 + 4 * lane; }
        f32x4 m = {0.f, 0.f, 0.f, 0.f};
#pragma unroll
        for (int k = 0; k < 32; ++k) { const f32x4 v = *(const f32x4*)(p + (size_t)k * pitch);
#pragma unroll
            for (int e = 0; e < 4; ++e) m[e] = fmaxf(m[e], fabsf(v[e])); }
        *(LAS f32x4*)(red + F.wave * 256 + 4 * lane) = m;
        LDS_FENCE_BAR();
        if (F.wave < 4) { const int c = F.wave * 64 + lane; float mm = 0.f;
#pragma unroll
            for (int w = 0; w < 8; ++w) mm = fmaxf(mm, red[w * 256 + c]);
            pmax[(size_t)rb * PM_STRIDE + pidx + c] = mm; }
        LDS_FENCE_BAR();
    }
}
__device__ __forceinline__ int in_srccol(int np) {
    if (np >= 1024 && np < 3072) { const int pn = np >> 8, p = np & 255; return ((p >> 7) ? 2048 : 1024) + (pn - 4) * 128 + (p & 127); }
    if (np < 1024 || np >= 5120) return np;
    const int pn = np >> 8, p = np & 255, bj = p >> 7, w = p & 127;
    return pn * 256 + 128 * (w >> 6) + 64 * bj + (w & 63);
}
__device__ __forceinline__ int up_srccol(int np) { const int pn = np >> 8, p = np & 255, bj = p >> 7, w = p & 127; return bj * FF + pn * 128 + w; }

template <int PART> __device__ __forceinline__ void p0_prologue(Frame& F, const Args& a) {
    const float* x_prompt = a.in[0]; const float* x_sample = a.in[1]; const float* w_in = a.in[2]; const float* w_om = a.in[4]; const float* w_of = a.in[5];
    const float* w_up = a.in[8]; const float* w_dn = a.in[10];
    unsigned char* ws = F.ws;
    LAS float* scr = (LAS float*)(F.lds + F.wave * 16384);
    const int gw = F.vcu * 8 + F.wave, NGW = F.G * 8, lane0 = mk_lane();
    const long gt = (long)gw * 64 + lane0, NGT = (long)NGW * 64;
    constexpr int I_IN = 32 * (DIN / 32), I_SQ = 32 * (D / 32), I_UP = 32 * (FF2 / 32), I_DN = (FF / 64) * (D / 32);
    constexpr int NITEMS = 2 * I_IN + 2 * I_SQ + 2 * I_SQ + 4 * I_UP + 4 * I_DN;
    for (int it = gw; it < NITEMS; it += NGW) {
        int r = it;
        if (r < 2 * I_IN) { const int i = r / I_IN; r -= i * I_IN; const int nb = r % (DIN / 32), kb = r / (DIN / 32), np0 = nb * 32;
            if ((np0 >= 3072) != (PART != 0)) continue;
            if (PART) p0_transpose_item_i8(w_in + (size_t)i * D * DIN, D, DIN, (signed char*)(ws + WS_WIN8) + ((long)i * 3072 - 3072) * D, kb, np0, in_srccol(np0), (const float*)(ws + WS_PART), 4 * FF2 + i * 3072 + in_srccol(np0) - 3072, scr, lane0);
            else p0_transpose_item(w_in + (size_t)i * D * DIN, D, DIN, (h16*)(ws + WS_WIN) + (size_t)i * DIN * D, kb, np0, in_srccol(np0), scr, lane0);
            continue; }
        r -= 2 * I_IN;
        if (PART && r < 4 * I_SQ) continue;
        if (r < 2 * I_SQ) { const int i = r / I_SQ; r -= i * I_SQ; const int nb = r % (D / 32), kb = r / (D / 32);
            p0_transpose_item(w_om + (size_t)i * D * D, D, D, (h16*)(ws + WS_WOM) + (size_t)i * D * D, kb, nb * 32, nb * 32, scr, lane0); continue; }
        r -= 2 * I_SQ;
        if (r < 2 * I_SQ) { const int i = r / I_SQ; r -= i * I_SQ; const int nb = r % (D / 32), kb = r / (D / 32);
            p0_transpose_item<true>(w_of + (size_t)i * D * D, D, D, (h16*)(ws + WS_WOF) + (size_t)i * D * D, kb, nb * 32, nb * 32, scr, lane0); continue; }
        r -= 2 * I_SQ;
        if (r < 4 * I_UP) { const int l = r / I_UP; r -= l * I_UP; const int nb = r % (FF2 / 32), kb = r / (FF2 / 32), np0 = nb * 32;
            if (((kI8Mask >> l) & 1u) != (unsigned)PART) continue;
            if (PART) p0_transpose_item_i8(w_up + (size_t)l * D * FF2, D, FF2, (signed char*)(ws + WS_W8) + (size_t)l * FF2 * D, kb, np0, up_srccol(np0), (const float*)(ws + WS_PART), l * FF2 + up_srccol(np0), scr, lane0);
            else p0_transpose_item(w_up + (size_t)l * D * FF2, D, FF2, (h16*)(ws + WS_WUP) + (size_t)l * FF2 * D, kb, np0, up_srccol(np0), scr, lane0);
            continue; }
        r -= 4 * I_UP;
        if (PART) break;
        { const int l = r / I_DN; r -= l * I_DN; const int nb = r % (D / 32), kb = r / (D / 32);
            p0_transpose_item(w_dn + (size_t)l * FF * D, FF, D, (h16*)(ws + WS_WDN) + (size_t)l * D * FF, kb, nb * 32, nb * 32, scr, lane0); }
    }
    if constexpr (PART == 1) {
      float* vec = (float*)(ws + WS_VEC); const float* pmax = (const float*)(ws + WS_PART);
      for (long i = gt; i < 4 * FF2; i += NGT) { const int l = (int)i / FF2, np = (int)i % FF2; vec[V_SW + i] = colmax_of(pmax, l * FF2 + up_srccol(np)) * (1.0f / 127.0f); }
      for (long i = gt; i < 2 * 3072; i += NGT) { const int li = (int)i / 3072, np = 3072 + (int)i % 3072; vec[V_SWQ + i] = colmax_of(pmax, 4 * FF2 + li * 3072 + in_srccol(np) - 3072) * (1.0f / 127.0f); }
      if constexpr (kD8Mask != 0u) {
        const h16* wt = (const h16*)(ws + WS_WDN); signed char* w8 = (signed char*)(ws + WS_WDN8);
        for (int r = gw; r < 4 * D; r += NGW) { if (!((kD8Mask >> (r / D)) & 1u)) continue;
            h16x8 in[11];
#pragma unroll
            for (int j = 0; j < 11; ++j) in[j] = *(const h16x8*)(wt + (size_t)r * FF + 512 * j + 8 * lane0);
            const float sc = rowq_rot(in, w8 + (size_t)r * FF, lane0);
            if (lane0 == 0) vec[V_SWD + r] = sc * (1.0f / 128.0f); } }
      return; }
    { h16* Fm = (h16*)(ws + WS_FMAT);
      for (long ch = gt; ch < (long)2048 * 512; ch += NGT) { const int k = (int)(ch >> 9), c8 = (int)(ch & 511) * 8, p = c8 >> 11, s0 = c8 & 2047; unsigned w[4];
#pragma unroll
          for (int e = 0; e < 4; ++e) { float v[2];
#pragma unroll
              for (int q = 0; q < 2; ++q) { const int s = s0 + 2 * e + q; const int ph = (k * s) & 2047; float sn, cs; sincospif((float)ph * (1.0f / 1024.0f), &sn, &cs); v[q] = p ? -sn : cs; }
              w[e] = pk_h2(v[0], v[1]); }
          u32x4 o; o.x = w[0]; o.y = w[1]; o.z = w[2]; o.w = w[3]; *(u32x4*)(Fm + (size_t)k * 4096 + c8) = o; } }
    { h16* Dm = (h16*)(ws + WS_DM);
      for (long ch = gt; ch < 1024 * 64; ch += NGT) { const int n = (int)(ch >> 6), c0 = (int)(ch & 63) * 8, jj = n & 511; const bool issin = n >= 512; unsigned w[4];
#pragma unroll
          for (int e = 0; e < 4; ++e) { float v[2];
#pragma unroll
              for (int q = 0; q < 2; ++q) { const int c = c0 + 2 * e + q; const int ph = (jj * c) & 511; float sn, cs; sincospif((float)ph * (1.0f / 256.0f), &sn, &cs); v[q] = issin ? sn : cs; }
              w[e] = pk_h2(v[0], v[1]); }
          u32x4 o; o.x = w[0]; o.y = w[1]; o.z = w[2]; o.w = w[3]; *(u32x4*)(Dm + (size_t)n * 512 + c0) = o; } }
    { float* rc = (float*)(ws + WS_ROPE); float* rs = rc + 2048 * 64;
      for (long i = gt; i < 2048 * 64; i += NGT) { const int t = (int)(i >> 6), d = (int)(i & 63); const double inv = exp2(-(double)d * (13.287712379549449 / 64.0)); const double ang = (double)t * inv;
          rc[i] = (float)cos(ang); rs[i] = (float)sin(ang); } }
    { h16* xb = (h16*)(ws + WS_R2); signed char* x8 = (signed char*)(ws + WS_X8); float* sx = (float*)(ws + WS_VEC) + V_SX;
      for (int row = gw; row < M; row += NGW) {
          const float* src = row < M_PROMPT ? x_prompt + (size_t)row * D : x_sample + (size_t)(row - M_PROMPT) * D;
          f32x4 v[4][2]; float amax = 0.f;
#pragma unroll
          for (int j = 0; j < 4; ++j) { const int c = 512 * j + 8 * lane0; v[j][0] = *(const f32x4*)(src + c); v[j][1] = *(const f32x4*)(src + c + 4); }
#pragma unroll
          for (int j = 0; j < 4; ++j) { store_h8(xb + (size_t)row * D + 512 * j + 8 * lane0, v[j][0], v[j][1]);
#pragma unroll
              for (int e = 0; e < 4; ++e) amax = fmaxf(amax, fmaxf(fabsf(v[j][0][e]), fabsf(v[j][1][e]))); }
          amax = wave_max(amax);
          const float inv = amax > 0.f ? 127.0f / amax : 0.f;
#pragma unroll
          for (int j = 0; j < 4; ++j) *(u32x2*)(x8 + (size_t)row * D + 512 * j + 8 * lane0) = pack8_i8(v[j][0][0], v[j][0][1], v[j][0][2], v[j][0][3], v[j][1][0], v[j][1][1], v[j][1][2], v[j][1][3], inv);
          if (lane0 == 0) sx[row] = amax * (1.0f / 127.0f);
      } }
}

__device__ __forceinline__ unsigned att_off(unsigned row, unsigned ch) { return 256u * row + 16u * (ch ^ (((row & 3) << 2) | ((row >> 2) & 3))); }
struct AttItem { int br, r, p, idx0, L, h; size_t rowb; };
__device__ __forceinline__ AttItem att_decode(int I) {
    AttItem t; const int bh = I / 48, it = I % 48; t.h = bh & 7; t.rowb = (size_t)(bh >> 3) * SEQ; int blk;
    if (it < 16) { t.br = 0; t.r = 1; t.p = 0; blk = it; } else if (it < 32) { t.br = 1; t.r = 4; t.p = (it - 16) >> 2; blk = (it - 16) & 3; } else { t.br = 2; t.r = 16; t.p = it - 32; blk = 0; }
    t.L = SEQ / t.r; t.idx0 = 128 * blk; return t;
}
#define ATT_ISSUE(T) do { \
        const int ch_ = tid & 15, r4_ = tid >> 4; \
        const h16* base_ = Hq + (T).h * 128 + 8 * ch_; \
        _Pragma("unroll") for (int j = 0; j < 17; ++j) { const bool isv_ = j >= 8; const int rr_ = isv_ ? r4_ + 32 * (j - 8) : r4_ + 32 * j; \
            int kidx_ = (T).idx0 - 64 + rr_; kidx_ = kidx_ < 0 ? 0 : (kidx_ >= (T).L ? (T).L - 1 : kidx_); \
            if (j < 16 || tid < 256) kv[j] = *(const u32x4*)(base_ + ((T).rowb + (T).p + (T).r * kidx_) * 3072 + (isv_ ? 2048 : 1024)); } \
        const int qtok_ = (T).p + (T).r * ((T).idx0 + 16 * w + q16); const h16* qp_ = Hq + ((T).rowb + qtok_) * 3072 + (T).h * 128 + 8 * g; \
        _Pragma("unroll") for (int s = 0; s < 4; ++s) qn[s] = *(const h16x8*)(qp_ + 32 * s); } while (0)
__device__ __forceinline__ void attn_phase(Frame& F, h16* Obr) {
    const h16* Hq = (const h16*)(F.ws + WS_R1 + R1_HQKV); float* Lse = (float*)(F.ws + WS_LSE);
    const int tid_ = F.wave * 64 + mk_lane();
    LAS unsigned char* lds = F.lds; const int tid = tid_, lane = tid & 63, w = F.wave, q16 = lane & 15, g = lane >> 4;
    constexpr int NITEM = NSEQ * NH * 48;
    int i_lo, i_hi, i_st;
    if (F.G % 8 == 0) { const int per = F.G / 8, x = F.vcu / per, j = F.vcu % per; i_lo = x * (NITEM / 8) + j; i_hi = (x + 1) * (NITEM / 8); i_st = per; }
    else { i_lo = (int)((long)F.vcu * NITEM / F.G); i_hi = (int)((long)(F.vcu + 1) * NITEM / F.G); i_st = 1; }
    if (i_lo >= i_hi) return;
    u32x4 kv[17]; h16x8 qn[4];
    AttItem nx = att_decode(i_lo);
    ATT_ISSUE(nx);
    for (int I = i_lo; I < i_hi; I += i_st) {
        const AttItem cu = nx;
        __syncthreads();
        {   const int ch = tid & 15, r4 = tid >> 4;
#pragma unroll
            for (int j = 0; j < 17; ++j) { const bool isv = j >= 8; const int rr = isv ? r4 + 32 * (j - 8) : r4 + 32 * j;
                if (j < 16 || tid < 256) *(LAS u32x4*)(lds + (isv ? ATT_V : ATT_K) + att_off(rr, ch)) = kv[j]; } }
        h16x8 Qf[4];
#pragma unroll
        for (int s = 0; s < 4; ++s) Qf[s] = qn[s];
        __syncthreads();
        if (I + i_st < i_hi) { nx = att_decode(I + i_st); ATT_ISSUE(nx); }
        const int idx0 = cu.idx0, L = cu.L;
        const int qtok = cu.p + cu.r * (idx0 + 16 * w + q16);
        f32x4 sc[9];
        h16x8 kfb[2][4];
#pragma unroll
        for (int s = 0; s < 4; ++s) kfb[0][s] = *(const LAS h16x8*)(lds + ATT_K + att_off(16 * w + q16, 4 * s + g));
#pragma unroll
        for (int tt = 0; tt < 9; ++tt) {
            if (tt + 1 < 9) {
#pragma unroll
                for (int s = 0; s < 4; ++s) kfb[(tt + 1) & 1][s] = *(const LAS h16x8*)(lds + ATT_K + att_off(16 * (w + tt + 1) + q16, 4 * s + g)); }
            asm volatile("" ::: "memory");
            f32x4 a = {0.f, 0.f, 0.f, 0.f};
#pragma unroll
            for (int s = 0; s < 4; ++s) a = __builtin_amdgcn_mfma_f32_16x16x32_f16(kfb[tt & 1][s], Qf[s], a, 0, 0, 0);
            sc[tt] = a; }
        const int ql = 16 * w + q16;
        const int clo = ql > 64 - idx0 ? ql : 64 - idx0, chi = (ql + 128) < (L + 63 - idx0) ? (ql + 128) : (L + 63 - idx0);
        const unsigned span = (unsigned)(chi - clo); const int cb = 16 * w + 4 * g - clo;
        float mx = -3.0e38f;
#pragma unroll
        for (int tt = 0; tt < 9; ++tt)
#pragma unroll
            for (int e = 0; e < 4; ++e) { const bool ok = (unsigned)(cb + 16 * tt + e) <= span; sc[tt][e] = ok ? sc[tt][e] : -3.0e38f; mx = fmaxf(mx, sc[tt][e]); }
        mx = fmaxf(mx, shx<16>(mx)); mx = fmaxf(mx, shx<32>(mx));
        float den = 0.f;
#pragma unroll
        for (int tt = 0; tt < 9; ++tt)
#pragma unroll
            for (int e = 0; e < 4; ++e) { const float pv = __builtin_amdgcn_exp2f(sc[tt][e] - mx); sc[tt][e] = pv; den += pv; }
        den += shx<16>(den); den += shx<32>(den);
        h16x8 Pf[5];
#pragma unroll
        for (int ks = 0; ks < 5; ++ks) { u32x4 wv; wv.x = pk_h2(sc[2 * ks][0], sc[2 * ks][1]); wv.y = pk_h2(sc[2 * ks][2], sc[2 * ks][3]);
            if (ks < 4) { wv.z = pk_h2(sc[2 * ks + 1][0], sc[2 * ks + 1][1]); wv.w = pk_h2(sc[2 * ks + 1][2], sc[2 * ks + 1][3]); } else { wv.z = 0u; wv.w = 0u; }
            Pf[ks] = __builtin_bit_cast(h16x8, wv); }
        const float rden = 1.0f / den;
        unsigned char* op = (unsigned char*)Obr + ((size_t)cu.br * M + cu.rowb + qtok) * 1024 + cu.h * 128 + 4 * g;
        const float rs16 = rden * 16.0f;
        const int qq = q16 >> 2, pp = q16 & 3;
        typedef short s16x8 __attribute__((ext_vector_type(8)));
        s16x4 vlo[2][5], vhi[2][5];
#define ATT_LDV(B, C8) do { _Pragma("unroll") for (int ks = 0; ks < 5; ++ks) { const unsigned r0 = 16 * (w + 2 * ks) + 4 * g + qq, r1 = r0 + 16; \
            vlo[B][ks] = __builtin_bit_cast(s16x4, __builtin_amdgcn_ds_read_tr16_b64_v4i16((LAS s16x4*)(lds + ATT_V + att_off(r0, 2 * (C8) + (pp >> 1)) + 8 * (pp & 1)))); \
            vhi[B][ks] = __builtin_bit_cast(s16x4, __builtin_amdgcn_ds_read_tr16_b64_v4i16((LAS s16x4*)(lds + ATT_V + att_off(r1, 2 * (C8) + (pp >> 1)) + 8 * (pp & 1)))); } } while (0)
        ATT_LDV(0, 0);
#pragma unroll
        for (int c8 = 0; c8 < 8; ++c8) {
            if (c8 + 1 < 8) ATT_LDV((c8 + 1) & 1, c8 + 1);
            asm volatile("" ::: "memory");
            f32x4 o = {0.f, 0.f, 0.f, 0.f};
#pragma unroll
            for (int ks = 0; ks < 5; ++ks) {
                const s16x8 vv = __builtin_shufflevector(vlo[c8 & 1][ks], vhi[c8 & 1][ks], 0, 1, 2, 3, 4, 5, 6, 7);
                o = __builtin_amdgcn_mfma_f32_16x16x32_f16(__builtin_bit_cast(h16x8, vv), Pf[ks], o, 0, 0, 0); }
            int ov = __builtin_amdgcn_cvt_pk_fp8_f32(o[0] * rs16, o[1] * rs16, 0, false); ov = __builtin_amdgcn_cvt_pk_fp8_f32(o[2] * rs16, o[3] * rs16, ov, true);
            *(int*)(op + 16 * c8) = ov; }
#undef ATT_LDV
        if (g == 0) Lse[((size_t)cu.br * M + cu.rowb + qtok) * 8 + cu.h] = (mx + __log2f(den)) * 0.69314718055994531f;
    }
}
#undef ATT_ISSUE

__device__ __forceinline__ void load8(const h16* p, float (&v)[8]) { const h16x8 hv = *(const h16x8*)p;
#pragma unroll
    for (int e = 0; e < 8; ++e) v[e] = (float)hv[e]; }
struct MRow { h16x8 bg[2], pn[2]; u32x2 o[3][2]; float l[3][2]; };
__device__ __forceinline__ MRow merge_load_row(const h16* Hc, const h16* Obr, const float* Lse, int row, int lane) {
    MRow r;
#pragma unroll
    for (int q = 0; q < 2; ++q) {
        const int c = 512 * q + 8 * lane, h = c >> 7;
        r.bg[q] = *(const h16x8*)(Hc + (size_t)row * 3072 + c);
        const int rn = row + 1 < M ? row + 1 : row;
        r.pn[q] = *(const h16x8*)(Hc + (size_t)rn * 3072 + 1024 + c);
#pragma unroll
        for (int b = 0; b < 3; ++b) { r.o[b][q] = *(const u32x2*)((const unsigned char*)Obr + ((size_t)b * M + row) * 1024 + c); r.l[b][q] = Lse[((size_t)b * M + row) * 8 + h]; }
    }
    return r;
}
__device__ __forceinline__ void merge_phase(Frame& F, const h16* Obr, const float* cws  ) {
    const h16* Hc = (const h16*)(F.ws + WS_R1); const float* Lse = (const float*)(F.ws + WS_LSE); h16* YC = (h16*)(F.ws + WS_R1 + R1_HQKV);
    const int lane_ = mk_lane();
    int vcu_ = F.vcu; asm volatile("" : "+s"(vcu_));
    const int gw = vcu_ * 8 + F.wave, NGW = F.G * 8, lane = lane_;
    const int per = (M + NGW - 1) / NGW; const int r_lo = gw * per, r_hi = (r_lo + per) < M ? (r_lo + per) : M;
    if (r_lo >= r_hi) return;
    float w0[2][8], w1[2][8], w2[2][8];
#pragma unroll
    for (int q = 0; q < 2; ++q)
#pragma unroll
        for (int e = 0; e < 8; ++e) { const int c = 512 * q + 8 * lane + e; w0[q][e] = cws[c]; w1[q][e] = cws[1024 + c]; w2[q][e] = cws[2048 + c]; }
    float pl[2][8], pc[2][8];
#pragma unroll
    for (int q = 0; q < 2; ++q) { const int c = 512 * q + 8 * lane;
        load8(Hc + (size_t)r_lo * 3072 + 1024 + c, pc[q]);
        const int rp = r_lo > 0 ? r_lo - 1 : 0;
        load8(Hc + (size_t)rp * 3072 + 1024 + c, pl[q]); }
    MRow cur = merge_load_row(Hc, Obr, Lse, r_lo, lane);
    for (int row = r_lo; row < r_hi; ++row) {
        MRow nxt = cur;
        if (row + 1 < r_hi) nxt = merge_load_row(Hc, Obr, Lse, row + 1, lane);
        asm volatile("" ::: "memory");
        const int t = row & (SEQ - 1);
        const float ml = t > 0 ? 1.0f : 0.0f, mr = t < SEQ - 1 ? 1.0f : 0.0f;
        h16* yo = YC + (size_t)row * D;
#pragma unroll
        for (int q = 0; q < 2; ++q) {
            const int c = 512 * q + 8 * lane;
            f32x4 o0, o1;
#pragma unroll
            for (int e = 0; e < 8; ++e) { const float pr = (float)cur.pn[q][e];
                const float y = (float)cur.bg[q][e] * (w0[q][e] * (ml * pl[q][e]) + w1[q][e] * pc[q][e] + w2[q][e] * (mr * pr)); if (e < 4) o0[e] = y; else o1[e - 4] = y;
                pl[q][e] = pc[q][e]; pc[q][e] = pr; }
            store_h8(yo + c, o0, o1);
        }
#pragma unroll
        for (int q = 0; q < 2; ++q) {
            const int c = 512 * q + 8 * lane;
            const float l0 = cur.l[0][q], l1 = cur.l[1][q], l2 = cur.l[2][q];
            const float mx = fmaxf(l0, fmaxf(l1, l2)); float e0 = __expf(l0 - mx), e1 = __expf(l1 - mx), e2 = __expf(l2 - mx); const float rs = 0.0625f / (e0 + e1 + e2); e0 *= rs; e1 *= rs; e2 *= rs;
            f32x4 o0, o1;
#pragma unroll
            for (int hw = 0; hw < 2; ++hw) {
                const int x0 = (int)(hw ? cur.o[0][q].y : cur.o[0][q].x), x1 = (int)(hw ? cur.o[1][q].y : cur.o[1][q].x), x2 = (int)(hw ? cur.o[2][q].y : cur.o[2][q].x);
                const f32x2 ylo = __builtin_amdgcn_cvt_pk_f32_fp8(x0, false) * e0 + __builtin_amdgcn_cvt_pk_f32_fp8(x1, false) * e1 + __builtin_amdgcn_cvt_pk_f32_fp8(x2, false) * e2;
                const f32x2 yhi = __builtin_amdgcn_cvt_pk_f32_fp8(x0, true) * e0 + __builtin_amdgcn_cvt_pk_f32_fp8(x1, true) * e1 + __builtin_amdgcn_cvt_pk_f32_fp8(x2, true) * e2;
                if (hw == 0) { o0[0] = ylo.x; o0[1] = ylo.y; o0[2] = yhi.x; o0[3] = yhi.y; } else { o1[0] = ylo.x; o1[1] = ylo.y; o1[2] = yhi.x; o1[3] = yhi.y; } }
            store_h8(yo + 1024 + c, o0, o1);
        }
        cur = nxt;
    }
}

template <bool FINAL, bool WA256 = false>
__device__ __forceinline__ void norm_phase(Frame& F, h16* xb, float* out, const float* g, const float* bta, h16* A256 = nullptr) {
    const int lane_ = mk_lane();
    const int gw = F.vcu * 8 + F.wave, NGW = F.G * 8, lane = lane_;
    f32x4 gg[4][2], bb[4][2];
#pragma unroll
    for (int j = 0; j < 4; ++j) { const int c = 512 * j + 8 * lane; gg[j][0] = *(const f32x4*)(g + c); gg[j][1] = *(const f32x4*)(g + c + 4); bb[j][0] = *(const f32x4*)(bta + c); bb[j][1] = *(const f32x4*)(bta + c + 4); }
    h16x8 xv[4];
    if (gw < M) {
#pragma unroll
        for (int j = 0; j < 4; ++j) xv[j] = ((const h16x8*)(xb + (size_t)gw * D) + lane)[64 * j]; }
    for (int row = gw; row < M; row += NGW) {
        float v[4][8]; float s = 0.f;
#pragma unroll
        for (int j = 0; j < 4; ++j)
#pragma unroll
            for (int e = 0; e < 8; ++e) { v[j][e] = (float)xv[j][e]; s += v[j][e]; }
        const int nrow = row + NGW;
        if (nrow < M) {
#pragma unroll
            for (int j = 0; j < 4; ++j) xv[j] = ((const h16x8*)(xb + (size_t)nrow * D) + lane)[64 * j]; }
        const float mean = wave_sum(s) * (1.0f / D); float s2 = 0.f;
#pragma unroll
        for (int j = 0; j < 4; ++j)
#pragma unroll
            for (int e = 0; e < 8; ++e) { v[j][e] -= mean; s2 += v[j][e] * v[j][e]; }
        const float rstd = 1.0f / sqrtf(wave_sum(s2) * (1.0f / D) + LN_EPS);
#pragma unroll
        for (int j = 0; j < 4; ++j) {
            const int c = 512 * j + 8 * lane;
            f32x4 y0, y1;
#pragma unroll
            for (int e = 0; e < 4; ++e) { y0[e] = v[j][e] * rstd * gg[j][0][e] + bb[j][0][e]; y1[e] = v[j][e + 4] * rstd * gg[j][1][e] + bb[j][1][e]; }
            if (FINAL) { float* o = out + (size_t)row * D + c; *(f32x4*)o = y0; *(f32x4*)(o + 4) = y1; }
            else store_h8(xb + (size_t)row * D + c, y0, y1);
            if (WA256) {
                u32x4 w; w.x = pk_h2(y0[0], y0[1]); w.y = pk_h2(y0[2], y0[3]); w.z = pk_h2(y1[0], y1[1]); w.w = pk_h2(y1[2], y1[3]);
                const h16x8 hv = __builtin_bit_cast(h16x8, w); float a = 0.f;
#pragma unroll
                for (int e = 0; e < 8; e += 2) a += (float)hv[e] - (float)hv[e + 1];
                a = wave_sum(a);
                if (lane == 0) A256[((size_t)(row >> 11) * 4 + j) * 2048 + (row & 2047)] = (h16)a;
            }
        }
    }
}

template <bool KEEPZ> __device__ __forceinline__ void norm_phase_x8(Frame& F, h16* xb, signed char* x8, float* sx, const float* g, const float* bta, float* stats) {
    const int lane_ = mk_lane();
    const int gw = F.vcu * 8 + F.wave, NGW = F.G * 8, lane = lane_;
    f32x4 gg[4][2], bb[4][2];
#pragma unroll
    for (int j = 0; j < 4; ++j) { const int c = 512 * j + 8 * lane; gg[j][0] = *(const f32x4*)(g + c); gg[j][1] = *(const f32x4*)(g + c + 4); bb[j][0] = *(const f32x4*)(bta + c); bb[j][1] = *(const f32x4*)(bta + c + 4); }
    h16x8 xv[4];
    if (gw < M) {
#pragma unroll
        for (int j = 0; j < 4; ++j) xv[j] = ((const h16x8*)(xb + (size_t)gw * D) + lane)[64 * j]; }
    for (int row = gw; row < M; row += NGW) {
        float v[4][8]; float s = 0.f;
#pragma unroll
        for (int j = 0; j < 4; ++j)
#pragma unroll
            for (int e = 0; e < 8; ++e) { v[j][e] = (float)xv[j][e]; s += v[j][e]; }
        const int nrow = row + NGW;
        if (nrow < M) {
#pragma unroll
            for (int j = 0; j < 4; ++j) xv[j] = ((const h16x8*)(xb + (size_t)nrow * D) + lane)[64 * j]; }
        const float mean = wave_sum(s) * (1.0f / D); float s2 = 0.f;
#pragma unroll
        for (int j = 0; j < 4; ++j)
#pragma unroll
            for (int e = 0; e < 8; ++e) { v[j][e] -= mean; s2 += v[j][e] * v[j][e]; }
        const float rstd = 1.0f / sqrtf(wave_sum(s2) * (1.0f / D) + LN_EPS);
        float amax = 0.f;
#pragma unroll
        for (int j = 0; j < 4; ++j) {
            const int c = 512 * j + 8 * lane;
            f32x4 y0, y1;
#pragma unroll
            for (int e = 0; e < 4; ++e) { y0[e] = v[j][e] * rstd * gg[j][0][e] + bb[j][0][e]; y1[e] = v[j][e + 4] * rstd * gg[j][1][e] + bb[j][1][e]; v[j][e] = y0[e]; v[j][e + 4] = y1[e];
                amax = fmaxf(amax, fmaxf(fabsf(y0[e]), fabsf(y1[e]))); }
            if constexpr (!KEEPZ) store_h8(xb + (size_t)row * D + c, y0, y1);
        }
        amax = wave_max(amax);
        const float inv = amax > 0.f ? 127.0f / amax : 0.f;
#pragma unroll
        for (int j = 0; j < 4; ++j) *(u32x2*)(x8 + (size_t)row * D + 512 * j + 8 * lane) = pack8_i8(v[j][0], v[j][1], v[j][2], v[j][3], v[j][4], v[j][5], v[j][6], v[j][7], inv);
        if (lane == 0) { sx[row] = amax * (1.0f / 127.0f); if constexpr (KEEPZ) { f32x2 st; st.x = mean; st.y = rstd; *(f32x2*)(stats + 2 * (size_t)row) = st; } }
    }
}

__device__ __forceinline__ void actq_phase(Frame& F, const h16* act, signed char* a8, float* sa) {
    const int lane = mk_lane();
    int vcu_ = F.vcu; asm volatile("" : "+s"(vcu_));
    const int gw = vcu_ * 8 + F.wave, NGW = F.G * 8;
    h16x8 cur[11];
    if (gw < M) {
#pragma unroll
        for (int j = 0; j < 11; ++j) cur[j] = *(const h16x8*)(act + (size_t)gw * FF + 512 * j + 8 * lane); }
    for (int row = gw; row < M; row += NGW) {
        h16x8 nxt[11];
        const int nrow = row + NGW;
#pragma unroll
        for (int j = 0; j < 11; ++j) nxt[j] = cur[j];
        if (nrow < M) {
#pragma unroll
            for (int j = 0; j < 11; ++j) nxt[j] = *(const h16x8*)(act + (size_t)nrow * FF + 512 * j + 8 * lane); }
        const float sc = rowq_rot(cur, a8 + (size_t)row * FF, lane);
        if (lane == 0) sa[row] = sc;
#pragma unroll
        for (int j = 0; j < 11; ++j) cur[j] = nxt[j];
    }
}

constexpr int N_PHASES = 35;
__global__ void __launch_bounds__(512, 2) mk_fwd(Args args) {
    extern __shared__ __attribute__((aligned(16))) unsigned char lds_raw[];
    Frame F;
    F.lds = (LAS unsigned char*)lds_raw;
    F.MISC = (volatile LAS unsigned*)(F.lds + LDS_MISC);
    const int tid0 = threadIdx.x; F.wave = __builtin_amdgcn_readfirstlane(tid0 >> 6);
    F.G = gridDim.x; { const int bx = blockIdx.x; F.vcu = (F.G % 8 == 0) ? (bx % 8) * (F.G / 8) + bx / 8 : bx; }
    F.ws = args.ws; F.ctl = (unsigned*)(args.ws + WS_CTL);
    if (tid0 < 32) F.MISC[tid0] = 0u;
    __syncthreads();
#if MK_ONE_LAUNCH
    constexpr int lo = 0, hi = N_PHASES;
#else
    const int lo = args.ph_lo, hi = args.ph_hi;
#endif
    XcdBarrier bar; bar.bar = F.ctl + CW_BAR; bar.x = 0; bar.st = nullptr;
    if (hi - lo > 1) bar = xcd_barrier_post(F.ctl + CW_BAR, F.MISC + 8);
    bar.w = F.wave;
#ifndef MK_SITES
#define MK_SITES 0xffffffffu
#endif
#define SITE(n) ((MK_SITES >> (n)) & 1u)
#ifndef MK_REP_MASK
#define MK_REP_MASK 0u
#endif
#define RPT(n) _Pragma("unroll") for (int rep_ = 0; rep_ < 1 + (int)((MK_REP_MASK >> (n)) & 1u); ++rep_)
#define RPB() do { if (rep_) xcd_barrier(bar); } while (0)
#if MK_ONE_LAUNCH
#define IN(k) true
#define SEAM(k) xcd_barrier(bar)
#else
#define IN(k) (lo <= (k) && (k) < hi)
#define SEAM(k) do { if (IN(k) && IN((k) + 1)) xcd_barrier(bar); } while (0)
#endif
    const float* ln_mix_g = args.in[6]; const float* ln_mix_b = args.in[7]; const float* ln_ffn_g = args.in[11]; const float* ln_ffn_b = args.in[12];
    const int bx = (int)blockIdx.x;

    RPT(0) if (SITE(0) && IN(0)) { RPB(); p0_colmax(F, args.in[8], args.in[2]); p0_prologue<0>(F, args); xcd_barrier(bar); p0_prologue<1>(F, args); } SEAM(0);

    for (int pair = 0; pair < 2; ++pair) {
        const int pb = 1 + 17 * pair;
        for (int half = 0; half < 2; ++half) {
            const int l = 2 * pair + half;
            size_t zoff = 0; asm volatile("" : "+s"(zoff));
            unsigned char* ws = args.ws + zoff;
            h16* xb = (h16*)(ws + WS_R2);
            const int pm0 = pb + (half ? 9 : 0);
            int pn_;
            if (half == 0) {
                RPT(1) if (SITE(1) && IN(pm0 + 0)) { RPB();
                    { ProbStd P; P.A = (const char*)xb; P.B = (const char*)(ws + WS_WIN) + (size_t)pair * DIN * D * 2; P.K = D; P.lda = D; P.ldb = D; P.upmap = false; P.S.init(M / 256, 3072 / 256, F.G, bx);
                      EpiIn E{(h16*)(ws + WS_R1), (h16*)(ws + WS_R1 + R1_HQKV), (const float*)(ws + WS_ROPE), (const float*)(ws + WS_ROPE) + 2048 * 64};
                      pg8::gemm_phase<ProbStd, EpiIn>(F.lds, F.wave, P, E); }
                    __syncthreads();
                    { ProbStd P; P.A = (const char*)(ws + WS_X8); P.B = (const char*)(ws + WS_WIN8) + (size_t)pair * 3072 * D; P.K = D / 2; P.lda = D / 2; P.ldb = D / 2; P.upmap = false; P.S.init(M / 256, 3072 / 256, F.G, bx);
                      EpiInQ E{(h16*)(ws + WS_R1 + R1_HQKV), (const float*)(ws + WS_ROPE), (const float*)(ws + WS_ROPE) + 2048 * 64, (const float*)(ws + WS_VEC) + V_SX, (const float*)(ws + WS_VEC) + V_SWQ + pair * 3072};
                      pg8::gemm_phase<ProbStd, EpiInQ, true>(F.lds, F.wave, P, E); }
                }
                SEAM(pm0 + 0);
                RPT(2) if (SITE(2) && IN(pm0 + 1)) { RPB(); attn_phase(F, (h16*)args.out); }
                SEAM(pm0 + 1);
                RPT(3) if (SITE(3) && IN(pm0 + 2)) { RPB(); merge_phase(F, (const h16*)args.out, args.in[3] + (size_t)pair * 3 * CONV); }
                SEAM(pm0 + 2);
                RPT(4) if (SITE(4) && IN(pm0 + 3)) { RPB();
                    ProbStd P; P.A = (const char*)(ws + WS_R1 + R1_HQKV); P.B = (const char*)(ws + WS_WOM) + (size_t)pair * D * D * 2; P.K = D; P.lda = D; P.ldb = D; P.upmap = false; P.S.init(M / 256, D / 256, F.G, bx);
                    EpiRes E{xb, nullptr, nullptr, nullptr};
                    pg8::gemm_phase<ProbStd, EpiRes>(F.lds, F.wave, P, E);
                }
                SEAM(pm0 + 3);
                pn_ = pm0 + 4;
            } else {
                RPT(5) if (SITE(5) && IN(pm0 + 0)) { RPB();
                    ProbDftC P; P.Dm = (const char*)(ws + WS_DM); P.zb = (const char*)xb; P.G = F.G; P.c = bx;
                    EpiDftC E{(h16*)(ws + WS_R1)};
                    pg8::gemm_phase<ProbDftC, EpiDftC>(F.lds, F.wave, P, E);
                }
                SEAM(pm0 + 0);
                RPT(6) if (SITE(6) && IN(pm0 + 1)) { RPB();
                    ProbDftS P; P.Fmat = (const char*)(ws + WS_FMAT); P.Bt = (const char*)(ws + WS_R1); P.G = F.G; P.c = bx;
                    EpiDftS2 E{(h16*)(ws + WS_R1 + R1_F), args.out + (size_t)blockIdx.x * 65536};
                    pg8::gemm_phase<ProbDftS, EpiDftS2>(F.lds, F.wave, P, E);
                    dfts_side(F, (const h16*)(ws + WS_R1), (const h16*)(ws + WS_STATS), (const h16*)(ws + WS_FMAT), (h16*)(ws + WS_R1 + R1_F));
                }
                SEAM(pm0 + 1);
                RPT(7) if (SITE(7) && IN(pm0 + 2)) { RPB();
                    ProbStd P; P.A = (const char*)(ws + WS_R1 + R1_F); P.B = (const char*)(ws + WS_WOF) + (size_t)pair * D * D * 2; P.K = D; P.lda = D; P.ldb = D; P.upmap = false; P.S.init(M / 256, D / 256, F.G, bx);
                    EpiRes E{xb, nullptr, nullptr, nullptr};
                    pg8::gemm_phase<ProbStd, EpiRes>(F.lds, F.wave, P, E);
                }
                SEAM(pm0 + 2);
                pn_ = pm0 + 3;
            }
            RPT(8) if (SITE(8) && IN(pn_)) { RPB(); norm_phase_x8<true>(F, xb, (signed char*)(ws + WS_X8), (float*)(ws + WS_VEC) + V_SX, ln_mix_g + l * D, ln_mix_b + l * D, (float*)(ws + WS_LSE)); }
            SEAM(pn_);
            const int pf = pn_ + 1;
            const bool i8 = (kI8Mask >> l) & 1u;
            const char* Wup = i8 ? (const char*)(ws + WS_W8) + (size_t)l * FF2 * D : (const char*)(ws + WS_WUP) + (size_t)l * FF2 * D * 2;
            const float* swl = (const float*)(ws + WS_VEC) + V_SW + l * FF2; const float* sxv = (const float*)(ws + WS_VEC) + V_SX;
            RPT(9) if (SITE(9) && IN(pf + 0)) { RPB();
                if (kI8Mask == 0xFu || (kI8Mask != 0u && i8)) { ProbHalo P; P.A = (const char*)(ws + WS_X8); P.B = Wup; P.K = D / 2; P.lda = D / 2; P.ldb = D / 2; P.G = F.G; P.c = bx;
                    EpiHalo<true> E{(float*)(ws + WS_HALO), sxv, swl};
                    pg8::gemm_phase<ProbHalo, EpiHalo<true>, true>(F.lds, F.wave, P, E); }
                else if constexpr (kI8Mask != 0xFu) { ProbHalo P; P.A = (const char*)xb; P.B = Wup; P.K = D; P.lda = D; P.ldb = D; P.G = F.G; P.c = bx;
                    EpiHalo<false> E{(float*)(ws + WS_HALO), sxv, swl};
                    pg8::gemm_phase<ProbHalo, EpiHalo<false>, false>(F.lds, F.wave, P, E); }
            }
            SEAM(pf + 0);
            RPT(10) if (SITE(10) && IN(pf + 1)) { RPB();
                if (kI8Mask == 0xFu || (kI8Mask != 0u && i8)) { ProbStd P; P.A = (const char*)(ws + WS_X8); P.B = Wup; P.K = D / 2; P.lda = D / 2; P.ldb = D / 2; P.upmap = true; P.S.init(M / 256, FF2 / 256, F.G, bx);
                    EpiUp<true> E{(h16*)(ws + WS_R1), (const float*)(ws + WS_HALO), args.in[9] + (size_t)l * 3 * FF2, sxv, swl};
                    pg8::gemm_phase<ProbStd, EpiUp<true>, true>(F.lds, F.wave, P, E); }
                else if constexpr (kI8Mask != 0xFu) { ProbStd P; P.A = (const char*)xb; P.B = Wup; P.K = D; P.lda = D; P.ldb = D; P.upmap = true; P.S.init(M / 256, FF2 / 256, F.G, bx);
                    EpiUp<false> E{(h16*)(ws + WS_R1), (const float*)(ws + WS_HALO), args.in[9] + (size_t)l * 3 * FF2, sxv, swl};
                    pg8::gemm_phase<ProbStd, EpiUp<false>, false>(F.lds, F.wave, P, E); }
            }
            SEAM(pf + 1);
            const bool d8 = (kD8Mask >> l) & 1u;
            if (kD8Mask != 0u && d8) { actq_phase(F, (const h16*)(ws + WS_R1), (signed char*)args.out, (float*)(ws + WS_VEC) + V_SA); xcd_barrier(bar); }
            RPT(11) if (SITE(11) && IN(pf + 2)) { RPB();
                if (kD8Mask != 0u && d8) {
                    ProbStd P; P.A = (const char*)args.out; P.B = (const char*)(ws + WS_WDN8) + (size_t)l * D * FF; P.K = FF / 2; P.lda = FF / 2; P.ldb = FF / 2; P.upmap = false; P.S.init(M / 256, D / 256, F.G, bx);
                    EpiResT<true, true> E{xb, (const float*)(ws + WS_LSE), ln_mix_g + l * D, ln_mix_b + l * D, (const float*)(ws + WS_VEC) + V_SA, (const float*)(ws + WS_VEC) + V_SWD + l * D};
                    pg8::gemm_phase<ProbStd, EpiResT<true, true>, true>(F.lds, F.wave, P, E);
                } else if constexpr (kD8Mask != 0xFu) {
                    ProbStd P; P.A = (const char*)(ws + WS_R1); P.B = (const char*)(ws + WS_WDN) + (size_t)l * D * FF * 2; P.K = FF; P.lda = FF; P.ldb = FF; P.upmap = false; P.S.init(M / 256, D / 256, F.G, bx);
                    EpiResT<true> E{xb, (const float*)(ws + WS_LSE), ln_mix_g + l * D, ln_mix_b + l * D};
                    pg8::gemm_phase<ProbStd, EpiResT<true>>(F.lds, F.wave, P, E);
                }
            }
            SEAM(pf + 2);
            if (l < 3) { RPT(12) if (SITE(12) && IN(pf + 3)) { RPB(); if (half == 0) norm_phase<false, true>(F, xb, args.out, ln_ffn_g + l * D, ln_ffn_b + l * D, (h16*)(ws + WS_STATS)); else norm_phase_x8<false>(F, xb, (signed char*)(ws + WS_X8), (float*)(ws + WS_VEC) + V_SX, ln_ffn_g + l * D, ln_ffn_b + l * D, nullptr); } SEAM(pf + 3); }
            else { RPT(13) if (SITE(13) && IN(pf + 3)) norm_phase<true>(F, xb, args.out, ln_ffn_g + l * D, ln_ffn_b + l * D); }
        }
    }
#undef IN
#undef SEAM
}

extern "C" void kernel_launch(void* const* d_in, const int* in_sizes, int n_in, void* d_out, int out_size, void* d_ws, size_t ws_size, hipStream_t stream) {
    static int grid = 0;
    if (grid == 0) {
        if (n_in != 13 || out_size != M * D || ws_size < WS_END) { fprintf(stderr, "kernel_launch: unexpected problem (n_in %d, out %d, ws %zu)\n", n_in, out_size, ws_size); grid = -1; return; }
        int dev = 0, cus = 0, per_cu = 0;
        if (hipGetDevice(&dev) != hipSuccess || hipDeviceGetAttribute(&cus, hipDeviceAttributeMultiprocessorCount, dev) != hipSuccess) { grid = -1; return; }
        if (hipFuncSetAttribute((const void*)mk_fwd, hipFuncAttributeMaxDynamicSharedMemorySize, LDS_BYTES) != hipSuccess) { fprintf(stderr, "kernel_launch: hipFuncSetAttribute failed\n"); grid = -1; return; }
        if (hipOccupancyMaxActiveBlocksPerMultiprocessor(&per_cu, (const void*)mk_fwd, 512, LDS_BYTES) != hipSuccess || per_cu < 1) { fprintf(stderr, "kernel_launch: occupancy query says %d\n", per_cu); }
        (void)hipGetLastError();
        grid = cus;
    }
    if (grid < 0) return;
    (void)hipMemsetAsync((char*)d_ws + WS_CTL, 0, CTL_ZERO_BYTES, stream);
    Args a{};
    for (int i = 0; i < 13; ++i) a.in[i] = (const float*)d_in[i];
    a.out = (float*)d_out; a.ws = (unsigned char*)d_ws;
#if MK_ONE_LAUNCH
    a.ph_lo = 0; a.ph_hi = N_PHASES;
    hipLaunchKernelGGL(mk_fwd, dim3(grid), dim3(512), LDS_BYTES, stream, a);
#else
    for (int k = 0; k < N_PHASES; ++k) { a.ph_lo = k; a.ph_hi = k + 1; hipLaunchKernelGGL(mk_fwd, dim3(grid), dim3(512), LDS_BYTES, stream, a); }
#endif
}
```

```cpp
#include <hip/hip_runtime.h>
#include <cstdio>
#include <cstdint>

#ifndef MK_ONE_LAUNCH
#define MK_ONE_LAUNCH 1
#endif

#define LAS __attribute__((address_space(3)))
#define GAS __attribute__((address_space(1)))
typedef _Float16 h16;
typedef _Float16 h16x8 __attribute__((ext_vector_type(8)));
typedef _Float16 h16x4 __attribute__((ext_vector_type(4)));
typedef _Float16 h16x2 __attribute__((ext_vector_type(2)));
typedef float f32x4 __attribute__((ext_vector_type(4)));
typedef float f32x2 __attribute__((ext_vector_type(2)));
typedef unsigned u32x4 __attribute__((ext_vector_type(4)));
typedef unsigned u32x2 __attribute__((ext_vector_type(2)));
typedef short s16x4 __attribute__((ext_vector_type(4)));

constexpr int D = 2048, SEQ = 2048, NSEQ = 24, M = NSEQ * SEQ;
constexpr int M_PROMPT = 16 * SEQ;
constexpr int CONV = 1024, ATT = 1024, NH = 8, HD = 128, DIN = 6144, FF = 5632, FF2 = 11264;
constexpr int NHALO = 2 * (M / 128);
constexpr float ALPHA = 1.6817928305074290861f;
constexpr float LN_EPS = 1e-5f;
constexpr float QSCALE = 0.08838834764831844055f * 1.44269504088896341f;

constexpr size_t MiB = 1u << 20;
constexpr size_t WS_CTL = 0, CTL_ZERO_BYTES = 256 * 1024;
constexpr size_t WS_ROPE = 1 * MiB;
constexpr size_t WS_VEC = 2 * MiB;
constexpr size_t WS_PART = 3 * MiB;
constexpr size_t WS_STATS = 19 * MiB;
constexpr size_t WS_LSE = 27 * MiB;
constexpr size_t WS_HALO = 32 * MiB;
constexpr size_t WS_FMAT = 66 * MiB;
constexpr size_t WS_DM = 82 * MiB;
constexpr size_t WS_WIN = 90 * MiB;
constexpr size_t WS_WOM = 138 * MiB;
constexpr size_t WS_WOF = 154 * MiB;
constexpr size_t WS_WUP = 170 * MiB;
constexpr size_t WS_WDN = 346 * MiB;
constexpr size_t WS_R2 = 434 * MiB;
constexpr size_t WS_R1 = 722 * MiB;
constexpr size_t WS_X8 = 1298 * MiB;
constexpr size_t WS_W8 = 1394 * MiB;
constexpr size_t WS_END = 1482 * MiB;
constexpr size_t WS_WDN8 = WS_WUP + 16 * MiB;
constexpr size_t WS_WIN8 = WS_WUP;
#ifndef I8MASK
#define I8MASK 0xF
#endif
constexpr unsigned kI8Mask = I8MASK;
constexpr size_t R1_HQKV = (size_t)M * 3072 * 2;
constexpr int BTP = 4096 + 64;
constexpr size_t R1_F = (size_t)NSEQ * 2048 * 4096 * 2;
constexpr int V_CSUM_IN = 0, V_BIAS_IN = V_CSUM_IN + 2 * DIN, V_CSUM_UP = V_BIAS_IN + 2 * DIN, V_BIAS_UP = V_CSUM_UP + 4 * FF2,
              V_CSUM_D = V_BIAS_UP + 4 * FF2, V_BIAS_D = V_CSUM_D + 2 * 4 * 1024, V_ONES = V_BIAS_D + 2 * 4 * 1024, V_ZEROS = V_ONES + D, V_END = V_ZEROS + D;
static_assert(V_END * 4 <= (int)MiB, "vector region");
constexpr int V_SW = 0;
constexpr int V_SX = 65536;
constexpr int V_SWQ = 4 * FF2;
constexpr int PM_STRIDE = 4 * FF2 + 2 * 3072;
constexpr int V_SWD = V_SWQ + 2 * 3072;
constexpr int V_SA = 131072;
static_assert(V_SWD + 4 * D <= V_SX && (V_SX + M) <= V_SA && (V_SA + M) * 4 <= (int)MiB, "scale vectors");
#ifndef D8MASK
#define D8MASK 0xF
#endif
constexpr unsigned kD8Mask = D8MASK;
static_assert(MK_ONE_LAUNCH || kD8Mask == 0u, "the activation-quantisation phase has no phase id of its own");
__host__ __device__ constexpr size_t part_off(int mi) { return mi < 2 ? (size_t)mi * 32 * 2 * DIN : (size_t)2 * 32 * 2 * DIN + (size_t)(mi - 2) * 32 * 2 * FF2; }
static_assert(part_off(6) * 4 <= 16 * MiB, "partial region");

constexpr int CW_BAR = 1024;
constexpr int CW_SMAX = 16384;
constexpr int LDS_BYTES = 147456;
constexpr int LDS_TAB = 131072;
constexpr int LDS_RED = 133120;
constexpr int LDS_MISC = LDS_BYTES - 128;
constexpr int ATT_K = 0, ATT_V = 65536;
static_assert(ATT_V + 272 * 256 <= LDS_MISC, "attention LDS");

__device__ __forceinline__ unsigned pk_h2(float lo, float hi) { f32x2 v = {lo, hi}; h16x2 h = __builtin_convertvector(v, h16x2); return __builtin_bit_cast(unsigned, h); }
__device__ __forceinline__ int mk_lane() { int l; asm volatile("v_mbcnt_lo_u32_b32 %0, -1, 0\n\tv_mbcnt_hi_u32_b32 %0, -1, %0" : "=v"(l)); return l; }
template <int O> __device__ __forceinline__ float shx(float v) {
    if constexpr (O < 32) return __builtin_bit_cast(float, __builtin_amdgcn_ds_swizzle(__builtin_bit_cast(int, v), (O << 10) | 0x1f));
    else return __builtin_bit_cast(float, __builtin_amdgcn_ds_bpermute((mk_lane() ^ 32) << 2, __builtin_bit_cast(int, v)));
}
template <int CTRL, int RM> __device__ __forceinline__ float dpp_f(float ident, float v) {
    return __builtin_bit_cast(float, __builtin_amdgcn_update_dpp(__builtin_bit_cast(int, ident), __builtin_bit_cast(int, v), CTRL, RM, 0xF, false));
}
__device__ __forceinline__ float wave_sum(float v) {
    v += dpp_f<0xB1, 0xF>(0.f, v); v += dpp_f<0x4E, 0xF>(0.f, v); v += dpp_f<0x141, 0xF>(0.f, v); v += dpp_f<0x140, 0xF>(0.f, v);
    v += dpp_f<0x142, 0xA>(0.f, v); v += dpp_f<0x143, 0xC>(0.f, v);
    return __builtin_bit_cast(float, __builtin_amdgcn_readlane(__builtin_bit_cast(int, v), 63));
}
__device__ __forceinline__ float wave_max(float v) {
    v = fmaxf(v, dpp_f<0xB1, 0xF>(0.f, v)); v = fmaxf(v, dpp_f<0x4E, 0xF>(0.f, v)); v = fmaxf(v, dpp_f<0x141, 0xF>(0.f, v)); v = fmaxf(v, dpp_f<0x140, 0xF>(0.f, v));
    v = fmaxf(v, dpp_f<0x142, 0xA>(0.f, v)); v = fmaxf(v, dpp_f<0x143, 0xC>(0.f, v));
    return __builtin_bit_cast(float, __builtin_amdgcn_readlane(__builtin_bit_cast(int, v), 63));
}
__device__ __forceinline__ void rot128(float (&v)[8], float s1, float s2, float s3, float s4) {
#pragma unroll
    for (int h = 1; h < 8; h <<= 1)
#pragma unroll
        for (int i = 0; i < 8; ++i) if ((i & h) == 0) { const float a = v[i], b = v[i + h]; v[i] = a + b; v[i + h] = a - b; }
    asm volatile(
        "s_nop 1\n\t"
        "v_fmac_f32_dpp %0, %0, %8 quad_perm:[1,0,3,2] row_mask:0xf bank_mask:0xf\n\t"
        "v_fmac_f32_dpp %1, %1, %8 quad_perm:[1,0,3,2] row_mask:0xf bank_mask:0xf\n\t"
        "v_fmac_f32_dpp %2, %2, %8 quad_perm:[1,0,3,2] row_mask:0xf bank_mask:0xf\n\t"
        "v_fmac_f32_dpp %3, %3, %8 quad_perm:[1,0,3,2] row_mask:0xf bank_mask:0xf\n\t"
        "v_fmac_f32_dpp %4, %4, %8 quad_perm:[1,0,3,2] row_mask:0xf bank_mask:0xf\n\t"
        "v_fmac_f32_dpp %5, %5, %8 quad_perm:[1,0,3,2] row_mask:0xf bank_mask:0xf\n\t"
        "v_fmac_f32_dpp %6, %6, %8 quad_perm:[1,0,3,2] row_mask:0xf bank_mask:0xf\n\t"
        "v_fmac_f32_dpp %7, %7, %8 quad_perm:[1,0,3,2] row_mask:0xf bank_mask:0xf\n\t"
        "v_fmac_f32_dpp %0, %0, %9 quad_perm:[2,3,0,1] row_mask:0xf bank_mask:0xf\n\t"
        "v_fmac_f32_dpp %1, %1, %9 quad_perm:[2,3,0,1] row_mask:0xf bank_mask:0xf\n\t"
        "v_fmac_f32_dpp %2, %2, %9 quad_perm:[2,3,0,1] row_mask:0xf bank_mask:0xf\n\t"
        "v_fmac_f32_dpp %3, %3, %9 quad_perm:[2,3,0,1] row_mask:0xf bank_mask:0xf\n\t"
        "v_fmac_f32_dpp %4, %4, %9 quad_perm:[2,3,0,1] row_mask:0xf bank_mask:0xf\n\t"
        "v_fmac_f32_dpp %5, %5, %9 quad_perm:[2,3,0,1] row_mask:0xf bank_mask:0xf\n\t"
        "v_fmac_f32_dpp %6, %6, %9 quad_perm:[2,3,0,1] row_mask:0xf bank_mask:0xf\n\t"
        "v_fmac_f32_dpp %7, %7, %9 quad_perm:[2,3,0,1] row_mask:0xf bank_mask:0xf\n\t"
        "v_fmac_f32_dpp %0, %0, %10 row_half_mirror row_mask:0xf bank_mask:0xf\n\t"
        "v_fmac_f32_dpp %1, %1, %10 row_half_mirror row_mask:0xf bank_mask:0xf\n\t"
        "v_fmac_f32_dpp %2, %2, %10 row_half_mirror row_mask:0xf bank_mask:0xf\n\t"
        "v_fmac_f32_dpp %3, %3, %10 row_half_mirror row_mask:0xf bank_mask:0xf\n\t"
        "v_fmac_f32_dpp %4, %4, %10 row_half_mirror row_mask:0xf bank_mask:0xf\n\t"
        "v_fmac_f32_dpp %5, %5, %10 row_half_mirror row_mask:0xf bank_mask:0xf\n\t"
        "v_fmac_f32_dpp %6, %6, %10 row_half_mirror row_mask:0xf bank_mask:0xf\n\t"
        "v_fmac_f32_dpp %7, %7, %10 row_half_mirror row_mask:0xf bank_mask:0xf\n\t"
        "v_fmac_f32_dpp %0, %0, %11 row_mirror row_mask:0xf bank_mask:0xf\n\t"
        "v_fmac_f32_dpp %1, %1, %11 row_mirror row_mask:0xf bank_mask:0xf\n\t"
        "v_fmac_f32_dpp %2, %2, %11 row_mirror row_mask:0xf bank_mask:0xf\n\t"
        "v_fmac_f32_dpp %3, %3, %11 row_mirror row_mask:0xf bank_mask:0xf\n\t"
        "v_fmac_f32_dpp %4, %4, %11 row_mirror row_mask:0xf bank_mask:0xf\n\t"
        "v_fmac_f32_dpp %5, %5, %11 row_mirror row_mask:0xf bank_mask:0xf\n\t"
        "v_fmac_f32_dpp %6, %6, %11 row_mirror row_mask:0xf bank_mask:0xf\n\t"
        "v_fmac_f32_dpp %7, %7, %11 row_mirror row_mask:0xf bank_mask:0xf\n\t"
        : "+v"(v[0]), "+v"(v[1]), "+v"(v[2]), "+v"(v[3]), "+v"(v[4]), "+v"(v[5]), "+v"(v[6]), "+v"(v[7])
        : "v"(s1), "v"(s2), "v"(s3), "v"(s4));
}
__device__ __forceinline__ u32x2 pack8_i8(float a0, float a1, float a2, float a3, float a4, float a5, float a6, float a7, float inv) {
    const unsigned b0 = __builtin_bit_cast(unsigned, __builtin_fmaf(a0, inv, 12582912.0f)), b1 = __builtin_bit_cast(unsigned, __builtin_fmaf(a1, inv, 12582912.0f)),
                   b2 = __builtin_bit_cast(unsigned, __builtin_fmaf(a2, inv, 12582912.0f)), b3 = __builtin_bit_cast(unsigned, __builtin_fmaf(a3, inv, 12582912.0f)),
                   b4 = __builtin_bit_cast(unsigned, __builtin_fmaf(a4, inv, 12582912.0f)), b5 = __builtin_bit_cast(unsigned, __builtin_fmaf(a5, inv, 12582912.0f)),
                   b6 = __builtin_bit_cast(unsigned, __builtin_fmaf(a6, inv, 12582912.0f)), b7 = __builtin_bit_cast(unsigned, __builtin_fmaf(a7, inv, 12582912.0f));
    u32x2 o;
    o.x = __builtin_amdgcn_perm(b1, b0, 0x0c0c0400u) | __builtin_amdgcn_perm(b3, b2, 0x04000c0cu);
    o.y = __builtin_amdgcn_perm(b5, b4, 0x0c0c0400u) | __builtin_amdgcn_perm(b7, b6, 0x04000c0cu);
    return o;
}
__device__ __forceinline__ float rowq_rot(const h16x8 (&in)[11], signed char* dst, int lane) {
    const float s1 = (lane & 1) ? -1.0f : 1.0f, s2 = (lane & 2) ? -1.0f : 1.0f, s3 = (lane & 4) ? -1.0f : 1.0f, s4 = (lane & 8) ? -1.0f : 1.0f;
    float v[11][8];
#pragma unroll
    for (int j = 0; j < 11; ++j) {
#pragma unroll
        for (int e = 0; e < 8; ++e) v[j][e] = (float)in[j][e];
        rot128(v[j], s1, s2, s3, s4);
    }
#pragma unroll
    for (int j = 0; j < 10; j += 2)
#pragma unroll
        for (int e = 0; e < 8; ++e) { const float a = v[j][e], b = v[j + 1][e]; v[j][e] = a + b; v[j + 1][e] = a - b; }
#pragma unroll
    for (int j = 0; j < 8; ++j) if ((j & 2) == 0) {
#pragma unroll
        for (int e = 0; e < 8; ++e) { const float a = v[j][e], b = v[j + 2][e]; v[j][e] = a + b; v[j + 2][e] = a - b; } }
    float m0 = 0.f, m1 = 0.f, m2 = 0.f;
#pragma unroll
    for (int j = 0; j < 11; ++j)
#pragma unroll
        for (int e = 0; e < 8; ++e) { const float a = fabsf(v[j][e]); if (j < 8) m0 = fmaxf(m0, a); else if (j < 10) m1 = fmaxf(m1, a); else m2 = fmaxf(m2, a); }
    float amax = fmaxf(fmaxf(0.5f * m0, 0.70710678118654752f * m1), m2);
    amax = wave_max(amax);
    const float inv = amax > 0.f ? 127.0f / amax : 0.f;
#pragma unroll
    for (int j = 0; j < 11; ++j) { const float fi = inv * (j < 8 ? 0.5f : (j < 10 ? 0.70710678118654752f : 1.0f));
        *(u32x2*)(dst + 512 * j + 8 * lane) = pack8_i8(v[j][0], v[j][1], v[j][2], v[j][3], v[j][4], v[j][5], v[j][6], v[j][7], fi); }
    return amax * (1.0f / 127.0f);
}
#define LDS_FENCE_BAR() do { asm volatile("s_waitcnt lgkmcnt(0)" ::: "memory"); __builtin_amdgcn_s_barrier(); asm volatile("" ::: "memory"); } while (0)

#define XB_TMO      128
#define XB_XCNT(j)  (256  + 64 * (j))
#define XB_XSUB(j)  (1280 + 64 * (j))
#define XB_XGEN(j)  (2304 + 64 * (j))
#define XB_TOP      3328
#define XB_TOPGEN   3392
#define XCD_BAR_WORDS 3456
#define XB_SPIN_CAP (1u << 22)
static_assert(kI8Mask == 0xFu, "WS_WIN8 lives in the fp16 up-weight region");
static_assert(CW_BAR + XCD_BAR_WORDS <= CW_SMAX && (CW_SMAX + 4 * FF2) * 4 <= (int)CTL_ZERO_BYTES, "control words inside the memset region");
__device__ __forceinline__ unsigned xb_ld(unsigned* p)              { return __hip_atomic_load(p, __ATOMIC_RELAXED, __HIP_MEMORY_SCOPE_AGENT); }
__device__ __forceinline__ unsigned xb_add(unsigned* p, unsigned v) { return __hip_atomic_fetch_add(p, v, __ATOMIC_RELAXED, __HIP_MEMORY_SCOPE_AGENT); }
__device__ __forceinline__ unsigned xb_xcc_id() { return (unsigned)__builtin_amdgcn_s_getreg((3 << 11) | 20) & 0xFu; }
#define XB_SPIN(cond, bar) do { unsigned _sp = 0; while (cond) { __builtin_amdgcn_s_sleep(1); \
    if ((++_sp & 255u) == 0u) { if (xb_ld(&(bar)[XB_TMO])) break; if (_sp > XB_SPIN_CAP) { atomicAdd(&(bar)[XB_TMO], 1u); break; } } } } while (0)
struct XcdBarrier { unsigned* bar; unsigned x; volatile LAS unsigned* st; int w; };
__device__ __forceinline__ XcdBarrier xcd_barrier_post(unsigned* bar, volatile LAS unsigned* st) {
    XcdBarrier b; b.bar = bar; b.x = xb_xcc_id(); b.st = st; b.w = 0;
    if (threadIdx.x == 0) (void)xb_add(&bar[XB_XCNT(b.x)], 1u);
    return b;
}
__device__ __forceinline__ void xcd_barrier_complete(unsigned* bar, unsigned x, unsigned& nloc, unsigned& nx) {
    const unsigned G = gridDim.x * gridDim.y * gridDim.z;
    unsigned sum, cnt, mine, sp = 0u;
    for (;;) {
        sum = 0u; cnt = 0u; mine = 0u;
#pragma unroll
        for (unsigned j = 0; j < 16; ++j) { const unsigned c = xb_ld(&bar[XB_XCNT(j)]); sum += c; cnt += (c > 0u) ? 1u : 0u; mine = (j == x) ? c : mine; }
        if (sum == G) break;
        __builtin_amdgcn_s_sleep(1);
        if ((++sp & 255u) == 0u) { if (xb_ld(&bar[XB_TMO])) break; if (sp > XB_SPIN_CAP) { atomicAdd(&bar[XB_TMO], 1u); break; } }
    }
    nloc = mine > 0u ? mine : 1u; nx = cnt > 0u ? cnt : 1u;
}
__device__ __forceinline__ void xcd_barrier(const XcdBarrier& b) {
    asm volatile("s_waitcnt vmcnt(0)" ::: "memory");
    __syncthreads();
    if (b.w == 0 && mk_lane() == 0) {
        unsigned* bar = b.bar;
        __builtin_amdgcn_s_waitcnt(0);
        unsigned nloc = b.st[0], nx = b.st[1];
        if (nloc == 0u) { xcd_barrier_complete(bar, b.x, nloc, nx); b.st[0] = nloc; b.st[1] = nx; }
        const unsigned old = xb_add(&bar[XB_XSUB(b.x)], 1u);
        const unsigned gen = old / nloc;
        if (old + 1u == (gen + 1u) * nloc) {
            __builtin_amdgcn_fence(__ATOMIC_RELEASE, "agent");
            asm volatile("s_waitcnt vmcnt(0)" ::: "memory");
            const unsigned og = xb_add(&bar[XB_TOP], 1u);
            const unsigned tg = og / nx;
            if (og + 1u == (tg + 1u) * nx) xb_add(&bar[XB_TOPGEN], 1u);
            else XB_SPIN(xb_ld(&bar[XB_TOPGEN]) == tg, bar);
            __builtin_amdgcn_fence(__ATOMIC_ACQUIRE, "agent");
            xb_add(&bar[XB_XGEN(b.x)], 1u);
            asm volatile("s_waitcnt vmcnt(0)" ::: "memory");
        } else {
            XB_SPIN(xb_ld(&bar[XB_XGEN(b.x)]) == gen, bar);
            __builtin_amdgcn_fence(__ATOMIC_ACQUIRE, "agent");
            asm volatile("s_waitcnt vmcnt(0)" ::: "memory");
        }
    }
    __syncthreads();
}

namespace pg8 {
constexpr int BM = 256, BK = 64, HALF = 128, HTB = HALF * BK * 2, STAGE_BYTES = 8 * HTB, NXCD = 8, WGM = 4;
__device__ __forceinline__ int lds_byte(int r, int c) { const int st = (r >> 4) * 2 + (c >> 5), rr = r & 15, cc = c & 31, ob = rr * 64 + cc * 2; return st * 1024 + (ob ^ (((ob >> 9) & 1) << 5)); }
__device__ __forceinline__ void stage_rc(int b, int& R, int& C) { const int st = b / 1024, sb = b % 1024, swz = sb ^ (((sb >> 9) & 1) << 5); R = (st >> 1) * 16 + swz / 64; C = (st & 1) * 32 + (swz % 64) / 2; }
__device__ __forceinline__ int perm32(int rho) { const int n = rho >> 4, i = rho & 15; return 8 * (i >> 2) + 4 * n + (i & 3); }
struct Unit { int pm, pn, g; int part, keep; };
typedef f32x4 Acc[2][2][4][2];
__device__ __forceinline__ void glds16_s(const void* sbase, unsigned voff, unsigned lds_dst) {
    unsigned keep;
    asm volatile("s_mov_b32 %0, m0\n\ts_mov_b32 m0, %3\n\ts_nop 0\n\tglobal_load_lds_dwordx4 %1, %2\n\ts_mov_b32 m0, %0" : "=&s"(keep) : "v"(voff), "s"(sbase), "s"(lds_dst) : "memory");
}

struct StaticOrder {
    int nM, nN, nwg, G, c;
    __device__ void init(int nM_, int nN_, int G_, int c_) { nM = nM_; nN = nN_; nwg = nM * nN; G = G_; c = c_; }
    __device__ bool next(int i, Unit& u) const {
        const long L = (long)i * G + c; if (L >= nwg) return false;
        int wgid = (int)L; { const int q = nwg / NXCD, r = nwg % NXCD, xcd = wgid % NXCD, off = wgid / NXCD; wgid = (xcd < r ? xcd * (q + 1) : r * (q + 1) + (xcd - r) * q) + off; }
        const int nig = WGM * nN, gid = wgid / nig, fm = gid * WGM, gsz = (nM - fm) < WGM ? (nM - fm) : WGM;
        u.pm = fm + ((wgid % nig) % gsz); u.pn = (wgid % nig) / gsz; u.g = 0; u.part = 0; u.keep = 0; return true;
    }
};

typedef int i32x4 __attribute__((ext_vector_type(4)));
template <bool I8> __device__ __forceinline__ f32x4 mma_step(const h16x8& b, const h16x8& a, const f32x4& c) {
    if constexpr (I8) return __builtin_bit_cast(f32x4, __builtin_amdgcn_mfma_i32_16x16x64_i8(__builtin_bit_cast(i32x4, b), __builtin_bit_cast(i32x4, a), __builtin_bit_cast(i32x4, c), 0, 0, 0));
    else return __builtin_amdgcn_mfma_f32_16x16x32_f16(b, a, c, 0, 0, 0);
}
template <class Prob, class Epi, bool I8 = false, bool ALIGN_EPI = true, bool SP2 = true>
__device__ __forceinline__ void gemm_phase(LAS unsigned char* lds, int wave, const Prob& P, const Epi& E) {
    const int tid_ = wave * 64 + mk_lane();
    const int tid = tid_, wid = __builtin_amdgcn_readfirstlane(tid >> 6), lane = tid & 63, wr = wid >> 2, wc = wid & 3, fr = lane & 15, fq = lane >> 4;
    const int K = P.K, nt = K / BK;
    unsigned voffA[2], voffB[2];
#pragma unroll
    for (int i = 0; i < 2; ++i) { int R, C; stage_rc(tid * 16 + i * 8192, R, C); const int Rb = (R & ~31) + perm32(R & 31);
        voffA[i] = P.a_rowoff(R) + (unsigned)C * 2u; voffB[i] = P.b_rowoff(Rb) + (unsigned)C * 2u; }
    const size_t kstep = (size_t)(BK * 2);
    const size_t hstepA = P.a_hstep(), hstepB = P.b_hstep();
    const unsigned ldsw = (unsigned)wid * 1024u;
    const unsigned ldsb = (unsigned)(size_t)lds + ldsw;
    const int aoff = lds_byte(wr * 64 + fr, fq * 8), boff = lds_byte(wc * 32 + fr, fq * 8);
#define PG8_SA(b, h) (((b) * 2 + (h)) * HTB)
#define PG8_SB(b, h) ((4 + (b) * 2 + (h)) * HTB)
#define PG8_STAGE(bufoff, gbase, voff) do { _Pragma("unroll") for (int _i = 0; _i < 2; ++_i) glds16_s((gbase), (voff)[_i], ldsb + (unsigned)((bufoff) + _i * 8192)); } while (0)
#define PG8_LDA(dst, b, h) do { _Pragma("unroll") for (int m = 0; m < 4; ++m) _Pragma("unroll") for (int k = 0; k < 2; ++k) dst[m][k] = *(const LAS h16x8*)(lds + PG8_SA(b, h) + aoff + m * 2048 + k * 1024); } while (0)
#define PG8_LDB(dst, b, h) do { _Pragma("unroll") for (int n = 0; n < 2; ++n) _Pragma("unroll") for (int k = 0; k < 2; ++k) dst[n][k] = *(const LAS h16x8*)(lds + PG8_SB(b, h) + boff + n * 2048 + k * 1024); } while (0)
#define PG8_MMA(ai, bj, At, Bt) do { __builtin_amdgcn_s_setprio(1); _Pragma("unroll") for (int m = 0; m < 4; ++m) _Pragma("unroll") for (int n = 0; n < 2; ++n) _Pragma("unroll") for (int k = 0; k < 2; ++k) \
        acc[ai][bj][m][n] = mma_step<I8>(Bt[n][k], At[m][k], acc[ai][bj][m][n]); __builtin_amdgcn_s_setprio(0); } while (0)
#define PG8_WAIT_V(n) asm volatile("s_waitcnt vmcnt(" #n ")" ::: "memory")
#define PG8_WAIT_L(n) asm volatile("s_waitcnt lgkmcnt(" #n ")" ::: "memory")
#define PG8_BAR __builtin_amdgcn_s_barrier()
#define PG8_SCHED __builtin_amdgcn_sched_barrier(0)
    Unit cur, nxt; int ui = 0;
    if (!P.next(0, cur)) return;
    Acc acc;
#pragma unroll
    for (int a = 0; a < 2; ++a)
#pragma unroll
        for (int b = 0; b < 2; ++b)
#pragma unroll
            for (int m = 0; m < 4; ++m)
#pragma unroll
                for (int n = 0; n < 2; ++n) acc[a][b][m][n] = (f32x4){0.f, 0.f, 0.f, 0.f};
    h16x8 At[4][2], B0[2][2], B1[2][2];
    const char* cA = P.a_tile(cur); const char* cB = P.b_tile(cur);
    if constexpr (SP2) {
        PG8_STAGE(PG8_SB(0, 0), cB, voffB); PG8_STAGE(PG8_SB(0, 1), cB + hstepB, voffB); PG8_STAGE(PG8_SA(0, 0), cA, voffA); PG8_STAGE(PG8_SA(0, 1), cA + hstepA, voffA);
        if (wr == 1) PG8_BAR;
        PG8_WAIT_V(2); PG8_BAR;
        PG8_STAGE(PG8_SB(1, 0), cB + kstep, voffB); PG8_STAGE(PG8_SA(1, 0), cA + kstep, voffA); PG8_STAGE(PG8_SB(1, 1), cB + hstepB + kstep, voffB);
        PG8_WAIT_V(6); PG8_BAR;
    } else {
        PG8_STAGE(PG8_SB(0, 0), cB, voffB); PG8_STAGE(PG8_SA(0, 0), cA, voffA); PG8_STAGE(PG8_SB(0, 1), cB + hstepB, voffB); PG8_STAGE(PG8_SA(0, 1), cA + hstepA, voffA);
        if (wr == 1) PG8_BAR;
        PG8_WAIT_V(4); PG8_BAR;
        PG8_STAGE(PG8_SB(1, 0), cB + kstep, voffB); PG8_STAGE(PG8_SA(1, 0), cA + kstep, voffA); PG8_STAGE(PG8_SB(1, 1), cB + hstepB + kstep, voffB);
        PG8_WAIT_V(6); PG8_BAR;
    }
    for (;;) {
        const bool has_next = P.next(ui + 1, nxt);
        const char* nA = has_next ? P.a_tile(nxt) : cA; const char* nB = has_next ? P.b_tile(nxt) : cB;
        for (int t = 0; t < nt; t += 2) {
            const bool last = (t == nt - 2);
            const char* a1 = cA + (size_t)(t + 1) * kstep;
            const char* a2 = last ? nA : cA + (size_t)(t + 2) * kstep; const char* b2 = last ? nB : cB + (size_t)(t + 2) * kstep;
            const char* a3 = a2 + kstep; const char* b3 = b2 + kstep;
            if constexpr (SP2) {
            PG8_LDB(B0, 0, 0); PG8_LDB(B1, 0, 1); PG8_SCHED; PG8_LDA(At, 0, 0); PG8_STAGE(PG8_SA(1, 1), a1 + hstepA, voffA);
            PG8_WAIT_V(8); PG8_WAIT_L(0); PG8_BAR; PG8_MMA(0, 0, At, B0); PG8_MMA(0, 1, At, B1); PG8_BAR; PG8_SCHED;
            PG8_LDA(At, 0, 1); PG8_STAGE(PG8_SB(0, 0), b2, voffB); PG8_STAGE(PG8_SB(0, 1), b2 + hstepB, voffB); PG8_STAGE(PG8_SA(0, 0), a2, voffA);
            PG8_WAIT_V(8); PG8_WAIT_L(0); PG8_BAR; PG8_MMA(1, 0, At, B0); PG8_MMA(1, 1, At, B1); PG8_BAR; PG8_SCHED;
            PG8_LDB(B0, 1, 0); PG8_LDB(B1, 1, 1); PG8_SCHED; PG8_LDA(At, 1, 0); PG8_STAGE(PG8_SA(0, 1), a2 + hstepA, voffA);
            PG8_WAIT_V(8); PG8_WAIT_L(0); PG8_BAR; PG8_MMA(0, 0, At, B0); PG8_MMA(0, 1, At, B1); PG8_BAR; PG8_SCHED;
            PG8_LDA(At, 1, 1); PG8_STAGE(PG8_SB(1, 0), b3, voffB); PG8_STAGE(PG8_SB(1, 1), b3 + hstepB, voffB); PG8_STAGE(PG8_SA(1, 0), a3, voffA);
            PG8_WAIT_V(8); PG8_WAIT_L(0); PG8_BAR; PG8_MMA(1, 0, At, B0); PG8_MMA(1, 1, At, B1); PG8_BAR; PG8_SCHED;
            } else {
            PG8_LDB(B0, 0, 0); PG8_SCHED; PG8_LDA(At, 0, 0); PG8_STAGE(PG8_SA(1, 1), a1 + hstepA, voffA);
            PG8_WAIT_L(8); PG8_BAR; PG8_WAIT_L(0); PG8_MMA(0, 0, At, B0); PG8_BAR; PG8_SCHED;
            PG8_LDB(B1, 0, 1); PG8_STAGE(PG8_SB(0, 0), b2, voffB);
            PG8_BAR; PG8_WAIT_L(0); PG8_MMA(0, 1, At, B1); PG8_BAR;
            PG8_LDA(At, 0, 1); PG8_STAGE(PG8_SA(0, 0), a2, voffA);
            PG8_BAR; PG8_WAIT_L(0); PG8_MMA(1, 0, At, B0); PG8_BAR; PG8_SCHED;
            PG8_STAGE(PG8_SB(0, 1), b2 + hstepB, voffB);
            PG8_WAIT_V(6); PG8_BAR; PG8_MMA(1, 1, At, B1); PG8_BAR;
            PG8_LDB(B0, 1, 0); PG8_SCHED; PG8_LDA(At, 1, 0); PG8_STAGE(PG8_SA(0, 1), a2 + hstepA, voffA);
            PG8_WAIT_L(8); PG8_BAR; PG8_WAIT_L(0); PG8_MMA(0, 0, At, B0); PG8_BAR; PG8_SCHED;
            PG8_LDB(B1, 1, 1); PG8_STAGE(PG8_SB(1, 0), b3, voffB);
            PG8_BAR; PG8_WAIT_L(0); PG8_MMA(0, 1, At, B1); PG8_BAR;
            PG8_LDA(At, 1, 1); PG8_STAGE(PG8_SA(1, 0), a3, voffA);
            PG8_BAR; PG8_WAIT_L(0); PG8_MMA(1, 0, At, B0); PG8_BAR; PG8_SCHED;
            PG8_STAGE(PG8_SB(1, 1), b3 + hstepB, voffB);
            PG8_WAIT_V(6); PG8_BAR; PG8_MMA(1, 1, At, B1); PG8_BAR;
            }
        }
        if constexpr (ALIGN_EPI) { if (wr == 0) PG8_BAR; }
        { const int l_tid = wave * 64 + mk_lane();
          const int l_lane = l_tid & 63; E(acc, cur, wr, wc, l_lane & 15, l_lane >> 4, lds, l_tid); }
        if (!has_next) break;
        if (!cur.keep) {
#pragma unroll
        for (int a = 0; a < 2; ++a)
#pragma unroll
            for (int b = 0; b < 2; ++b)
#pragma unroll
                for (int m = 0; m < 4; ++m)
#pragma unroll
                    for (int n = 0; n < 2; ++n) acc[a][b][m][n] = (f32x4){0.f, 0.f, 0.f, 0.f};
        }
        cur = nxt; cA = nA; cB = nB; ++ui;
        if constexpr (ALIGN_EPI) { if (wr == 1) PG8_BAR; }
    }
    PG8_WAIT_V(0);
    if constexpr (!ALIGN_EPI) { if (wr == 0) PG8_BAR; }
    PG8_BAR;
#undef PG8_SA
#undef PG8_SB
#undef PG8_STAGE
#undef PG8_LDA
#undef PG8_LDB
#undef PG8_MMA
#undef PG8_WAIT_V
#undef PG8_WAIT_L
#undef PG8_BAR
#undef PG8_SCHED
}
}
using pg8::Unit; using pg8::Acc;

struct ProbStd {
    const char* A; const char* B; int K, lda, ldb; bool upmap; pg8::StaticOrder S;
    __device__ bool next(int i, Unit& u) const { return S.next(i, u); }
    __device__ const char* a_tile(const Unit& u) const { return A + (size_t)u.pm * 256 * lda * 2; }
    __device__ const char* b_tile(const Unit& u) const { return B + (size_t)u.pn * 256 * ldb * 2; }
    __device__ unsigned a_rowoff(int R) const { const int r = upmap ? (128 * (R >> 6) + 8 * (R & 15) + ((R >> 4) & 3)) : R; return (unsigned)r * (unsigned)lda * 2u; }
    __device__ unsigned b_rowoff(int R) const { return (unsigned)R * (unsigned)ldb * 2u; }
    __device__ size_t a_hstep() const { return (size_t)(upmap ? 4 : 128) * lda * 2; }
    __device__ size_t b_hstep() const { return (size_t)128 * ldb * 2; }
};
struct ProbHalo {
    const char* A; const char* B; int K, lda, ldb; int G, c;
    __device__ bool next(int i, Unit& u) const { const int L = i * G + c; if (L >= 3 * 44) return false; u.pm = L % 3; u.pn = L / 3; u.g = 0; u.part = 0; u.keep = 0; return true; }
    __device__ const char* a_tile(const Unit& u) const { return A + ((long)64 * 256 * u.pm - 1) * (long)lda * 2; }
    __device__ const char* b_tile(const Unit& u) const { return B + (size_t)u.pn * 256 * ldb * 2; }
    __device__ unsigned a_rowoff(int R) const { return (unsigned)(64 * R + 65 * (R & 1)) * (unsigned)lda * 2u; }
    __device__ unsigned b_rowoff(int R) const { return (unsigned)R * (unsigned)ldb * 2u; }
    __device__ size_t a_hstep() const { return (size_t)64 * 128 * lda * 2; }
    __device__ size_t b_hstep() const { return (size_t)128 * ldb * 2; }
};
struct ProbDftC {
    const char* Dm; const char* zb; int G, c;
    static constexpr int K = 512;
    __device__ bool next(int i, Unit& u) const { const int L0 = i * G + c; if (L0 >= 1536) return false; const int L = (L0 % 8) * 192 + L0 / 8;
        u.pm = L & 1; u.g = (L >> 1) & 3; u.pn = L >> 3; u.part = 0; u.keep = 0; return true; }
    __device__ const char* a_tile(const Unit& u) const { return Dm + (size_t)u.pm * 512 * 512 * 2; }
    __device__ const char* b_tile(const Unit& u) const { return zb + ((size_t)u.pn * 256 * D + 512 * u.g) * 2; }
    __device__ unsigned a_rowoff(int R) const { return (unsigned)R * 512u * 2u; }
    __device__ unsigned b_rowoff(int R) const { return (unsigned)R * (unsigned)D * 2u; }
    __device__ size_t a_hstep() const { return (size_t)128 * 512 * 2; }
    __device__ size_t b_hstep() const { return (size_t)128 * D * 2; }
};
struct ProbDftS {
    const char* Fmat; const char* Bt; int G, c;
    static constexpr int K = 2048;
    __device__ bool next(int i, Unit& u) const { const int L0 = (i >> 1) * G + c; if (L0 >= 384) return false;
        const int L = (L0 % 8) * 48 + L0 / 8; u.pn = L & 3; u.pm = (L >> 2) & 3; u.g = L >> 4; u.part = i & 1; u.keep = (i & 1) ^ 1; return true; }
    __device__ const char* a_tile(const Unit& u) const { return Fmat + ((size_t)u.pm * 256 * 4096 + (size_t)u.part * 2048) * 2; }
    __device__ const char* b_tile(const Unit& u) const { return Bt + (((size_t)u.g * 1024 + (size_t)u.pn * 256) * BTP + (size_t)u.part * 2048) * 2; }
    __device__ unsigned a_rowoff(int R) const { return (unsigned)R * 4096u * 2u; }
    __device__ unsigned b_rowoff(int R) const { return (unsigned)R * (unsigned)BTP * 2u; }
    __device__ size_t a_hstep() const { return (size_t)128 * 4096 * 2; }
    __device__ size_t b_hstep() const { return (size_t)128 * BTP * 2; }
};

__device__ __forceinline__ void store_h8(h16* p, const f32x4& v0, const f32x4& v1) {
    u32x4 w; w.x = pk_h2(v0[0], v0[1]); w.y = pk_h2(v0[2], v0[3]); w.z = pk_h2(v1[0], v1[1]); w.w = pk_h2(v1[2], v1[3]);
    *(u32x4*)p = w;
}
__device__ __forceinline__ void store_h8_nt(h16* p, const f32x4& v0, const f32x4& v1) {
    u32x4 w; w.x = pk_h2(v0[0], v0[1]); w.y = pk_h2(v0[2], v0[3]); w.z = pk_h2(v1[0], v1[1]); w.w = pk_h2(v1[2], v1[3]);
    __builtin_nontemporal_store(w, (u32x4*)p);
}

__device__ __forceinline__ f32x4 ldf4(const float* base, unsigned idx) { return *(const f32x4*)((const char*)base + (idx << 2)); }
struct EpiIn {
    h16* Hc; h16* Hq; const float* ropec; const float* ropes;
    __device__ __forceinline__ void operator()(Acc& acc, const Unit& u, int wr, int wc, int fr, int fq, LAS unsigned char* lds, int tid) const {
        const unsigned row0 = u.pm * 256, pn = u.pn, colt = pn * 256 + wc * 32 + 8 * fq;
        const bool rope = (pn >= 12 && pn < 20);
        const float sc = (pn >= 12 && pn < 16) ? QSCALE : 1.0f;
#pragma unroll
        for (int ai = 0; ai < 2; ++ai)
#pragma unroll
            for (int m = 0; m < 4; ++m) {
                const unsigned row = row0 + ai * 128 + wr * 64 + m * 16 + fr;
                if (rope) {
                    const unsigned t = row & (SEQ - 1), d0 = 32 * (wc & 1) + 8 * fq;
                    const float* cp = ropec + t * 64 + d0; const float* sp = ropes + t * 64 + d0;
                    f32x4 v[2][2];
#pragma unroll
                    for (int n = 0; n < 2; ++n) { const f32x4 c = *(const f32x4*)(cp + 4 * n), s = *(const f32x4*)(sp + 4 * n);
                        const f32x4 x1 = acc[ai][0][m][n], x2 = acc[ai][1][m][n];
                        v[0][n] = (x1 * c - x2 * s) * sc; v[1][n] = (x2 * c + x1 * s) * sc; }
                    h16* o = Hq + (size_t)row * 3072 + (256 * (pn - 12) + 128 * (wc >> 1) + d0);
                    store_h8(o, v[0][0], v[0][1]); store_h8(o + 64, v[1][0], v[1][1]);
                } else {
                    if (pn >= 4 && pn < 12) {
                        store_h8(Hc + (size_t)row * 3072 + 1024 + (pn - 4) * 128 + wc * 32 + 8 * fq, acc[ai][0][m][0] * acc[ai][1][m][0], acc[ai][0][m][1] * acc[ai][1][m][1]);
                    } else {
                    h16* o = (pn < 12) ? (Hc + (size_t)row * 3072 + colt) : (Hq + (size_t)row * 3072 + (colt - 3072));
                    store_h8(o, acc[ai][0][m][0], acc[ai][0][m][1]); store_h8(o + 128, acc[ai][1][m][0], acc[ai][1][m][1]); }
                }
                asm volatile("" ::: "memory");
            }
    }
};

struct EpiInQ {
    h16* Hq; const float* ropec; const float* ropes; const float* sx; const float* sw;
    __device__ __forceinline__ void operator()(Acc& acc, const Unit& u, int wr, int wc, int fr, int fq, LAS unsigned char* lds, int tid) const {
        const unsigned row0 = u.pm * 256, pn = u.pn, colt = pn * 256 + wc * 32 + 8 * fq;
        const bool rope = pn < 8;
        const float sc = pn < 4 ? QSCALE : 1.0f;
        f32x4 swv[2][2];
#pragma unroll
        for (int bj = 0; bj < 2; ++bj)
#pragma unroll
            for (int n = 0; n < 2; ++n) swv[bj][n] = ldf4(sw, colt + 128u * bj + 4u * n) * sc;
#pragma unroll
        for (int ai = 0; ai < 2; ++ai)
#pragma unroll
            for (int m = 0; m < 4; ++m) {
                const unsigned row = row0 + ai * 128 + wr * 64 + m * 16 + fr;
                const float rs = *(const float*)((const char*)sx + (row << 2));
                f32x4 x[2][2];
#pragma unroll
                for (int bj = 0; bj < 2; ++bj)
#pragma unroll
                    for (int n = 0; n < 2; ++n) { const pg8::i32x4 iv = __builtin_bit_cast(pg8::i32x4, acc[ai][bj][m][n]); x[bj][n] = __builtin_convertvector(iv, f32x4) * (swv[bj][n] * rs); }
                if (rope) {
                    const unsigned t = row & (SEQ - 1), d0 = 32 * (wc & 1) + 8 * fq;
                    f32x4 v[2][2];
#pragma unroll
                    for (int n = 0; n < 2; ++n) { const f32x4 c = ldf4(ropec, t * 64 + d0 + 4u * n), s = ldf4(ropes, t * 64 + d0 + 4u * n);
                        v[0][n] = x[0][n] * c - x[1][n] * s; v[1][n] = x[1][n] * c + x[0][n] * s; }
                    h16* o = Hq + (size_t)row * 3072 + (256 * pn + 128 * (wc >> 1) + d0);
                    store_h8(o, v[0][0], v[0][1]); store_h8(o + 64, v[1][0], v[1][1]);
                } else {
                    h16* o = Hq + (size_t)row * 3072 + colt;
                    store_h8(o, x[0][0], x[0][1]); store_h8(o + 128, x[1][0], x[1][1]);
                }
                asm volatile("" ::: "memory");
            }
    }
};

template <bool LNX, bool I8 = false> struct EpiResT {
    h16* X; const float* stats; const float* g; const float* bta;
    const float* sa; const float* swd;
    __device__ __forceinline__ void operator()(Acc& acc, const Unit& u, int wr, int wc, int fr, int fq, LAS unsigned char* lds, int tid) const {
#pragma unroll
        for (int bj = 0; bj < 2; ++bj) {
            const unsigned colt = u.pn * 256 + 128u * bj + wc * 32 + 8 * fq;
            f32x4 ga[2], ba[2], cs[2];
            if constexpr (LNX) {
#pragma unroll
                for (int n = 0; n < 2; ++n) { ga[n] = ldf4(g, colt + 4u * n) * ALPHA; ba[n] = ldf4(bta, colt + 4u * n) * ALPHA; }
            }
            if constexpr (I8) {
#pragma unroll
                for (int n = 0; n < 2; ++n) cs[n] = ldf4(swd, colt + 4u * n);
            }
#pragma unroll
            for (int ai = 0; ai < 2; ++ai) {
                h16x8 xv[4];
                f32x2 st[4]; float rs[4];
#pragma unroll
                for (int m = 0; m < 4; ++m) { const unsigned row = u.pm * 256 + ai * 128 + wr * 64 + m * 16 + fr; xv[m] = *(const h16x8*)(X + (size_t)row * D + colt);
                    if constexpr (LNX) st[m] = *(const f32x2*)((const char*)stats + (row << 3));
                    if constexpr (I8) rs[m] = *(const float*)((const char*)sa + (row << 2)); }
                asm volatile("" ::: "memory");
#pragma unroll
                for (int m = 0; m < 4; ++m) {
                    const unsigned row = u.pm * 256 + ai * 128 + wr * 64 + m * 16 + fr;
                    f32x4 z[2];
#pragma unroll
                    for (int n = 0; n < 2; ++n) {
                        f32x4 a = acc[ai][bj][m][n];
                        if constexpr (I8) { const pg8::i32x4 iv = __builtin_bit_cast(pg8::i32x4, a); a = __builtin_convertvector(iv, f32x4) * (cs[n] * rs[m]); }
#pragma unroll
                        for (int e = 0; e < 4; ++e) {
                            if constexpr (LNX) { const float t = ((float)xv[m][4 * n + e] - st[m].x) * st[m].y; z[n][e] = t * ga[n][e] + (ba[n][e] + a[e]); }
                            else z[n][e] = (float)xv[m][4 * n + e] * ALPHA + a[e]; }
                    }
                    store_h8(X + (size_t)row * D + colt, z[0], z[1]);
                }
                asm volatile("" ::: "memory");
            }
        }
    }
};
typedef EpiResT<false> EpiRes;

template <bool I8> struct EpiHalo {
    float* HALO; const float* sx; const float* sw;
    __device__ __forceinline__ void operator()(Acc& acc, const Unit& u, int wr, int wc, int fr, int fq, LAS unsigned char* lds, int tid) const {
        const unsigned h0 = u.pm * 256, colt = u.pn * 256 + wc * 32 + 8 * fq;
        if constexpr (I8) {
#pragma unroll
            for (int ai = 0; ai < 2; ++ai)
#pragma unroll
                for (int m = 0; m < 4; ++m) { const int hidx = (int)(h0 + ai * 128 + wr * 64 + m * 16 + fr); int tok = 64 * hidx + 65 * (hidx & 1) - 1; tok = tok < 0 ? 0 : (tok >= M ? M - 1 : tok);
                    const float rs = sx[tok];
#pragma unroll
                    for (int bj = 0; bj < 2; ++bj)
#pragma unroll
                        for (int n = 0; n < 2; ++n) { const pg8::i32x4 iv = __builtin_bit_cast(pg8::i32x4, acc[ai][bj][m][n]); acc[ai][bj][m][n] = __builtin_convertvector(iv, f32x4) * rs; } } }
#pragma unroll
        for (int ai = 0; ai < 2; ++ai)
#pragma unroll
            for (int m = 0; m < 4; ++m) {
                const unsigned rl = ai * 128 + wr * 64 + m * 16 + fr;
                float* o = HALO + (size_t)(h0 + rl) * FF2 + colt;
#pragma unroll
                for (int bj = 0; bj < 2; ++bj)
#pragma unroll
                    for (int n = 0; n < 2; ++n) *(f32x4*)(o + bj * 128 + 4 * n) = acc[ai][bj][m][n];
            }
    }
};

__device__ __forceinline__ float dpp_shr1(float oldv, float src) {
    return __builtin_bit_cast(float, __builtin_amdgcn_update_dpp(__builtin_bit_cast(int, oldv), __builtin_bit_cast(int, src), 0x111, 0xf, 0xf, false));
}
__device__ __forceinline__ float dpp_shl1(float oldv, float src) {
    return __builtin_bit_cast(float, __builtin_amdgcn_update_dpp(__builtin_bit_cast(int, oldv), __builtin_bit_cast(int, src), 0x101, 0xf, 0xf, false));
}
__device__ __forceinline__ float silu_f(float x) { return x * __builtin_amdgcn_rcpf(1.0f + __expf(-x)); }

template <bool I8> struct EpiUp {
    h16* ACT; const float* HALO; const float* cw;
    const float* sx; const float* sw;
    __device__ __forceinline__ void operator()(Acc& acc, const Unit& u, int wr, int wc, int fr, int fq, LAS unsigned char* lds, int tid) const {
        const unsigned tok0 = u.pm * 256;
        const unsigned tl0 = 128 * wr + 8 * fr;
        if constexpr (I8) {
#pragma unroll
            for (int ai = 0; ai < 2; ++ai) { const f32x4 sa = ldf4(sx, tok0 + tl0 + 4u * ai);
#pragma unroll
                for (int m = 0; m < 4; ++m)
#pragma unroll
                    for (int bj = 0; bj < 2; ++bj)
#pragma unroll
                        for (int n = 0; n < 2; ++n) { const pg8::i32x4 iv = __builtin_bit_cast(pg8::i32x4, acc[ai][bj][m][n]); acc[ai][bj][m][n] = __builtin_convertvector(iv, f32x4) * sa[m]; }
                asm volatile("" ::: "memory"); }
        }
        const unsigned bk = 2 * u.pm + wr;
        const bool lvalid = (bk & 15) != 0, rvalid = (bk & 15) != 15;
#pragma unroll
        for (int bj = 0; bj < 2; ++bj) {
            const unsigned colp = u.pn * 256 + bj * 128 + wc * 32 + 8 * fq;
            const unsigned coll = bj * FF + u.pn * 128 + wc * 32 + 8 * fq;
#pragma unroll
            for (int n = 0; n < 2; ++n) {
                f32x4 c0 = ldf4(cw, coll + 4u * n), c1 = ldf4(cw, (unsigned)FF2 + coll + 4u * n), c2 = ldf4(cw, 2u * FF2 + coll + 4u * n);
                if constexpr (I8) { const f32x4 swv = ldf4(sw, colp + 4u * n); c0 = c0 * swv; c1 = c1 * swv; c2 = c2 * swv; }
                f32x4 hl = {0.f, 0.f, 0.f, 0.f}, hr = {0.f, 0.f, 0.f, 0.f};
                if (fr == 0 && lvalid) hl = ldf4(HALO, (2u * bk) * (unsigned)FF2 + colp + 4u * n);
                if (fr == 15 && rvalid) hr = ldf4(HALO, (2u * bk + 1u) * (unsigned)FF2 + colp + 4u * n);
#pragma unroll
                for (int e = 0; e < 4; ++e) {
                    const float prev = dpp_shr1(hl[e], acc[1][bj][3][n][e]);
                    const float next = dpp_shl1(hr[e], acc[0][bj][0][n][e]);
                    float left = prev;
#pragma unroll
                    for (int j = 0; j < 8; ++j) {
                        const float cur = acc[j >> 2][bj][j & 3][n][e];
                        const float nx = (j < 7) ? acc[(j + 1) >> 2][bj][(j + 1) & 3][n][e] : next;
                        acc[j >> 2][bj][j & 3][n][e] = c0[e] * left + c1[e] * cur + c2[e] * nx;
                        left = cur;
                    }
                }
                asm volatile("" ::: "memory");
            }
        }
        const unsigned colo = u.pn * 128 + wc * 32 + 8 * fq;
#pragma unroll
        for (int ai = 0; ai < 2; ++ai)
#pragma unroll
            for (int m = 0; m < 4; ++m) {
                f32x4 a[2];
#pragma unroll
                for (int n = 0; n < 2; ++n)
#pragma unroll
                    for (int e = 0; e < 4; ++e) a[n][e] = silu_f(acc[ai][0][m][n][e]) * acc[ai][1][m][n][e];
                store_h8_nt((h16*)((char*)ACT + (((tok0 + tl0 + 4u * ai + m) * (unsigned)FF + colo) << 1)), a[0], a[1]);
                asm volatile("" ::: "memory");
            }
    }
};

struct EpiDftC {
    h16* BtAB;
    __device__ __forceinline__ void operator()(Acc& acc, const Unit& u, int wr, int wc, int fr, int fq, LAS unsigned char* lds, int tid) const {
        const unsigned b = u.pn >> 3, s0 = (u.pn & 7) * 256;
#pragma unroll
        for (int ai = 0; ai < 2; ++ai)
#pragma unroll
            for (int m = 0; m < 4; ++m) {
                const unsigned rl = ai * 128 + wr * 64 + m * 16 + fr;
                h16* o = BtAB + ((size_t)(b * 1024 + u.g * 256 + rl)) * BTP + (u.pm * 2048 + s0 + wc * 32 + 8 * fq);
                store_h8(o, acc[ai][0][m][0], acc[ai][0][m][1]); store_h8(o + 128, acc[ai][1][m][0], acc[ai][1][m][1]);
            }
    }
};

__device__ __forceinline__ void store_h8_skip0(h16* p, const f32x4& v0, const f32x4& v1) {
    const unsigned w0 = pk_h2(v0[0], v0[1]), w1 = pk_h2(v0[2], v0[3]); u32x2 w23; w23.x = pk_h2(v1[0], v1[1]); w23.y = pk_h2(v1[2], v1[3]);
    *(unsigned short*)(p + 1) = (unsigned short)(w0 >> 16); *(unsigned*)(p + 2) = w1; *(u32x2*)(p + 4) = w23;
}
struct EpiDftS2 {
    h16* F; float* scratch;
    __device__ __forceinline__ void operator()(Acc& acc, const Unit& u, int wr, int wc, int fr, int fq, LAS unsigned char* lds, int tid) const {
        f32x4* ps = (f32x4*)scratch + tid;
        if (u.part == 0) {
#pragma unroll
            for (int ai = 0; ai < 2; ++ai)
#pragma unroll
                for (int m = 0; m < 4; ++m)
#pragma unroll
                    for (int bj = 0; bj < 2; ++bj)
#pragma unroll
                        for (int n = 0; n < 2; ++n) ps[(((ai * 4 + m) * 2 + bj) * 2 + n) * 512] = acc[ai][bj][m][n];
            return;
        }
        const float sc = 0.0009765625f;
        const unsigned jl = wc * 32 + 8 * fq;
#pragma unroll
        for (int ai = 0; ai < 2; ++ai)
#pragma unroll
            for (int m = 0; m < 4; ++m) {
                const unsigned kk = u.pm * 256 + ai * 128 + wr * 64 + m * 16 + fr;
                h16* o = F + (size_t)(u.g * 2048 + kk) * D + u.pn * 512 + jl;
                h16* om = F + (size_t)(u.g * 2048 + 2048 - kk) * D + u.pn * 512 + jl;
#pragma unroll
                for (int bj = 0; bj < 2; ++bj) {
                    const f32x4 p0 = ps[(((ai * 4 + m) * 2 + bj) * 2 + 0) * 512], p1 = ps[(((ai * 4 + m) * 2 + bj) * 2 + 1) * 512];
                    const f32x4 y0 = acc[ai][bj][m][0] * sc, y1 = acc[ai][bj][m][1] * sc;
                    const f32x4 z0 = (p0 * 2.0f - acc[ai][bj][m][0]) * sc, z1 = (p1 * 2.0f - acc[ai][bj][m][1]) * sc;
                    const bool j0 = (bj == 0) && (jl == 0);
                    store_h8(o + bj * 128, y0, y1);
                    if (j0) store_h8_skip0(o + 256, z0, z1); else store_h8(o + 256 + bj * 128, z0, z1);
                    if (kk != 0) {
                        store_h8(om + bj * 128, z0, z1);
                        if (j0) store_h8_skip0(om + 256, y0, y1); else store_h8(om + 256 + bj * 128, y0, y1);
                    }
                }
                asm volatile("" ::: "memory");
            }
    }
};

struct Args { const float* in[13]; float* out; unsigned char* ws; int ph_lo, ph_hi; };
struct Frame {
    LAS unsigned char* lds; volatile LAS unsigned* MISC; unsigned* ctl;
    int wave, vcu, G;
    unsigned char* ws;
};

__device__ __forceinline__ void dftc_side(Frame& F, const h16* xb, h16* A256) {
    const int lane_ = mk_lane();
    const int gw = F.vcu * 8 + F.wave, NGW = F.G * 8, lane = lane_;
    for (int t = gw; t < M; t += NGW) {
        const h16x8* xr = (const h16x8*)(xb + (size_t)t * D) + lane; float s[4];
#pragma unroll
        for (int j = 0; j < 4; ++j) { const h16x8 v = xr[64 * j]; float a = 0.f;
#pragma unroll
            for (int e = 0; e < 8; e += 2) a += (float)v[e] - (float)v[e + 1];
            s[j] = wave_sum(a); }
        if (lane < 4) { const float v = lane == 0 ? s[0] : (lane == 1 ? s[1] : (lane == 2 ? s[2] : s[3])); A256[((size_t)(t >> 11) * 4 + lane) * 2048 + (t & 2047)] = (h16)v; }
    }
}
__device__ __forceinline__ void dfts_side(Frame& F, const h16* BtAB, const h16* A256, const h16* Fmat, h16* Fo) {
    const int lane_ = mk_lane();
    const int nheavy = (F.G < 384 && 2 * F.G > 384) ? 384 - F.G : 0, bxi = (int)blockIdx.x;
    if (bxi < nheavy) return;
    const int gw = (bxi - nheavy) * 8 + F.wave, NGW = (F.G - nheavy) * 8, lane = lane_;
    for (int J = gw; J < 96 * 32; J += NGW) {
        const int pair = J >> 5, ch = J & 31, b = pair >> 2, grp = pair & 3;
        const h16x8* ap = (const h16x8*)(A256 + (size_t)pair * 2048) + lane; float av[4][8];
#pragma unroll
        for (int j = 0; j < 4; ++j) { const h16x8 v = ap[64 * j];
#pragma unroll
            for (int e = 0; e < 8; ++e) av[j][e] = (float)v[e]; }
        for (int k0 = ch * 33; k0 < ch * 33 + 33; k0 += 3) {
            float a3[3] = {0.f, 0.f, 0.f};
#pragma unroll
            for (int q = 0; q < 3; ++q) { const int kk = (k0 + q) <= 1024 ? (k0 + q) : 1024; const h16x8* fp = (const h16x8*)(Fmat + (size_t)kk * 4096) + lane;
#pragma unroll
                for (int j = 0; j < 4; ++j) { const h16x8 v = fp[64 * j];
#pragma unroll
                    for (int e = 0; e < 8; ++e) a3[q] += (float)v[e] * av[j][e]; } }
#pragma unroll
            for (int q = 0; q < 3; ++q) { const int kk = k0 + q; const float a = wave_sum(a3[q]) * 0.0009765625f;
                if (lane == 0 && kk <= 1024) { Fo[((size_t)b * 2048 + kk) * D + grp * 512 + 256] = (h16)a; if (kk >= 1 && kk <= 1023) Fo[((size_t)b * 2048 + 2048 - kk) * D + grp * 512 + 256] = (h16)a; } }
        }
    }
    for (int r = gw; r < NSEQ * 1024; r += NGW) {
        const h16x8* p = (const h16x8*)(BtAB + (size_t)r * BTP) + lane; float s = 0.f;
#pragma unroll
        for (int j = 0; j < 4; ++j) { const h16x8 v = p[64 * j];
#pragma unroll
            for (int e = 0; e < 8; e += 2) s += (float)v[e] - (float)v[e + 1]; }
        s = wave_sum(s) * 0.0009765625f;
        if (lane == 0) { const int b = r >> 10, n = r & 1023, grp = n >> 8, j = n & 255; h16* o = Fo + ((size_t)b * 2048 + 1024) * D + grp * 512;
            o[j] = (h16)s; if (j >= 1) o[256 + j] = (h16)s; }
    }
}

__device__ __forceinline__ int fpos_chan(int kpos) { const int p = kpos & 511; return (kpos & ~511) + (p <= 256 ? p : 768 - p); }
template <bool KMAP = false>
__device__ __forceinline__ void p0_transpose_item(const float* W, int K, int N, h16* WT, int kb, int np0, int scol0, LAS float* scr, int lane) {
    const int k0 = 64 * kb;
#pragma unroll 8
    for (int i = 0; i < 32; ++i) { const int kk = 2 * i + (lane >> 5); const int ksrc = KMAP ? fpos_chan(k0 + kk) : (k0 + kk); scr[kk * 33 + (lane & 31)] = W[(size_t)ksrc * N + scol0 + (lane & 31)]; }
    asm volatile("s_waitcnt lgkmcnt(0)" ::: "memory");
    const int c = lane & 7;
#pragma unroll
    for (int j = 0; j < 4; ++j) { const int n = (lane >> 3) + 8 * j; const LAS float* s = scr + (8 * c) * 33 + n;
        u32x4 o; o.x = pk_h2(s[0 * 33], s[1 * 33]); o.y = pk_h2(s[2 * 33], s[3 * 33]); o.z = pk_h2(s[4 * 33], s[5 * 33]); o.w = pk_h2(s[6 * 33], s[7 * 33]);
        *(u32x4*)(WT + (size_t)(np0 + n) * K + k0 + 8 * c) = o; }
    asm volatile("s_waitcnt lgkmcnt(0)" ::: "memory");
}
__device__ __forceinline__ float colmax_of(const float* pmax, int idx) { float m = 0.f;
#pragma unroll
    for (int rb = 0; rb < 8; ++rb) m = fmaxf(m, pmax[(size_t)rb * PM_STRIDE + idx]); return m; }
__device__ __forceinline__ void p0_transpose_item_i8(const float* W, int K, int N, signed char* WT, int kb, int np0, int scol0, const float* pmax, int cidx0, LAS float* scr, int lane) {
    const int k0 = 64 * kb;
#pragma unroll 8
    for (int i = 0; i < 32; ++i) { const int kk = 2 * i + (lane >> 5); scr[kk * 33 + (lane & 31)] = W[(size_t)(k0 + kk) * N + scol0 + (lane & 31)]; }
    asm volatile("s_waitcnt lgkmcnt(0)" ::: "memory");
    const int c = lane & 7;
#pragma unroll
    for (int j = 0; j < 4; ++j) { const int n = (lane >> 3) + 8 * j; const LAS float* s = scr + (8 * c) * 33 + n;
        const float mx = colmax_of(pmax, cidx0 + n); const float inv = mx > 0.f ? 127.0f / mx : 0.f;
        *(u32x2*)(WT + (size_t)(np0 + n) * K + k0 + 8 * c) = pack8_i8(s[0 * 33], s[1 * 33], s[2 * 33], s[3 * 33], s[4 * 33], s[5 * 33], s[6 * 33], s[7 * 33], inv); }
    asm volatile("s_waitcnt lgkmcnt(0)" ::: "memory");
}
__device__ __forceinline__ void p0_colmax(Frame& F, const float* w_up, const float* w_in) {
    const int lane = mk_lane();
    LAS float* red = (LAS float*)F.lds;
    float* pmax = (float*)(F.ws + WS_PART);
    constexpr int NCM_UP = 4 * 44 * 8, NCM_IN = 2 * 12 * 8;
    for (int it = F.vcu; it < NCM_UP + NCM_IN; it += F.G) {
        const float* p; int pidx, rb; size_t pitch;
        if (it < NCM_UP) { const int l = it / 352, r = it % 352, cg = r % 44; rb = r / 44; pitch = FF2; pidx = l * FF2 + cg * 256;
            p = w_up + (size_t)l * D * FF2 + (size_t)(rb * 256 + F.wave * 32) * FF2 + cg * 256 + 4 * lane; }
        else { const int j = it - NCM_UP, i = j / 96, r = j % 96, cg = r % 12; rb = r / 12; pitch = DIN; pidx = 4 * FF2 + i * 3072 + cg * 256;
            p = w_in + (size_t)i * D * DIN + (size_t)(rb * 256 + F.wave * 32) * DIN + 3072 + cg * 256 + 4 * lane; }
        f32x4 m = {0.f, 0.f, 0.f, 0.f};
#pragma unroll
        for (int k = 0; k < 32; ++k) { const f32x4 v = *(const f32x4*)(p + (size_t)k * pitch);
#pragma unroll
            for (int e = 0; e < 4; ++e) m[e] = fmaxf(m[e], fabsf(v[e])); }
        *(LAS f32x4*)(red + F.wave * 256 + 4 * lane) = m;
        LDS_FENCE_BAR();
        if (F.wave < 4) { const int c = F.wave * 64 + lane; float mm = 0.f;
#pragma unroll
            for (int w = 0; w < 8; ++w) mm = fmaxf(mm, red[w * 256 + c]);
            pmax[(size_t)rb * PM_STRIDE + pidx + c] = mm; }
        LDS_FENCE_BAR();
    }
}
__device__ __forceinline__ int in_srccol(int np) {
    if (np >= 1024 && np < 3072) { const int pn = np >> 8, p = np & 255; return ((p >> 7) ? 2048 : 1024) + (pn - 4) * 128 + (p & 127); }
    if (np < 1024 || np >= 5120) return np;
    const int pn = np >> 8, p = np & 255, bj = p >> 7, w = p & 127;
    return pn * 256 + 128 * (w >> 6) + 64 * bj + (w & 63);
}
__device__ __forceinline__ int up_srccol(int np) { const int pn = np >> 8, p = np & 255, bj = p >> 7, w = p & 127; return bj * FF + pn * 128 + w; }

template <int PART> __device__ __forceinline__ void p0_prologue(Frame& F, const Args& a) {
    const float* x_prompt = a.in[0]; const float* x_sample = a.in[1]; const float* w_in = a.in[2]; const float* w_om = a.in[4]; const float* w_of = a.in[5];
    const float* w_up = a.in[8]; const float* w_dn = a.in[10];
    unsigned char* ws = F.ws;
    LAS float* scr = (LAS float*)(F.lds + F.wave * 16384);
    const int gw = F.vcu * 8 + F.wave, NGW = F.G * 8, lane0 = mk_lane();
    const long gt = (long)gw * 64 + lane0, NGT = (long)NGW * 64;
    constexpr int I_IN = 32 * (DIN / 32), I_SQ = 32 * (D / 32), I_UP = 32 * (FF2 / 32), I_DN = (FF / 64) * (D / 32);
    constexpr int NITEMS = 2 * I_IN + 2 * I_SQ + 2 * I_SQ + 4 * I_UP + 4 * I_DN;
    for (int it = gw; it < NITEMS; it += NGW) {
        int r = it;
        if (r < 2 * I_IN) { const int i = r / I_IN; r -= i * I_IN; const int nb = r % (DIN / 32), kb = r / (DIN / 32), np0 = nb * 32;
            if ((np0 >= 3072) != (PART != 0)) continue;
            if (PART) p0_transpose_item_i8(w_in + (size_t)i * D * DIN, D, DIN, (signed char*)(ws + WS_WIN8) + ((long)i * 3072 - 3072) * D, kb, np0, in_srccol(np0), (const float*)(ws + WS_PART), 4 * FF2 + i * 3072 + in_srccol(np0) - 3072, scr, lane0);
            else p0_transpose_item(w_in + (size_t)i * D * DIN, D, DIN, (h16*)(ws + WS_WIN) + (size_t)i * DIN * D, kb, np0, in_srccol(np0), scr, lane0);
            continue; }
        r -= 2 * I_IN;
        if (PART && r < 4 * I_SQ) continue;
        if (r < 2 * I_SQ) { const int i = r / I_SQ; r -= i * I_SQ; const int nb = r % (D / 32), kb = r / (D / 32);
            p0_transpose_item(w_om + (size_t)i * D * D, D, D, (h16*)(ws + WS_WOM) + (size_t)i * D * D, kb, nb * 32, nb * 32, scr, lane0); continue; }
        r -= 2 * I_SQ;
        if (r < 2 * I_SQ) { const int i = r / I_SQ; r -= i * I_SQ; const int nb = r % (D / 32), kb = r / (D / 32);
            p0_transpose_item<true>(w_of + (size_t)i * D * D, D, D, (h16*)(ws + WS_WOF) + (size_t)i * D * D, kb, nb * 32, nb * 32, scr, lane0); continue; }
        r -= 2 * I_SQ;
        if (r < 4 * I_UP) { const int l = r / I_UP; r -= l * I_UP; const int nb = r % (FF2 / 32), kb = r / (FF2 / 32), np0 = nb * 32;
            if (((kI8Mask >> l) & 1u) != (unsigned)PART) continue;
            if (PART) p0_transpose_item_i8(w_up + (size_t)l * D * FF2, D, FF2, (signed char*)(ws + WS_W8) + (size_t)l * FF2 * D, kb, np0, up_srccol(np0), (const float*)(ws + WS_PART), l * FF2 + up_srccol(np0), scr, lane0);
            else p0_transpose_item(w_up + (size_t)l * D * FF2, D, FF2, (h16*)(ws + WS_WUP) + (size_t)l * FF2 * D, kb, np0, up_srccol(np0), scr, lane0);
            continue; }
        r -= 4 * I_UP;
        if (PART) break;
        { const int l = r / I_DN; r -= l * I_DN; const int nb = r % (D / 32), kb = r / (D / 32);
            p0_transpose_item(w_dn + (size_t)l * FF * D, FF, D, (h16*)(ws + WS_WDN) + (size_t)l * D * FF, kb, nb * 32, nb * 32, scr, lane0); }
    }
    if constexpr (PART == 1) {
      float* vec = (float*)(ws + WS_VEC); const float* pmax = (const float*)(ws + WS_PART);
      for (long i = gt; i < 4 * FF2; i += NGT) { const int l = (int)i / FF2, np = (int)i % FF2; vec[V_SW + i] = colmax_of(pmax, l * FF2 + up_srccol(np)) * (1.0f / 127.0f); }
      for (long i = gt; i < 2 * 3072; i += NGT) { const int li = (int)i / 3072, np = 3072 + (int)i % 3072; vec[V_SWQ + i] = colmax_of(pmax, 4 * FF2 + li * 3072 + in_srccol(np) - 3072) * (1.0f / 127.0f); }
      if constexpr (kD8Mask != 0u) {
        const h16* wt = (const h16*)(ws + WS_WDN); signed char* w8 = (signed char*)(ws + WS_WDN8);
        for (int r = gw; r < 4 * D; r += NGW) { if (!((kD8Mask >> (r / D)) & 1u)) continue;
            h16x8 in[11];
#pragma unroll
            for (int j = 0; j < 11; ++j) in[j] = *(const h16x8*)(wt + (size_t)r * FF + 512 * j + 8 * lane0);
            const float sc = rowq_rot(in, w8 + (size_t)r * FF, lane0);
            if (lane0 == 0) vec[V_SWD + r] = sc * (1.0f / 128.0f); } }
      return; }
    { h16* Fm = (h16*)(ws + WS_FMAT);
      for (long ch = gt; ch < (long)2048 * 512; ch += NGT) { const int k = (int)(ch >> 9), c8 = (int)(ch & 511) * 8, p = c8 >> 11, s0 = c8 & 2047; unsigned w[4];
#pragma unroll
          for (int e = 0; e < 4; ++e) { float v[2];
#pragma unroll
              for (int q = 0; q < 2; ++q) { const int s = s0 + 2 * e + q; const int ph = (k * s) & 2047; float sn, cs; sincospif((float)ph * (1.0f / 1024.0f), &sn, &cs); v[q] = p ? -sn : cs; }
              w[e] = pk_h2(v[0], v[1]); }
          u32x4 o; o.x = w[0]; o.y = w[1]; o.z = w[2]; o.w = w[3]; *(u32x4*)(Fm + (size_t)k * 4096 + c8) = o; } }
    { h16* Dm = (h16*)(ws + WS_DM);
      for (long ch = gt; ch < 1024 * 64; ch += NGT) { const int n = (int)(ch >> 6), c0 = (int)(ch & 63) * 8, jj = n & 511; const bool issin = n >= 512; unsigned w[4];
#pragma unroll
          for (int e = 0; e < 4; ++e) { float v[2];
#pragma unroll
              for (int q = 0; q < 2; ++q) { const int c = c0 + 2 * e + q; const int ph = (jj * c) & 511; float sn, cs; sincospif((float)ph * (1.0f / 256.0f), &sn, &cs); v[q] = issin ? sn : cs; }
              w[e] = pk_h2(v[0], v[1]); }
          u32x4 o; o.x = w[0]; o.y = w[1]; o.z = w[2]; o.w = w[3]; *(u32x4*)(Dm + (size_t)n * 512 + c0) = o; } }
    { float* rc = (float*)(ws + WS_ROPE); float* rs = rc + 2048 * 64;
      for (long i = gt; i < 2048 * 64; i += NGT) { const int t = (int)(i >> 6), d = (int)(i & 63); const double inv = exp2(-(double)d * (13.287712379549449 / 64.0)); const double ang = (double)t * inv;
          rc[i] = (float)cos(ang); rs[i] = (float)sin(ang); } }
    { h16* xb = (h16*)(ws + WS_R2); signed char* x8 = (signed char*)(ws + WS_X8); float* sx = (float*)(ws + WS_VEC) + V_SX;
      for (int row = gw; row < M; row += NGW) {
          const float* src = row < M_PROMPT ? x_prompt + (size_t)row * D : x_sample + (size_t)(row - M_PROMPT) * D;
          f32x4 v[4][2]; float amax = 0.f;
#pragma unroll
          for (int j = 0; j < 4; ++j) { const int c = 512 * j + 8 * lane0; v[j][0] = *(const f32x4*)(src + c); v[j][1] = *(const f32x4*)(src + c + 4); }
#pragma unroll
          for (int j = 0; j < 4; ++j) { store_h8(xb + (size_t)row * D + 512 * j + 8 * lane0, v[j][0], v[j][1]);
#pragma unroll
              for (int e = 0; e < 4; ++e) amax = fmaxf(amax, fmaxf(fabsf(v[j][0][e]), fabsf(v[j][1][e]))); }
          amax = wave_max(amax);
          const float inv = amax > 0.f ? 127.0f / amax : 0.f;
#pragma unroll
          for (int j = 0; j < 4; ++j) *(u32x2*)(x8 + (size_t)row * D + 512 * j + 8 * lane0) = pack8_i8(v[j][0][0], v[j][0][1], v[j][0][2], v[j][0][3], v[j][1][0], v[j][1][1], v[j][1][2], v[j][1][3], inv);
          if (lane0 == 0) sx[row] = amax * (1.0f / 127.0f);
      } }
}

__device__ __forceinline__ unsigned att_off(unsigned row, unsigned ch) { return 256u * row + 16u * (ch ^ (((row & 3) << 2) | ((row >> 2) & 3))); }
struct AttItem { int br, r, p, idx0, L, h; size_t rowb; };
__device__ __forceinline__ AttItem att_decode(int I) {
    AttItem t; const int bh = I / 48, it = I % 48; t.h = bh & 7; t.rowb = (size_t)(bh >> 3) * SEQ; int blk;
    if (it < 16) { t.br = 0; t.r = 1; t.p = 0; blk = it; } else if (it < 32) { t.br = 1; t.r = 4; t.p = (it - 16) >> 2; blk = (it - 16) & 3; } else { t.br = 2; t.r = 16; t.p = it - 32; blk = 0; }
    t.L = SEQ / t.r; t.idx0 = 128 * blk; return t;
}
#define ATT_ISSUE(T) do { \
        const int ch_ = tid & 15, r4_ = tid >> 4; \
        const h16* base_ = Hq + (T).h * 128 + 8 * ch_; \
        _Pragma("unroll") for (int j = 0; j < 17; ++j) { const bool isv_ = j >= 8; const int rr_ = isv_ ? r4_ + 32 * (j - 8) : r4_ + 32 * j; \
            int kidx_ = (T).idx0 - 64 + rr_; kidx_ = kidx_ < 0 ? 0 : (kidx_ >= (T).L ? (T).L - 1 : kidx_); \
            if (j < 16 || tid < 256) kv[j] = *(const u32x4*)(base_ + ((T).rowb + (T).p + (T).r * kidx_) * 3072 + (isv_ ? 2048 : 1024)); } \
        const int qtok_ = (T).p + (T).r * ((T).idx0 + 16 * w + q16); const h16* qp_ = Hq + ((T).rowb + qtok_) * 3072 + (T).h * 128 + 8 * g; \
        _Pragma("unroll") for (int s = 0; s < 4; ++s) qn[s] = *(const h16x8*)(qp_ + 32 * s); } while (0)
__device__ __forceinline__ void attn_phase(Frame& F, h16* Obr) {
    const h16* Hq = (const h16*)(F.ws + WS_R1 + R1_HQKV); float* Lse = (float*)(F.ws + WS_LSE);
    const int tid_ = F.wave * 64 + mk_lane();
    LAS unsigned char* lds = F.lds; const int tid = tid_, lane = tid & 63, w = F.wave, q16 = lane & 15, g = lane >> 4;
    constexpr int NITEM = NSEQ * NH * 48;
    int i_lo, i_hi, i_st;
    if (F.G % 8 == 0) { const int per = F.G / 8, x = F.vcu / per, j = F.vcu % per; i_lo = x * (NITEM / 8) + j; i_hi = (x + 1) * (NITEM / 8); i_st = per; }
    else { i_lo = (int)((long)F.vcu * NITEM / F.G); i_hi = (int)((long)(F.vcu + 1) * NITEM / F.G); i_st = 1; }
    if (i_lo >= i_hi) return;
    u32x4 kv[17]; h16x8 qn[4];
    AttItem nx = att_decode(i_lo);
    ATT_ISSUE(nx);
    for (int I = i_lo; I < i_hi; I += i_st) {
        const AttItem cu = nx;
        __syncthreads();
        {   const int ch = tid & 15, r4 = tid >> 4;
#pragma unroll
            for (int j = 0; j < 17; ++j) { const bool isv = j >= 8; const int rr = isv ? r4 + 32 * (j - 8) : r4 + 32 * j;
                if (j < 16 || tid < 256) *(LAS u32x4*)(lds + (isv ? ATT_V : ATT_K) + att_off(rr, ch)) = kv[j]; } }
        h16x8 Qf[4];
#pragma unroll
        for (int s = 0; s < 4; ++s) Qf[s] = qn[s];
        __syncthreads();
        if (I + i_st < i_hi) { nx = att_decode(I + i_st); ATT_ISSUE(nx); }
        const int idx0 = cu.idx0, L = cu.L;
        const int qtok = cu.p + cu.r * (idx0 + 16 * w + q16);
        f32x4 sc[9];
        h16x8 kfb[2][4];
#pragma unroll
        for (int s = 0; s < 4; ++s) kfb[0][s] = *(const LAS h16x8*)(lds + ATT_K + att_off(16 * w + q16, 4 * s + g));
#pragma unroll
        for (int tt = 0; tt < 9; ++tt) {
            if (tt + 1 < 9) {
#pragma unroll
                for (int s = 0; s < 4; ++s) kfb[(tt + 1) & 1][s] = *(const LAS h16x8*)(lds + ATT_K + att_off(16 * (w + tt + 1) + q16, 4 * s + g)); }
            asm volatile("" ::: "memory");
            f32x4 a = {0.f, 0.f, 0.f, 0.f};
#pragma unroll
            for (int s = 0; s < 4; ++s) a = __builtin_amdgcn_mfma_f32_16x16x32_f16(kfb[tt & 1][s], Qf[s], a, 0, 0, 0);
            sc[tt] = a; }
        const int ql = 16 * w + q16;
        const int clo = ql > 64 - idx0 ? ql : 64 - idx0, chi = (ql + 128) < (L + 63 - idx0) ? (ql + 128) : (L + 63 - idx0);
        const unsigned span = (unsigned)(chi - clo); const int cb = 16 * w + 4 * g - clo;
        float mx = -3.0e38f;
#pragma unroll
        for (int tt = 0; tt < 9; ++tt)
#pragma unroll
            for (int e = 0; e < 4; ++e) { const bool ok = (unsigned)(cb + 16 * tt + e) <= span; sc[tt][e] = ok ? sc[tt][e] : -3.0e38f; mx = fmaxf(mx, sc[tt][e]); }
        mx = fmaxf(mx, shx<16>(mx)); mx = fmaxf(mx, shx<32>(mx));
        float den = 0.f;
#pragma unroll
        for (int tt = 0; tt < 9; ++tt)
#pragma unroll
            for (int e = 0; e < 4; ++e) { const float pv = __builtin_amdgcn_exp2f(sc[tt][e] - mx); sc[tt][e] = pv; den += pv; }
        den += shx<16>(den); den += shx<32>(den);
        h16x8 Pf[5];
#pragma unroll
        for (int ks = 0; ks < 5; ++ks) { u32x4 wv; wv.x = pk_h2(sc[2 * ks][0], sc[2 * ks][1]); wv.y = pk_h2(sc[2 * ks][2], sc[2 * ks][3]);
            if (ks < 4) { wv.z = pk_h2(sc[2 * ks + 1][0], sc[2 * ks + 1][1]); wv.w = pk_h2(sc[2 * ks + 1][2], sc[2 * ks + 1][3]); } else { wv.z = 0u; wv.w = 0u; }
            Pf[ks] = __builtin_bit_cast(h16x8, wv); }
        const float rden = 1.0f / den;
        unsigned char* op = (unsigned char*)Obr + ((size_t)cu.br * M + cu.rowb + qtok) * 1024 + cu.h * 128 + 4 * g;
        const float rs16 = rden * 16.0f;
        const int qq = q16 >> 2, pp = q16 & 3;
        typedef short s16x8 __attribute__((ext_vector_type(8)));
        s16x4 vlo[2][5], vhi[2][5];
#define ATT_LDV(B, C8) do { _Pragma("unroll") for (int ks = 0; ks < 5; ++ks) { const unsigned r0 = 16 * (w + 2 * ks) + 4 * g + qq, r1 = r0 + 16; \
            vlo[B][ks] = __builtin_bit_cast(s16x4, __builtin_amdgcn_ds_read_tr16_b64_v4i16((LAS s16x4*)(lds + ATT_V + att_off(r0, 2 * (C8) + (pp >> 1)) + 8 * (pp & 1)))); \
            vhi[B][ks] = __builtin_bit_cast(s16x4, __builtin_amdgcn_ds_read_tr16_b64_v4i16((LAS s16x4*)(lds + ATT_V + att_off(r1, 2 * (C8) + (pp >> 1)) + 8 * (pp & 1)))); } } while (0)
        ATT_LDV(0, 0);
#pragma unroll
        for (int c8 = 0; c8 < 8; ++c8) {
            if (c8 + 1 < 8) ATT_LDV((c8 + 1) & 1, c8 + 1);
            asm volatile("" ::: "memory");
            f32x4 o = {0.f, 0.f, 0.f, 0.f};
#pragma unroll
            for (int ks = 0; ks < 5; ++ks) {
                const s16x8 vv = __builtin_shufflevector(vlo[c8 & 1][ks], vhi[c8 & 1][ks], 0, 1, 2, 3, 4, 5, 6, 7);
                o = __builtin_amdgcn_mfma_f32_16x16x32_f16(__builtin_bit_cast(h16x8, vv), Pf[ks], o, 0, 0, 0); }
            int ov = __builtin_amdgcn_cvt_pk_fp8_f32(o[0] * rs16, o[1] * rs16, 0, false); ov = __builtin_amdgcn_cvt_pk_fp8_f32(o[2] * rs16, o[3] * rs16, ov, true);
            *(int*)(op + 16 * c8) = ov; }
#undef ATT_LDV
        if (g == 0) Lse[((size_t)cu.br * M + cu.rowb + qtok) * 8 + cu.h] = (mx + __log2f(den)) * 0.69314718055994531f;
    }
}
#undef ATT_ISSUE

__device__ __forceinline__ void load8(const h16* p, float (&v)[8]) { const h16x8 hv = *(const h16x8*)p;
#pragma unroll
    for (int e = 0; e < 8; ++e) v[e] = (float)hv[e]; }
struct MRow { h16x8 bg[2], pn[2]; u32x2 o[3][2]; float l[3][2]; };
__device__ __forceinline__ MRow merge_load_row(const h16* Hc, const h16* Obr, const float* Lse, int row, int lane) {
    MRow r;
#pragma unroll
    for (int q = 0; q < 2; ++q) {
        const int c = 512 * q + 8 * lane, h = c >> 7;
        r.bg[q] = *(const h16x8*)(Hc + (size_t)row * 3072 + c);
        const int rn = row + 1 < M ? row + 1 : row;
        r.pn[q] = *(const h16x8*)(Hc + (size_t)rn * 3072 + 1024 + c);
#pragma unroll
        for (int b = 0; b < 3; ++b) { r.o[b][q] = *(const u32x2*)((const unsigned char*)Obr + ((size_t)b * M + row) * 1024 + c); r.l[b][q] = Lse[((size_t)b * M + row) * 8 + h]; }
    }
    return r;
}
__device__ __forceinline__ void merge_phase(Frame& F, const h16* Obr, const float* cws  ) {
    const h16* Hc = (const h16*)(F.ws + WS_R1); const float* Lse = (const float*)(F.ws + WS_LSE); h16* YC = (h16*)(F.ws + WS_R1 + R1_HQKV);
    const int lane_ = mk_lane();
    int vcu_ = F.vcu; asm volatile("" : "+s"(vcu_));
    const int gw = vcu_ * 8 + F.wave, NGW = F.G * 8, lane = lane_;
    const int per = (M + NGW - 1) / NGW; const int r_lo = gw * per, r_hi = (r_lo + per) < M ? (r_lo + per) : M;
    if (r_lo >= r_hi) return;
    float w0[2][8], w1[2][8], w2[2][8];
#pragma unroll
    for (int q = 0; q < 2; ++q)
#pragma unroll
        for (int e = 0; e < 8; ++e) { const int c = 512 * q + 8 * lane + e; w0[q][e] = cws[c]; w1[q][e] = cws[1024 + c]; w2[q][e] = cws[2048 + c]; }
    float pl[2][8], pc[2][8];
#pragma unroll
    for (int q = 0; q < 2; ++q) { const int c = 512 * q + 8 * lane;
        load8(Hc + (size_t)r_lo * 3072 + 1024 + c, pc[q]);
        const int rp = r_lo > 0 ? r_lo - 1 : 0;
        load8(Hc + (size_t)rp * 3072 + 1024 + c, pl[q]); }
    MRow cur = merge_load_row(Hc, Obr, Lse, r_lo, lane);
    for (int row = r_lo; row < r_hi; ++row) {
        MRow nxt = cur;
        if (row + 1 < r_hi) nxt = merge_load_row(Hc, Obr, Lse, row + 1, lane);
        asm volatile("" ::: "memory");
        const int t = row & (SEQ - 1);
        const float ml = t > 0 ? 1.0f : 0.0f, mr = t < SEQ - 1 ? 1.0f : 0.0f;
        h16* yo = YC + (size_t)row * D;
#pragma unroll
        for (int q = 0; q < 2; ++q) {
            const int c = 512 * q + 8 * lane;
            f32x4 o0, o1;
#pragma unroll
            for (int e = 0; e < 8; ++e) { const float pr = (float)cur.pn[q][e];
                const float y = (float)cur.bg[q][e] * (w0[q][e] * (ml * pl[q][e]) + w1[q][e] * pc[q][e] + w2[q][e] * (mr * pr)); if (e < 4) o0[e] = y; else o1[e - 4] = y;
                pl[q][e] = pc[q][e]; pc[q][e] = pr; }
            store_h8(yo + c, o0, o1);
        }
#pragma unroll
        for (int q = 0; q < 2; ++q) {
            const int c = 512 * q + 8 * lane;
            const float l0 = cur.l[0][q], l1 = cur.l[1][q], l2 = cur.l[2][q];
            const float mx = fmaxf(l0, fmaxf(l1, l2)); float e0 = __expf(l0 - mx), e1 = __expf(l1 - mx), e2 = __expf(l2 - mx); const float rs = 0.0625f / (e0 + e1 + e2); e0 *= rs; e1 *= rs; e2 *= rs;
            f32x4 o0, o1;
#pragma unroll
            for (int hw = 0; hw < 2; ++hw) {
                const int x0 = (int)(hw ? cur.o[0][q].y : cur.o[0][q].x), x1 = (int)(hw ? cur.o[1][q].y : cur.o[1][q].x), x2 = (int)(hw ? cur.o[2][q].y : cur.o[2][q].x);
                const f32x2 ylo = __builtin_amdgcn_cvt_pk_f32_fp8(x0, false) * e0 + __builtin_amdgcn_cvt_pk_f32_fp8(x1, false) * e1 + __builtin_amdgcn_cvt_pk_f32_fp8(x2, false) * e2;
                const f32x2 yhi = __builtin_amdgcn_cvt_pk_f32_fp8(x0, true) * e0 + __builtin_amdgcn_cvt_pk_f32_fp8(x1, true) * e1 + __builtin_amdgcn_cvt_pk_f32_fp8(x2, true) * e2;
                if (hw == 0) { o0[0] = ylo.x; o0[1] = ylo.y; o0[2] = yhi.x; o0[3] = yhi.y; } else { o1[0] = ylo.x; o1[1] = ylo.y; o1[2] = yhi.x; o1[3] = yhi.y; } }
            store_h8(yo + 1024 + c, o0, o1);
        }
        cur = nxt;
    }
}

template <bool FINAL, bool WA256 = false>
__device__ __forceinline__ void norm_phase(Frame& F, h16* xb, float* out, const float* g, const float* bta, h16* A256 = nullptr) {
    const int lane_ = mk_lane();
    const int gw = F.vcu * 8 + F.wave, NGW = F.G * 8, lane = lane_;
    f32x4 gg[4][2], bb[4][2];
#pragma unroll
    for (int j = 0; j < 4; ++j) { const int c = 512 * j + 8 * lane; gg[j][0] = *(const f32x4*)(g + c); gg[j][1] = *(const f32x4*)(g + c + 4); bb[j][0] = *(const f32x4*)(bta + c); bb[j][1] = *(const f32x4*)(bta + c + 4); }
    h16x8 xv[4];
    if (gw < M) {
#pragma unroll
        for (int j = 0; j < 4; ++j) xv[j] = ((const h16x8*)(xb + (size_t)gw * D) + lane)[64 * j]; }
    for (int row = gw; row < M; row += NGW) {
        float v[4][8]; float s = 0.f;
#pragma unroll
        for (int j = 0; j < 4; ++j)
#pragma unroll
            for (int e = 0; e < 8; ++e) { v[j][e] = (float)xv[j][e]; s += v[j][e]; }
        const int nrow = row + NGW;
        if (nrow < M) {
#pragma unroll
            for (int j = 0; j < 4; ++j) xv[j] = ((const h16x8*)(xb + (size_t)nrow * D) + lane)[64 * j]; }
        const float mean = wave_sum(s) * (1.0f / D); float s2 = 0.f;
#pragma unroll
        for (int j = 0; j < 4; ++j)
#pragma unroll
            for (int e = 0; e < 8; ++e) { v[j][e] -= mean; s2 += v[j][e] * v[j][e]; }
        const float rstd = 1.0f / sqrtf(wave_sum(s2) * (1.0f / D) + LN_EPS);
#pragma unroll
        for (int j = 0; j < 4; ++j) {
            const int c = 512 * j + 8 * lane;
            f32x4 y0, y1;
#pragma unroll
            for (int e = 0; e < 4; ++e) { y0[e] = v[j][e] * rstd * gg[j][0][e] + bb[j][0][e]; y1[e] = v[j][e + 4] * rstd * gg[j][1][e] + bb[j][1][e]; }
            if (FINAL) { float* o = out + (size_t)row * D + c; *(f32x4*)o = y0; *(f32x4*)(o + 4) = y1; }
            else store_h8(xb + (size_t)row * D + c, y0, y1);
            if (WA256) {
                u32x4 w; w.x = pk_h2(y0[0], y0[1]); w.y = pk_h2(y0[2], y0[3]); w.z = pk_h2(y1[0], y1[1]); w.w = pk_h2(y1[2], y1[3]);
                const h16x8 hv = __builtin_bit_cast(h16x8, w); float a = 0.f;
#pragma unroll
                for (int e = 0; e < 8; e += 2) a += (float)hv[e] - (float)hv[e + 1];
                a = wave_sum(a);
                if (lane == 0) A256[((size_t)(row >> 11) * 4 + j) * 2048 + (row & 2047)] = (h16)a;
            }
        }
    }
}

template <bool KEEPZ> __device__ __forceinline__ void norm_phase_x8(Frame& F, h16* xb, signed char* x8, float* sx, const float* g, const float* bta, float* stats) {
    const int lane_ = mk_lane();
    const int gw = F.vcu * 8 + F.wave, NGW = F.G * 8, lane = lane_;
    f32x4 gg[4][2], bb[4][2];
#pragma unroll
    for (int j = 0; j < 4; ++j) { const int c = 512 * j + 8 * lane; gg[j][0] = *(const f32x4*)(g + c); gg[j][1] = *(const f32x4*)(g + c + 4); bb[j][0] = *(const f32x4*)(bta + c); bb[j][1] = *(const f32x4*)(bta + c + 4); }
    h16x8 xv[4];
    if (gw < M) {
#pragma unroll
        for (int j = 0; j < 4; ++j) xv[j] = ((const h16x8*)(xb + (size_t)gw * D) + lane)[64 * j]; }
    for (int row = gw; row < M; row += NGW) {
        float v[4][8]; float s = 0.f;
#pragma unroll
        for (int j = 0; j < 4; ++j)
#pragma unroll
            for (int e = 0; e < 8; ++e) { v[j][e] = (float)xv[j][e]; s += v[j][e]; }
        const int nrow = row + NGW;
        if (nrow < M) {
#pragma unroll
            for (int j = 0; j < 4; ++j) xv[j] = ((const h16x8*)(xb + (size_t)nrow * D) + lane)[64 * j]; }
        const float mean = wave_sum(s) * (1.0f / D); float s2 = 0.f;
#pragma unroll
        for (int j = 0; j < 4; ++j)
#pragma unroll
            for (int e = 0; e < 8; ++e) { v[j][e] -= mean; s2 += v[j][e] * v[j][e]; }
        const float rstd = 1.0f / sqrtf(wave_sum(s2) * (1.0f / D) + LN_EPS);
        float amax = 0.f;
#pragma unroll
        for (int j = 0; j < 4; ++j) {
            const int c = 512 * j + 8 * lane;
            f32x4 y0, y1;
#pragma unroll
            for (int e = 0; e < 4; ++e) { y0[e] = v[j][e] * rstd * gg[j][0][e] + bb[j][0][e]; y1[e] = v[j][e + 4] * rstd * gg[j][1][e] + bb[j][1][e]; v[j][e] = y0[e]; v[j][e + 4] = y1[e];
                amax = fmaxf(amax, fmaxf(fabsf(y0[e]), fabsf(y1[e]))); }
            if constexpr (!KEEPZ) store_h8(xb + (size_t)row * D + c, y0, y1);
        }
        amax = wave_max(amax);
        const float inv = amax > 0.f ? 127.0f / amax : 0.f;
#pragma unroll
        for (int j = 0; j < 4; ++j) *(u32x2*)(x8 + (size_t)row * D + 512 * j + 8 * lane) = pack8_i8(v[j][0], v[j][1], v[j][2], v[j][3], v[j][4], v[j][5], v[j][6], v[j][7], inv);
        if (lane == 0) { sx[row] = amax * (1.0f / 127.0f); if constexpr (KEEPZ) { f32x2 st; st.x = mean; st.y = rstd; *(f32x2*)(stats + 2 * (size_t)row) = st; } }
    }
}

__device__ __forceinline__ void actq_phase(Frame& F, const h16* act, signed char* a8, float* sa) {
    const int lane = mk_lane();
    int vcu_ = F.vcu; asm volatile("" : "+s"(vcu_));
    const int gw = vcu_ * 8 + F.wave, NGW = F.G * 8;
    h16x8 cur[11];
    if (gw < M) {
#pragma unroll
        for (int j = 0; j < 11; ++j) cur[j] = *(const h16x8*)(act + (size_t)gw * FF + 512 * j + 8 * lane); }
    for (int row = gw; row < M; row += NGW) {
        h16x8 nxt[11];
        const int nrow = row + NGW;
#pragma unroll
        for (int j = 0; j < 11; ++j) nxt[j] = cur[j];
        if (nrow < M) {
#pragma unroll
            for (int j = 0; j < 11; ++j) nxt[j] = *(const h16x8*)(act + (size_t)nrow * FF + 512 * j + 8 * lane); }
        const float sc = rowq_rot(cur, a8 + (size_t)row * FF, lane);
        if (lane == 0) sa[row] = sc;
#pragma unroll
        for (int j = 0; j < 11; ++j) cur[j] = nxt[j];
    }
}

constexpr int N_PHASES = 35;
__global__ void __launch_bounds__(512, 2) mk_fwd(Args args) {
    extern __shared__ __attribute__((aligned(16))) unsigned char lds_raw[];
    Frame F;
    F.lds = (LAS unsigned char*)lds_raw;
    F.MISC = (volatile LAS unsigned*)(F.lds + LDS_MISC);
    const int tid0 = threadIdx.x; F.wave = __builtin_amdgcn_readfirstlane(tid0 >> 6);
    F.G = gridDim.x; { const int bx = blockIdx.x; F.vcu = (F.G % 8 == 0) ? (bx % 8) * (F.G / 8) + bx / 8 : bx; }
    F.ws = args.ws; F.ctl = (unsigned*)(args.ws + WS_CTL);
    if (tid0 < 32) F.MISC[tid0] = 0u;
    __syncthreads();
#if MK_ONE_LAUNCH
    constexpr int lo = 0, hi = N_PHASES;
#else
    const int lo = args.ph_lo, hi = args.ph_hi;
#endif
    XcdBarrier bar; bar.bar = F.ctl + CW_BAR; bar.x = 0; bar.st = nullptr;
    if (hi - lo > 1) bar = xcd_barrier_post(F.ctl + CW_BAR, F.MISC + 8);
    bar.w = F.wave;
#ifndef MK_SITES
#define MK_SITES 0xffffffffu
#endif
#define SITE(n) ((MK_SITES >> (n)) & 1u)
#ifndef MK_REP_MASK
#define MK_REP_MASK 0u
#endif
#define RPT(n) _Pragma("unroll") for (int rep_ = 0; rep_ < 1 + (int)((MK_REP_MASK >> (n)) & 1u); ++rep_)
#define RPB() do { if (rep_) xcd_barrier(bar); } while (0)
#if MK_ONE_LAUNCH
#define IN(k) true
#define SEAM(k) xcd_barrier(bar)
#else
#define IN(k) (lo <= (k) && (k) < hi)
#define SEAM(k) do { if (IN(k) && IN((k) + 1)) xcd_barrier(bar); } while (0)
#endif
    const float* ln_mix_g = args.in[6]; const float* ln_mix_b = args.in[7]; const float* ln_ffn_g = args.in[11]; const float* ln_ffn_b = args.in[12];
    const int bx = (int)blockIdx.x;

    RPT(0) if (SITE(0) && IN(0)) { RPB(); p0_colmax(F, args.in[8], args.in[2]); p0_prologue<0>(F, args); xcd_barrier(bar); p0_prologue<1>(F, args); } SEAM(0);

    for (int pair = 0; pair < 2; ++pair) {
        const int pb = 1 + 17 * pair;
        for (int half = 0; half < 2; ++half) {
            const int l = 2 * pair + half;
            size_t zoff = 0; asm volatile("" : "+s"(zoff));
            unsigned char* ws = args.ws + zoff;
            h16* xb = (h16*)(ws + WS_R2);
            const int pm0 = pb + (half ? 9 : 0);
            int pn_;
            if (half == 0) {
                RPT(1) if (SITE(1) && IN(pm0 + 0)) { RPB();
                    { ProbStd P; P.A = (const char*)xb; P.B = (const char*)(ws + WS_WIN) + (size_t)pair * DIN * D * 2; P.K = D; P.lda = D; P.ldb = D; P.upmap = false; P.S.init(M / 256, 3072 / 256, F.G, bx);
                      EpiIn E{(h16*)(ws + WS_R1), (h16*)(ws + WS_R1 + R1_HQKV), (const float*)(ws + WS_ROPE), (const float*)(ws + WS_ROPE) + 2048 * 64};
                      pg8::gemm_phase<ProbStd, EpiIn>(F.lds, F.wave, P, E); }
                    __syncthreads();
                    { ProbStd P; P.A = (const char*)(ws + WS_X8); P.B = (const char*)(ws + WS_WIN8) + (size_t)pair * 3072 * D; P.K = D / 2; P.lda = D / 2; P.ldb = D / 2; P.upmap = false; P.S.init(M / 256, 3072 / 256, F.G, bx);
                      EpiInQ E{(h16*)(ws + WS_R1 + R1_HQKV), (const float*)(ws + WS_ROPE), (const float*)(ws + WS_ROPE) + 2048 * 64, (const float*)(ws + WS_VEC) + V_SX, (const float*)(ws + WS_VEC) + V_SWQ + pair * 3072};
                      pg8::gemm_phase<ProbStd, EpiInQ, true>(F.lds, F.wave, P, E); }
                }
                SEAM(pm0 + 0);
                RPT(2) if (SITE(2) && IN(pm0 + 1)) { RPB(); attn_phase(F, (h16*)args.out); }
                SEAM(pm0 + 1);
                RPT(3) if (SITE(3) && IN(pm0 + 2)) { RPB(); merge_phase(F, (const h16*)args.out, args.in[3] + (size_t)pair * 3 * CONV); }
                SEAM(pm0 + 2);
                RPT(4) if (SITE(4) && IN(pm0 + 3)) { RPB();
                    ProbStd P; P.A = (const char*)(ws + WS_R1 + R1_HQKV); P.B = (const char*)(ws + WS_WOM) + (size_t)pair * D * D * 2; P.K = D; P.lda = D; P.ldb = D; P.upmap = false; P.S.init(M / 256, D / 256, F.G, bx);
                    EpiRes E{xb, nullptr, nullptr, nullptr};
                    pg8::gemm_phase<ProbStd, EpiRes>(F.lds, F.wave, P, E);
                }
                SEAM(pm0 + 3);
                pn_ = pm0 + 4;
            } else {
                RPT(5) if (SITE(5) && IN(pm0 + 0)) { RPB();
                    ProbDftC P; P.Dm = (const char*)(ws + WS_DM); P.zb = (const char*)xb; P.G = F.G; P.c = bx;
                    EpiDftC E{(h16*)(ws + WS_R1)};
                    pg8::gemm_phase<ProbDftC, EpiDftC>(F.lds, F.wave, P, E);
                }
                SEAM(pm0 + 0);
                RPT(6) if (SITE(6) && IN(pm0 + 1)) { RPB();
                    ProbDftS P; P.Fmat = (const char*)(ws + WS_FMAT); P.Bt = (const char*)(ws + WS_R1); P.G = F.G; P.c = bx;
                    EpiDftS2 E{(h16*)(ws + WS_R1 + R1_F), args.out + (size_t)blockIdx.x * 65536};
                    pg8::gemm_phase<ProbDftS, EpiDftS2>(F.lds, F.wave, P, E);
                    dfts_side(F, (const h16*)(ws + WS_R1), (const h16*)(ws + WS_STATS), (const h16*)(ws + WS_FMAT), (h16*)(ws + WS_R1 + R1_F));
                }
                SEAM(pm0 + 1);
                RPT(7) if (SITE(7) && IN(pm0 + 2)) { RPB();
                    ProbStd P; P.A = (const char*)(ws + WS_R1 + R1_F); P.B = (const char*)(ws + WS_WOF) + (size_t)pair * D * D * 2; P.K = D; P.lda = D; P.ldb = D; P.upmap = false; P.S.init(M / 256, D / 256, F.G, bx);
                    EpiRes E{xb, nullptr, nullptr, nullptr};
                    pg8::gemm_phase<ProbStd, EpiRes>(F.lds, F.wave, P, E);
                }
                SEAM(pm0 + 2);
                pn_ = pm0 + 3;
            }
            RPT(8) if (SITE(8) && IN(pn_)) { RPB(); norm_phase_x8<true>(F, xb, (signed char*)(ws + WS_X8), (float*)(ws + WS_VEC) + V_SX, ln_mix_g + l * D, ln_mix_b + l * D, (float*)(ws + WS_LSE)); }
            SEAM(pn_);
            const int pf = pn_ + 1;
            const bool i8 = (kI8Mask >> l) & 1u;
            const char* Wup = i8 ? (const char*)(ws + WS_W8) + (size_t)l * FF2 * D : (const char*)(ws + WS_WUP) + (size_t)l * FF2 * D * 2;
            const float* swl = (const float*)(ws + WS_VEC) + V_SW + l * FF2; const float* sxv = (const float*)(ws + WS_VEC) + V_SX;
            RPT(9) if (SITE(9) && IN(pf + 0)) { RPB();
                if (kI8Mask == 0xFu || (kI8Mask != 0u && i8)) { ProbHalo P; P.A = (const char*)(ws + WS_X8); P.B = Wup; P.K = D / 2; P.lda = D / 2; P.ldb = D / 2; P.G = F.G; P.c = bx;
                    EpiHalo<true> E{(float*)(ws + WS_HALO), sxv, swl};
                    pg8::gemm_phase<ProbHalo, EpiHalo<true>, true>(F.lds, F.wave, P, E); }
                else if constexpr (kI8Mask != 0xFu) { ProbHalo P; P.A = (const char*)xb; P.B = Wup; P.K = D; P.lda = D; P.ldb = D; P.G = F.G; P.c = bx;
                    EpiHalo<false> E{(float*)(ws + WS_HALO), sxv, swl};
                    pg8::gemm_phase<ProbHalo, EpiHalo<false>, false>(F.lds, F.wave, P, E); }
            }
            SEAM(pf + 0);
            RPT(10) if (SITE(10) && IN(pf + 1)) { RPB();
                if (kI8Mask == 0xFu || (kI8Mask != 0u && i8)) { ProbStd P; P.A = (const char*)(ws + WS_X8); P.B = Wup; P.K = D / 2; P.lda = D / 2; P.ldb = D / 2; P.upmap = true; P.S.init(M / 256, FF2 / 256, F.G, bx);
                    EpiUp<true> E{(h16*)(ws + WS_R1), (const float*)(ws + WS_HALO), args.in[9] + (size_t)l * 3 * FF2, sxv, swl};
                    pg8::gemm_phase<ProbStd, EpiUp<true>, true>(F.lds, F.wave, P, E); }
                else if constexpr (kI8Mask != 0xFu) { ProbStd P; P.A = (const char*)xb; P.B = Wup; P.K = D; P.lda = D; P.ldb = D; P.upmap = true; P.S.init(M / 256, FF2 / 256, F.G, bx);
                    EpiUp<false> E{(h16*)(ws + WS_R1), (const float*)(ws + WS_HALO), args.in[9] + (size_t)l * 3 * FF2, sxv, swl};
                    pg8::gemm_phase<ProbStd, EpiUp<false>, false>(F.lds, F.wave, P, E); }
            }
            SEAM(pf + 1);
            const bool d8 = (kD8Mask >> l) & 1u;
            if (kD8Mask != 0u && d8) { actq_phase(F, (const h16*)(ws + WS_R1), (signed char*)args.out, (float*)(ws + WS_VEC) + V_SA); xcd_barrier(bar); }
            RPT(11) if (SITE(11) && IN(pf + 2)) { RPB();
                if (kD8Mask != 0u && d8) {
                    ProbStd P; P.A = (const char*)args.out; P.B = (const char*)(ws + WS_WDN8) + (size_t)l * D * FF; P.K = FF / 2; P.lda = FF / 2; P.ldb = FF / 2; P.upmap = false; P.S.init(M / 256, D / 256, F.G, bx);
                    EpiResT<true, true> E{xb, (const float*)(ws + WS_LSE), ln_mix_g + l * D, ln_mix_b + l * D, (const float*)(ws + WS_VEC) + V_SA, (const float*)(ws + WS_VEC) + V_SWD + l * D};
                    pg8::gemm_phase<ProbStd, EpiResT<true, true>, true>(F.lds, F.wave, P, E);
                } else if constexpr (kD8Mask != 0xFu) {
                    ProbStd P; P.A = (const char*)(ws + WS_R1); P.B = (const char*)(ws + WS_WDN) + (size_t)l * D * FF * 2; P.K = FF; P.lda = FF; P.ldb = FF; P.upmap = false; P.S.init(M / 256, D / 256, F.G, bx);
                    EpiResT<true> E{xb, (const float*)(ws + WS_LSE), ln_mix_g + l * D, ln_mix_b + l * D};
                    pg8::gemm_phase<ProbStd, EpiResT<true>>(F.lds, F.wave, P, E);
                }
            }
            SEAM(pf + 2);
            if (l < 3) { RPT(12) if (SITE(12) && IN(pf + 3)) { RPB(); if (half == 0) norm_phase<false, true>(F, xb, args.out, ln_ffn_g + l * D, ln_ffn_b + l * D, (h16*)(ws + WS_STATS)); else norm_phase_x8<false>(F, xb, (signed char*)(ws + WS_X8), (float*)(ws + WS_VEC) + V_SX, ln_ffn_g + l * D, ln_ffn_b + l * D, nullptr); } SEAM(pf + 3); }
            else { RPT(13) if (SITE(13) && IN(pf + 3)) norm_phase<true>(F, xb, args.out, ln_ffn_g + l * D, ln_ffn_b + l * D); }
        }
    }
#undef IN
#undef SEAM
}

extern "C" void kernel_launch(void* const* d_in, const int* in_sizes, int n_in, void* d_out, int out_size, void* d_ws, size_t ws_size, hipStream_t stream) {
    static int grid = 0;
    if (grid == 0) {
        if (n_in != 13 || out_size != M * D || ws_size < WS_END) { fprintf(stderr, "kernel_launch: unexpected problem (n_in %d, out %d, ws %zu)\n", n_in, out_size, ws_size); grid = -1; return; }
        int dev = 0, cus = 0, per_cu = 0;
        if (hipGetDevice(&dev) != hipSuccess || hipDeviceGetAttribute(&cus, hipDeviceAttributeMultiprocessorCount, dev) != hipSuccess) { grid = -1; return; }
        if (hipFuncSetAttribute((const void*)mk_fwd, hipFuncAttributeMaxDynamicSharedMemorySize, LDS_BYTES) != hipSuccess) { fprintf(stderr, "kernel_launch: hipFuncSetAttribute failed\n"); grid = -1; return; }
        if (hipOccupancyMaxActiveBlocksPerMultiprocessor(&per_cu, (const void*)mk_fwd, 512, LDS_BYTES) != hipSuccess || per_cu < 1) { fprintf(stderr, "kernel_launch: occupancy query says %d\n", per_cu); }
        (void)hipGetLastError();
        grid = cus;
    }
    if (grid < 0) return;
    (void)hipMemsetAsync((char*)d_ws + WS_CTL, 0, CTL_ZERO_BYTES, stream);
    Args a{};
    for (int i = 0; i < 13; ++i) a.in[i] = (const float*)d_in[i];
    a.out = (float*)d_out; a.ws = (unsigned char*)d_ws;
#if MK_ONE_LAUNCH
    a.ph_lo = 0; a.ph_hi = N_PHASES;
    hipLaunchKernelGGL(mk_fwd, dim3(grid), dim3(512), LDS_BYTES, stream, a);
#else
    for (int k = 0; k < N_PHASES; ++k) { a.ph_lo = k; a.ph_hi = k + 1; hipLaunchKernelGGL(mk_fwd, dim3(grid), dim3(512), LDS_BYTES, stream, a); }
#endif
}
```
